# Optimizing an MI355X kernel written in HIP

```python
import math
import jax, jax.numpy as jnp
from jax import lax
import numpy as np

D_MODEL = 1024
BATCH = 1
SEQ = 16384
DEPTH = 1

D_MIX = D_MODEL
D_HGRN = D_MIX // 2
D_DIFF = D_MIX - D_HGRN
HGRN_EXPAND = 128
HGRN_HEADS = D_HGRN // HGRN_EXPAND
HGRN_DK = HGRN_EXPAND
HGRN_DV = D_HGRN // HGRN_HEADS
HGRN_CHUNK = 64
DIFF_HEADS = 4
DIFF_VDIM = D_DIFF // DIFF_HEADS
DIFF_QKDIM = DIFF_VDIM // 2
Q_BLOCK = 128
ROPE_THETA = 10000.0
NORM_EPS = 1e-6
SUBLN_EPS = 1e-5
LAMBDA_STD = 0.1
SPLIT_WIDTHS = (D_HGRN, D_HGRN, D_HGRN, D_HGRN,
                D_DIFF, D_DIFF, D_DIFF, D_DIFF)
D_IN = sum(SPLIT_WIDTHS)
SPLIT_POINTS = tuple(int(v) for v in np.cumsum(SPLIT_WIDTHS)[:-1])

kernel_name = "hymba_style_hgrn2_diffattn_hybrid"


def rmsnorm(x, w, eps=NORM_EPS):
    xf = x.astype(jnp.float32)
    y = xf * lax.rsqrt(jnp.mean(xf * xf, axis=-1, keepdims=True) + eps)
    return (y * w.astype(jnp.float32)).astype(x.dtype)


def rope_tables(T):
    half = DIFF_QKDIM // 2
    inv_freq = 1.0 / (ROPE_THETA ** (jnp.arange(half, dtype=jnp.float32) / half))
    ang = jnp.arange(T, dtype=jnp.float32)[:, None] * inv_freq[None, :]
    return jnp.cos(ang), jnp.sin(ang)


def apply_rope(t, cos, sin):
    c = cos[:, None, None, :].astype(t.dtype)
    s = sin[:, None, None, :].astype(t.dtype)
    t1, t2 = jnp.split(t, 2, axis=-1)
    return jnp.concatenate([t1 * c - t2 * s, t2 * c + t1 * s], axis=-1)


def hgrn2_mixer(q, f_pre, i, lb):
    B, T, _ = q.shape
    N = T // HGRN_CHUNK
    f = lb + (1.0 - lb) * jax.nn.sigmoid(f_pre.astype(jnp.float32))
    k = 1.0 - f
    g = jnp.log(f)

    def heads(t, d):
        return t.astype(jnp.float32).reshape(B, N, HGRN_CHUNK, HGRN_HEADS, d).transpose(1, 0, 3, 2, 4)

    qc, kc, gc = heads(q, HGRN_DK), heads(k, HGRN_DK), heads(g, HGRN_DK)
    vc = heads(i, HGRN_DV)
    bc = jnp.cumsum(gc, axis=3)
    causal = jnp.tril(jnp.ones((HGRN_CHUNK, HGRN_CHUNK), dtype=bool))[None, None, :, :, None]

    def step(S, inp):
        q_, k_, v_, b_ = inp
        inter = jnp.einsum('bhcd,bhde->bhce', q_ * jnp.exp(b_), S)
        diff = b_[:, :, :, None, :] - b_[:, :, None, :, :]
        decay = jnp.where(causal, jnp.exp(jnp.where(causal, diff, 0.0)), 0.0)
        A = jnp.einsum('bhtd,bhsd,bhtsd->bhts', q_, k_, decay)
        intra = jnp.einsum('bhts,bhse->bhte', A, v_)
        b_last = b_[:, :, -1, :]
        S_new = jnp.exp(b_last)[..., None] * S + jnp.einsum(
            'bhsd,bhse->bhde', k_ * jnp.exp(b_last[:, :, None, :] - b_), v_)
        return S_new, inter + intra

    S0 = jnp.zeros((B, HGRN_HEADS, HGRN_DK, HGRN_DV), jnp.float32)
    _, ys = lax.scan(step, S0, (qc, kc, vc, bc))
    return ys.transpose(1, 0, 3, 2, 4).reshape(B, T, HGRN_HEADS, HGRN_DV)


def diff_attention(q, k, v, lam):
    B, H, _, T, dh = q.shape
    NB = T // Q_BLOCK
    scale = dh ** -0.5
    q_blocks = q.reshape(B, H, 2, NB, Q_BLOCK, dh).transpose(3, 0, 1, 2, 4, 5)
    q_pos = jnp.arange(T).reshape(NB, Q_BLOCK)
    k_pos = jnp.arange(T)

    def attend(args):
        qb, qp = args
        s = jnp.einsum('bhcqd,bhckd->bhcqk', qb, k).astype(jnp.float32) * scale
        s = jnp.where((qp[:, None] >= k_pos[None, :])[None, None, None], s, -jnp.inf)
        p = jax.nn.softmax(s, axis=-1)
        w = p[:, :, 0] - lam * p[:, :, 1]
        return jnp.einsum('bhqk,bhke->bhqe', w.astype(v.dtype), v)

    o = lax.map(attend, (q_blocks, q_pos))
    return o.transpose(1, 0, 3, 2, 4).reshape(B, T, H, DIFF_VDIM)


def setup_inputs(seed: int = 0) -> dict:
    key = jax.random.key(seed)
    ks = jax.random.split(key, 12)
    f32 = jnp.float32
    x = jax.random.normal(ks[0], (BATCH, SEQ, D_MODEL), f32)
    norm_w = 1.0 + 0.02 * jax.random.normal(ks[1], (DEPTH, D_MODEL), f32)
    w_in = jax.random.normal(ks[2], (DEPTH, D_MODEL, D_IN), f32) * D_MODEL ** -0.5
    hgrn_lb_logits = 0.1 * jax.random.normal(ks[3], (DEPTH + 1, D_HGRN), f32)
    hgrn_norm_w = 1.0 + 0.02 * jax.random.normal(ks[4], (DEPTH, HGRN_DV), f32)
    diff_lambda_q1 = LAMBDA_STD * jax.random.normal(ks[5], (DEPTH, DIFF_QKDIM), f32)
    diff_lambda_k1 = LAMBDA_STD * jax.random.normal(ks[6], (DEPTH, DIFF_QKDIM), f32)
    diff_lambda_q2 = LAMBDA_STD * jax.random.normal(ks[7], (DEPTH, DIFF_QKDIM), f32)
    diff_lambda_k2 = LAMBDA_STD * jax.random.normal(ks[8], (DEPTH, DIFF_QKDIM), f32)
    diff_norm_w = 1.0 + 0.02 * jax.random.normal(ks[9], (DEPTH, DIFF_VDIM), f32)
    w_out = jax.random.normal(ks[10], (DEPTH, D_MIX, D_MODEL), f32) * (D_MIX * 2 * DEPTH) ** -0.5
    final_norm_w = 1.0 + 0.02 * jax.random.normal(ks[11], (D_MODEL,), f32)
    return {"x": x, "norm_w": norm_w, "w_in": w_in, "hgrn_lb_logits": hgrn_lb_logits,
            "hgrn_norm_w": hgrn_norm_w, "diff_lambda_q1": diff_lambda_q1,
            "diff_lambda_k1": diff_lambda_k1, "diff_lambda_q2": diff_lambda_q2,
            "diff_lambda_k2": diff_lambda_k2, "diff_norm_w": diff_norm_w,
            "w_out": w_out, "final_norm_w": final_norm_w}


def reference(x, norm_w, w_in, hgrn_lb_logits, hgrn_norm_w, diff_lambda_q1, diff_lambda_k1,
              diff_lambda_q2, diff_lambda_k2, diff_norm_w, w_out, final_norm_w):
    B, T, _ = x.shape
    cos, sin = rope_tables(T)
    lb_all = jnp.cumsum(jax.nn.softmax(hgrn_lb_logits.astype(jnp.float32), axis=0), axis=0)
    for l in range(DEPTH):
        h = rmsnorm(x, norm_w[l])
        proj = h @ w_in[l].astype(h.dtype)
        hq, hf, hi, hg, dq, dk, dv, dg = jnp.split(proj, SPLIT_POINTS, axis=-1)

        ho = hgrn2_mixer(hq, hf, hi, lb_all[l])
        ho = rmsnorm(ho, hgrn_norm_w[l]).reshape(B, T, D_HGRN)
        ho = ho.astype(x.dtype) * jax.nn.silu(hg)

        qd = apply_rope(dq.reshape(B, T, DIFF_HEADS, 2, DIFF_QKDIM), cos, sin).transpose(0, 2, 3, 1, 4)
        kd = apply_rope(dk.reshape(B, T, DIFF_HEADS, 2, DIFF_QKDIM), cos, sin).transpose(0, 2, 3, 1, 4)
        vd = dv.reshape(B, T, DIFF_HEADS, DIFF_VDIM).transpose(0, 2, 1, 3)
        lambda_init = 0.8 - 0.6 * math.exp(-0.3 * l)
        lam = (jnp.exp(jnp.sum(diff_lambda_q1[l].astype(jnp.float32) * diff_lambda_k1[l].astype(jnp.float32)))
               - jnp.exp(jnp.sum(diff_lambda_q2[l].astype(jnp.float32) * diff_lambda_k2[l].astype(jnp.float32)))
               + lambda_init)
        do = diff_attention(qd, kd, vd, lam)
        do = rmsnorm(do, diff_norm_w[l], SUBLN_EPS) * (1.0 - lambda_init)
        do = do.reshape(B, T, D_DIFF).astype(x.dtype) * jax.nn.silu(dg)

        mix = jnp.concatenate([ho, do], axis=-1)
        x = x + mix @ w_out[l].astype(mix.dtype)
    return rmsnorm(x, final_norm_w)
```

```cpp
#include <hip/hip_runtime.h>
#include <cstdio>
#include <cstdint>

typedef unsigned short bf16_t;
typedef float f32x4 __attribute__((ext_vector_type(4)));
typedef float f32x2 __attribute__((ext_vector_type(2)));
typedef unsigned u32x4 __attribute__((ext_vector_type(4)));
typedef unsigned u32x2 __attribute__((ext_vector_type(2)));
typedef __bf16 bf16x2_t __attribute__((ext_vector_type(2)));

constexpr int T = 16384, DM = 1024, DIN = 4096, DH = 512;
constexpr int NH = 4, HD = 128;
constexpr float NORM_EPS = 1e-6f, SUBLN_EPS = 1e-5f;
constexpr float LAMBDA_INIT = 0.2f;
constexpr float QSCALE = 0.125f * 1.4426950408889634f;

constexpr size_t MiB = 1u << 20;
constexpr size_t WS_CTL = 0;
constexpr size_t WS_COS = 1 * MiB, WS_SIN = 3 * MiB;
constexpr size_t WS_WOUT = 5 * MiB;
constexpr size_t WS_WIN = 8 * MiB;
constexpr size_t WS_XN = 16 * MiB;
constexpr size_t WS_MIX = 16 * MiB;
constexpr size_t WS_HQ = 48 * MiB;
constexpr size_t WS_G = 64 * MiB;
constexpr size_t WS_HI = 96 * MiB;
constexpr size_t WS_HG = 112 * MiB;
constexpr size_t WS_DQ = 128 * MiB;
constexpr size_t WS_DK = 144 * MiB;
constexpr size_t WS_DV = 160 * MiB;
constexpr size_t WS_DG = 176 * MiB;
constexpr size_t WS_US = 192 * MiB;
constexpr size_t WS_BS = 208 * MiB;
constexpr size_t WS_OTMP = 210 * MiB;
constexpr int CT_LAM = 16;
constexpr int CT_LB = 1024;
constexpr int CT_ROWSQ = 16384;

struct Params {
    const float* x; const float* norm_w; const float* w_in; const float* lb_logits; const float* hgrn_norm_w;
    const float* lq1; const float* lk1; const float* lq2; const float* lk2; const float* diff_norm_w; const float* w_out; const float* final_norm_w;
    float* out; unsigned char* ws;
};

__device__ __forceinline__ float bf2f(bf16_t h) { return __uint_as_float((unsigned)h << 16); }
__device__ __forceinline__ unsigned pk2(float lo, float hi) { f32x2 v = {lo, hi}; bf16x2_t b = __builtin_convertvector(v, bf16x2_t); return __builtin_bit_cast(unsigned, b); }
__device__ __forceinline__ bf16_t f2bf(float f) { return (bf16_t)(pk2(f, 0.f) & 0xffffu); }
__device__ __forceinline__ float wave_sum(float v) {
#pragma unroll
    for (int o = 1; o < 64; o <<= 1) v += __shfl_xor(v, o);
    return v;
}
__device__ __forceinline__ float sigmoidf_(float v) { return 1.0f / (1.0f + __expf(-v)); }
__device__ __forceinline__ float siluf_(float v) { return v / (1.0f + __expf(-v)); }

__host__ __device__ __forceinline__ int win_orig_col(int np) {
    if (np < 2048 || np >= 3072) return np;
    const int base = np & ~63, p = np & 63;
    return base + (p >> 1) + 32 * (p & 1);
}

__device__ __forceinline__ void epi8(const Params& P, int type, int t, int c, const float* v) {
    unsigned char* ws = P.ws;
    const size_t off = (size_t)t * DH + c;
    if (type == 1) {
        const float* lb = (const float*)(ws + WS_CTL) + CT_LB + c;
        float g[8];
#pragma unroll
        for (int j = 0; j < 8; ++j) { const float l = lb[j]; const float f = l + (1.0f - l) * sigmoidf_(v[j]); g[j] = __logf(f); }
        float* G = (float*)(ws + WS_G) + off;
        *(f32x4*)G = (f32x4){g[0], g[1], g[2], g[3]}; *(f32x4*)(G + 4) = (f32x4){g[4], g[5], g[6], g[7]};
        return;
    }
    float o[8];
    size_t base;
    if (type == 3 || type == 7) {
#pragma unroll
        for (int j = 0; j < 8; ++j) o[j] = siluf_(v[j]);
        base = (type == 3) ? WS_HG : WS_DG;
    } else if (type == 4 || type == 5) {
        const int i0 = (c & 63) >> 1;
        const f32x4 cs = *(const f32x4*)((const float*)(ws + WS_COS) + (size_t)t * 32 + i0);
        const f32x4 sn = *(const f32x4*)((const float*)(ws + WS_SIN) + (size_t)t * 32 + i0);
        const float sc = (type == 4) ? QSCALE : 1.0f;
#pragma unroll
        for (int j = 0; j < 4; ++j) { const float x1 = v[2 * j], x2 = v[2 * j + 1];
            o[2 * j] = (x1 * cs[j] - x2 * sn[j]) * sc; o[2 * j + 1] = (x2 * cs[j] + x1 * sn[j]) * sc; }
        base = (type == 4) ? WS_DQ : WS_DK;
    } else {
#pragma unroll
        for (int j = 0; j < 8; ++j) o[j] = v[j];
        base = (type == 0) ? WS_HQ : (type == 2) ? WS_HI : WS_DV;
    }
    u32x4 w = {pk2(o[0], o[1]), pk2(o[2], o[3]), pk2(o[4], o[5]), pk2(o[6], o[7])};
    *(u32x4*)((bf16_t*)(ws + base) + off) = w;
}

__device__ __forceinline__ void prologue_phase(const Params& P, int bid, int nblk, float* scr  ) {
    const int tid = threadIdx.x, lane = tid & 63, wave = tid >> 6, nwv = blockDim.x >> 6;
    const int gw = bid * nwv + wave, NGW = nblk * nwv;
    unsigned char* ws = P.ws;
    if (bid == 0 && wave == 0) {
        float a = P.lq1[lane] * P.lk1[lane], b = P.lq2[lane] * P.lk2[lane];
        a = wave_sum(a); b = wave_sum(b);
        if (lane == 0) ((float*)(ws + WS_CTL))[CT_LAM] = __expf(a) - __expf(b) + LAMBDA_INIT;
    }
    if (bid == 0) {
        for (int c = tid; c < DH; c += blockDim.x) { const float l0 = P.lb_logits[c], l1 = P.lb_logits[DH + c]; ((float*)(ws + WS_CTL))[CT_LB + c] = 1.0f / (1.0f + __expf(l1 - l0)); }
    }
    for (int idx = bid * blockDim.x + tid; idx < T * 32; idx += nblk * blockDim.x) {
        const int t = idx >> 5, i = idx & 31;
        const float invf = 1.0f / exp2f((float)i * (13.287712379549449f / 32.0f));
        const float ang = (float)t * invf;
        const double rev = (double)ang * 0.15915494309189535;
        const float fr = (float)(rev - __builtin_rint(rev));
        ((float*)(ws + WS_COS))[idx] = __builtin_amdgcn_cosf(fr);
        ((float*)(ws + WS_SIN))[idx] = __builtin_amdgcn_sinf(fr);
    }
    float* s = scr + wave * (64 * 33);
    constexpr int I_IN = (DM / 64) * (DIN / 32), I_OUT = (DM / 64) * (DM / 32);
    for (int it = gw; it < I_IN + I_OUT; it += NGW) {
        const bool isin = it < I_IN; const int r = isin ? it : it - I_IN;
        const float* W = isin ? P.w_in : P.w_out; const int N = isin ? DIN : DM;
        bf16_t* WT = (bf16_t*)(ws + (isin ? WS_WIN : WS_WOUT));
        const int nblkn = N / 32, kb = r / nblkn, nb = r % nblkn, k0 = 64 * kb, n0 = 32 * nb;
        const int ncol = isin ? win_orig_col(n0 + (lane & 31)) : n0 + (lane & 31);
#pragma unroll 8
        for (int i = 0; i < 32; ++i) { const int kk = 2 * i + (lane >> 5); s[kk * 33 + (lane & 31)] = W[(size_t)(k0 + kk) * N + ncol]; }
        __builtin_amdgcn_wave_barrier(); asm volatile("s_waitcnt lgkmcnt(0)" ::: "memory");
        const int c = lane & 7;
#pragma unroll
        for (int j = 0; j < 4; ++j) { const int n = (lane >> 3) + 8 * j; const float* q = s + (8 * c) * 33 + n;
            u32x4 o; o.x = pk2(q[0 * 33], q[1 * 33]); o.y = pk2(q[2 * 33], q[3 * 33]); o.z = pk2(q[4 * 33], q[5 * 33]); o.w = pk2(q[6 * 33], q[7 * 33]);
            *(u32x4*)(WT + (size_t)(n0 + n) * DM + k0 + 8 * c) = o; }
        __builtin_amdgcn_wave_barrier(); asm volatile("s_waitcnt lgkmcnt(0)" ::: "memory");
    }
    for (int m = gw; m < T; m += NGW) {
        const f32x4* xr = (const f32x4*)(P.x + (size_t)m * DM) + lane; const f32x4* wr = (const f32x4*)P.norm_w + lane;
        f32x4 v[4]; float ss = 0.f;
#pragma unroll
        for (int j = 0; j < 4; ++j) { v[j] = xr[64 * j]; ss += (v[j].x * v[j].x + v[j].y * v[j].y) + (v[j].z * v[j].z + v[j].w * v[j].w); }
        const float rstd = 1.0f / sqrtf(wave_sum(ss) * (1.0f / DM) + NORM_EPS);
        u32x2* o8 = (u32x2*)((bf16_t*)(ws + WS_XN) + (size_t)m * DM) + lane;
#pragma unroll
        for (int j = 0; j < 4; ++j) { const f32x4 w = wr[64 * j]; u32x2 o; o.x = pk2(v[j].x * rstd * w.x, v[j].y * rstd * w.y); o.y = pk2(v[j].z * rstd * w.z, v[j].w * rstd * w.w); o8[64 * j] = o; }
    }
}

__global__ void __launch_bounds__(512) k_prologue(Params P) {
    __shared__ float scr[8 * 64 * 33];
    prologue_phase(P, blockIdx.x, gridDim.x, scr);
}

__global__ void __launch_bounds__(256) k_naive_gemm_in(Params P) {
    __shared__ float As[64][33], Bs[64][33];
    const bf16_t* A = (const bf16_t*)(P.ws + WS_XN); const bf16_t* B = (const bf16_t*)(P.ws + WS_WIN);
    const int tid = threadIdx.x, ty = tid >> 3, tx = tid & 7, m0 = blockIdx.y * 64, n0 = blockIdx.x * 64;
    float acc[2][8] = {};
    const int lr = tid >> 2, lk = (tid & 3) * 8;
    for (int k0 = 0; k0 < DM; k0 += 32) {
        const u32x4 a = *(const u32x4*)(A + (size_t)(m0 + lr) * DM + k0 + lk), b = *(const u32x4*)(B + (size_t)(n0 + lr) * DM + k0 + lk);
#pragma unroll
        for (int j = 0; j < 4; ++j) { As[lr][lk + 2 * j] = __uint_as_float(a[j] << 16); As[lr][lk + 2 * j + 1] = __uint_as_float(a[j] & 0xffff0000u);
            Bs[lr][lk + 2 * j] = __uint_as_float(b[j] << 16); Bs[lr][lk + 2 * j + 1] = __uint_as_float(b[j] & 0xffff0000u); }
        __syncthreads();
#pragma unroll 8
        for (int k = 0; k < 32; ++k) { const float a0 = As[2 * ty][k], a1 = As[2 * ty + 1][k];
#pragma unroll
            for (int j = 0; j < 8; ++j) { const float bv = Bs[8 * tx + j][k]; acc[0][j] += a0 * bv; acc[1][j] += a1 * bv; } }
        __syncthreads();
    }
    const int nc = n0 + 8 * tx, type = nc >> 9, c = nc & 511;
    epi8(P, type, m0 + 2 * ty, c, acc[0]); epi8(P, type, m0 + 2 * ty + 1, c, acc[1]);
}

__global__ void __launch_bounds__(128) k_naive_hgrn(Params P) {
    __shared__ float qs[32][128], fs[32][128];
    const int h = blockIdx.x, e = threadIdx.x;
    const bf16_t* HQ = (const bf16_t*)(P.ws + WS_HQ); const float* G = (const float*)(P.ws + WS_G); const bf16_t* HI = (const bf16_t*)(P.ws + WS_HI);
    float* OT = (float*)(P.ws + WS_OTMP);
    float S[128];
#pragma unroll
    for (int d = 0; d < 128; ++d) S[d] = 0.f;
    for (int t0 = 0; t0 < T; t0 += 32) {
        for (int i = 0; i < 32; ++i) { qs[i][e] = bf2f(HQ[(size_t)(t0 + i) * DH + h * HD + e]); fs[i][e] = __expf(G[(size_t)(t0 + i) * DH + h * HD + e]); }
        __syncthreads();
        for (int i = 0; i < 32; ++i) {
            const float v = bf2f(HI[(size_t)(t0 + i) * DH + h * HD + e]); float o = 0.f;
#pragma unroll
            for (int d = 0; d < 128; ++d) { const float f = fs[i][d]; S[d] = f * S[d] + (1.0f - f) * v; o += qs[i][d] * S[d]; }
            OT[(size_t)(t0 + i) * DH + h * HD + e] = o;
        }
        __syncthreads();
    }
}
__global__ void __launch_bounds__(256) k_naive_hgrn_norm(Params P) {
    const int lane = threadIdx.x & 63, gw = (blockIdx.x * blockDim.x + threadIdx.x) >> 6, ngw = (gridDim.x * blockDim.x) >> 6;
    const float* OT = (const float*)(P.ws + WS_OTMP); const bf16_t* HG = (const bf16_t*)(P.ws + WS_HG); bf16_t* MIX = (bf16_t*)(P.ws + WS_MIX);
    for (int r = gw; r < T * NH; r += ngw) {
        const int t = r >> 2, h = r & 3; const size_t off = (size_t)t * DH + h * HD + 2 * lane;
        const float a = OT[off], b = OT[off + 1];
        const float rs = 1.0f / sqrtf(wave_sum(a * a + b * b) * (1.0f / HD) + NORM_EPS);
        const float y0 = a * rs * P.hgrn_norm_w[2 * lane] * bf2f(HG[off]), y1 = b * rs * P.hgrn_norm_w[2 * lane + 1] * bf2f(HG[off + 1]);
        *(unsigned*)(MIX + (size_t)t * DM + h * HD + 2 * lane) = pk2(y0, y1);
    }
}

__global__ void __launch_bounds__(256) k_naive_attn(Params P) {
    __shared__ float Kt[32][128], Vt[32][128];
    const int tid = threadIdx.x, tl = tid >> 2, vq = tid & 3, h = blockIdx.y, t0 = (gridDim.x - 1 - blockIdx.x) * 64, t = t0 + tl;
    const bf16_t* DQ = (const bf16_t*)(P.ws + WS_DQ); const bf16_t* DK = (const bf16_t*)(P.ws + WS_DK); const bf16_t* DV = (const bf16_t*)(P.ws + WS_DV);
    const bf16_t* DG = (const bf16_t*)(P.ws + WS_DG); bf16_t* MIX = (bf16_t*)(P.ws + WS_MIX);
    const float lam = ((const float*)(P.ws + WS_CTL))[CT_LAM];
    float q1[64], q2[64], o1[32], o2[32];
#pragma unroll
    for (int d = 0; d < 64; ++d) { q1[d] = bf2f(DQ[(size_t)t * DH + h * HD + d]); q2[d] = bf2f(DQ[(size_t)t * DH + h * HD + 64 + d]); }
#pragma unroll
    for (int j = 0; j < 32; ++j) { o1[j] = 0.f; o2[j] = 0.f; }
    float m1 = -1e30f, m2 = -1e30f, l1 = 0.f, l2 = 0.f;
    const int nt = (t0 + 64) / 32;
    for (int kt = 0; kt < nt; ++kt) {
        const int s0 = kt * 32;
        for (int i = tid; i < 32 * 128; i += 256) { const int r = i >> 7, c = i & 127; Kt[r][c] = bf2f(DK[(size_t)(s0 + r) * DH + h * HD + c]); Vt[r][c] = bf2f(DV[(size_t)(s0 + r) * DH + h * HD + c]); }
        __syncthreads();
        for (int s = 0; s < 32; ++s) {
            if (s0 + s <= t) {
                float a = 0.f, b = 0.f;
#pragma unroll
                for (int d = 0; d < 64; ++d) { a += q1[d] * Kt[s][d]; b += q2[d] * Kt[s][64 + d]; }
                { const float mn = fmaxf(m1, a), al = exp2f(m1 - mn), p = exp2f(a - mn); l1 = l1 * al + p; m1 = mn;
#pragma unroll
                  for (int j = 0; j < 32; ++j) o1[j] = o1[j] * al + p * Vt[s][vq * 32 + j]; }
                { const float mn = fmaxf(m2, b), al = exp2f(m2 - mn), p = exp2f(b - mn); l2 = l2 * al + p; m2 = mn;
#pragma unroll
                  for (int j = 0; j < 32; ++j) o2[j] = o2[j] * al + p * Vt[s][vq * 32 + j]; }
            }
        }
        __syncthreads();
    }
    const float i1 = 1.0f / l1, i2 = lam / l2; float ss = 0.f;
#pragma unroll
    for (int j = 0; j < 32; ++j) { o1[j] = o1[j] * i1 - o2[j] * i2; ss += o1[j] * o1[j]; }
    ss += __shfl_xor(ss, 1); ss += __shfl_xor(ss, 2);
    const float rs = (1.0f - LAMBDA_INIT) / sqrtf(ss * (1.0f / HD) + SUBLN_EPS);
#pragma unroll
    for (int j = 0; j < 32; j += 2) {
        const int c = vq * 32 + j;
        const float y0 = o1[j] * rs * P.diff_norm_w[c] * bf2f(DG[(size_t)t * DH + h * HD + c]), y1 = o1[j + 1] * rs * P.diff_norm_w[c + 1] * bf2f(DG[(size_t)t * DH + h * HD + c + 1]);
        *(unsigned*)(MIX + (size_t)t * DM + DH + h * HD + c) = pk2(y0, y1);
    }
}

__global__ void __launch_bounds__(256) k_naive_gemm_out(Params P) {
    __shared__ float As[64][33], Bs[32][65];
    const bf16_t* A = (const bf16_t*)(P.ws + WS_MIX);
    const int tid = threadIdx.x, ty = tid >> 3, tx = tid & 7, m0 = blockIdx.y * 64, n0 = blockIdx.x * 64;
    float acc[2][8] = {};
    const int lr = tid >> 2, lk = (tid & 3) * 8;
    for (int k0 = 0; k0 < DM; k0 += 32) {
        const u32x4 a = *(const u32x4*)(A + (size_t)(m0 + lr) * DM + k0 + lk);
#pragma unroll
        for (int j = 0; j < 4; ++j) { As[lr][lk + 2 * j] = __uint_as_float(a[j] << 16); As[lr][lk + 2 * j + 1] = __uint_as_float(a[j] & 0xffff0000u); }
        for (int i = tid; i < 32 * 64; i += 256) { const int kk = i >> 6, nn = i & 63; Bs[kk][nn] = P.w_out[(size_t)(k0 + kk) * DM + n0 + nn]; }
        __syncthreads();
#pragma unroll 8
        for (int k = 0; k < 32; ++k) { const float a0 = As[2 * ty][k], a1 = As[2 * ty + 1][k];
#pragma unroll
            for (int j = 0; j < 8; ++j) { const float bv = Bs[k][8 * tx + j]; acc[0][j] += a0 * bv; acc[1][j] += a1 * bv; } }
        __syncthreads();
    }
#pragma unroll
    for (int r = 0; r < 2; ++r) { const size_t off = (size_t)(m0 + 2 * ty + r) * DM + n0 + 8 * tx;
#pragma unroll
        for (int j = 0; j < 8; ++j) P.out[off + j] = P.x[off + j] + acc[r][j]; }
}
__global__ void __launch_bounds__(256) k_final_norm(Params P) {
    const int lane = threadIdx.x & 63, gw = (blockIdx.x * blockDim.x + threadIdx.x) >> 6, ngw = (gridDim.x * blockDim.x) >> 6;
    for (int m = gw; m < T; m += ngw) {
        f32x4* yr = (f32x4*)(P.out + (size_t)m * DM) + lane; const f32x4* wr = (const f32x4*)P.final_norm_w + lane;
        f32x4 v[4]; float ss = 0.f;
#pragma unroll
        for (int j = 0; j < 4; ++j) { v[j] = yr[64 * j]; ss += (v[j].x * v[j].x + v[j].y * v[j].y) + (v[j].z * v[j].z + v[j].w * v[j].w); }
        const float rstd = 1.0f / sqrtf(wave_sum(ss) * (1.0f / DM) + NORM_EPS);
#pragma unroll
        for (int j = 0; j < 4; ++j) { const f32x4 w = wr[64 * j]; yr[64 * j] = (f32x4){v[j].x * rstd * w.x, v[j].y * rstd * w.y, v[j].z * rstd * w.z, v[j].w * rstd * w.w}; }
    }
}


namespace pg8 {
#define PG8_LAS __attribute__((address_space(3)))
typedef short bf16x8 __attribute__((ext_vector_type(8)));
constexpr int BM = 256, BK = 64, HALF = 128, HTB = HALF * BK * 2  , STAGE_BYTES = 8 * HTB, NXCD = 8, WGM = 8;
__host__ __device__ __forceinline__ int lds_byte(int r, int c) { const int st = (r >> 4) * 2 + (c >> 5), rr = r & 15, cc = c & 31, ob = rr * 64 + cc * 2; return st * 1024 + (ob ^ (((ob >> 9) & 1) << 5)); }
__host__ __device__ __forceinline__ void stage_rc(int b, int& R, int& C) { const int st = b / 1024, sb = b % 1024, swz = sb ^ (((sb >> 9) & 1) << 5); R = (st >> 1) * 16 + swz / 64; C = (st & 1) * 32 + (swz % 64) / 2; }
__host__ __device__ __forceinline__ int perm32(int rho) { const int n = rho >> 4, i = rho & 15; return 8 * (i >> 2) + 4 * n + (i & 3); }
struct Unit { int pm, pn; };
struct Gemm { const bf16_t* A; const bf16_t* Bt; int M, N, K; };
struct StaticOrder {
    int nM, nN, nwg, G, c;
    __host__ __device__ void init(int M, int N, int G_, int c_) { nM = M / BM; nN = N / BM; nwg = nM * nN; G = G_; c = c_; }
    __host__ __device__ bool next(int i, Unit& u) const {
        const long L = (long)i * G + c; if (L >= nwg) return false;
        int wgid = (int)L; { const int q = nwg / NXCD, r = nwg % NXCD, xcd = wgid % NXCD, off = wgid / NXCD; wgid = (xcd < r ? xcd * (q + 1) : r * (q + 1) + (xcd - r) * q) + off; }
        const int nig = WGM * nN, gid = wgid / nig, fm = gid * WGM, gsz = (nM - fm) < WGM ? (nM - fm) : WGM;
        u.pm = fm + ((wgid % nig) % gsz); u.pn = (wgid % nig) / gsz; return true;
    }
    __device__ __forceinline__ void a_ready(const Unit&) const {}
    __device__ __forceinline__ void done(const Unit&) const {}
};
template <class Epi, class Sched, bool ALIGN_EPI = false, bool SP2 = false>
__device__ __forceinline__ void gemm_phase(PG8_LAS unsigned char* lds, const Gemm g, const Sched& S, const Epi& E) {
    const int tid = threadIdx.x, wid = __builtin_amdgcn_readfirstlane(tid >> 6), lane = tid & 63, wr = wid >> 2, wc = wid & 3, fr = lane & 15, fq = lane >> 4;
    const int K = g.K, nt = K / BK;
    unsigned voffA[2], voffB[2];
#pragma unroll
    for (int i = 0; i < 2; ++i) { int R, C; stage_rc(tid * 16 + i * 8192, R, C); const int Rb = Epi::PERM ? ((R & ~31) + perm32(R & 31)) : R;
        voffA[i] = (unsigned)(R * K + C) * 2u; voffB[i] = (unsigned)(Rb * K + C) * 2u; }
    const size_t kstep = (size_t)(BK * 2);
    const size_t hstep = (size_t)HALF * K * 2;
    const size_t tstep = 2 * hstep;
    const unsigned ldsw = (unsigned)wid * 1024u;
    const int aoff = lds_byte(wr * 64 + fr, fq * 8), boff = lds_byte(wc * 32 + fr, fq * 8);
#define PG8_SA(b, h) (((b) * 2 + (h)) * HTB)
#define PG8_SB(b, h) ((4 + (b) * 2 + (h)) * HTB)
#define PG8_STAGE(bufoff, gbase, voff) do { _Pragma("unroll") for (int _i = 0; _i < 2; ++_i) \
        __builtin_amdgcn_global_load_lds((const unsigned*)((const char*)(gbase) + (voff)[_i]), (PG8_LAS unsigned*)(lds + (bufoff) + ldsw + _i * 8192), 16, 0, 0); } while (0)
#define PG8_LDA(dst, b, h) do { _Pragma("unroll") for (int m = 0; m < 4; ++m) _Pragma("unroll") for (int k = 0; k < 2; ++k) dst[m][k] = *(const PG8_LAS bf16x8*)(lds + PG8_SA(b, h) + aoff + m * 2048 + k * 1024); } while (0)
#define PG8_LDB(dst, b, h) do { _Pragma("unroll") for (int n = 0; n < 2; ++n) _Pragma("unroll") for (int k = 0; k < 2; ++k) dst[n][k] = *(const PG8_LAS bf16x8*)(lds + PG8_SB(b, h) + boff + n * 2048 + k * 1024); } while (0)
#define PG8_MMA(ai, bj, At, Bt) do { __builtin_amdgcn_s_setprio(1); _Pragma("unroll") for (int m = 0; m < 4; ++m) _Pragma("unroll") for (int n = 0; n < 2; ++n) _Pragma("unroll") for (int k = 0; k < 2; ++k) \
        acc[ai][bj][m][n] = __builtin_amdgcn_mfma_f32_16x16x32_bf16(Bt[n][k], At[m][k], acc[ai][bj][m][n], 0, 0, 0); __builtin_amdgcn_s_setprio(0); } while (0)
#define PG8_WAIT_V(n) asm volatile("s_waitcnt vmcnt(" #n ")" ::: "memory")
#define PG8_WAIT_L(n) asm volatile("s_waitcnt lgkmcnt(" #n ")" ::: "memory")
#define PG8_BAR __builtin_amdgcn_s_barrier()
#define PG8_SCHED __builtin_amdgcn_sched_barrier(0)
    Unit cur, nxt; int ui = 0;
    if (!S.next(0, cur)) return;
    f32x4 acc[2][2][4][2];
#pragma unroll
    for (int a = 0; a < 2; ++a)
#pragma unroll
        for (int b = 0; b < 2; ++b)
#pragma unroll
            for (int m = 0; m < 4; ++m)
#pragma unroll
                for (int n = 0; n < 2; ++n) acc[a][b][m][n] = (f32x4){0.f, 0.f, 0.f, 0.f};
    bf16x8 At[4][2], B0[2][2], B1[2][2];
    const char* cA = (const char*)g.A + (size_t)cur.pm * tstep; const char* cB = (const char*)g.Bt + (size_t)cur.pn * tstep;
    S.a_ready(cur);
    if constexpr (SP2) {
        PG8_STAGE(PG8_SB(0, 0), cB, voffB); PG8_STAGE(PG8_SB(0, 1), cB + hstep, voffB); PG8_STAGE(PG8_SA(0, 0), cA, voffA); PG8_STAGE(PG8_SA(0, 1), cA + hstep, voffA);
        if (wr == 1) PG8_BAR;
        PG8_WAIT_V(2); PG8_BAR;
        PG8_STAGE(PG8_SB(1, 0), cB + kstep, voffB); PG8_STAGE(PG8_SA(1, 0), cA + kstep, voffA); PG8_STAGE(PG8_SB(1, 1), cB + hstep + kstep, voffB);
        PG8_WAIT_V(6); PG8_BAR;
    } else {
        PG8_STAGE(PG8_SB(0, 0), cB, voffB); PG8_STAGE(PG8_SA(0, 0), cA, voffA); PG8_STAGE(PG8_SB(0, 1), cB + hstep, voffB); PG8_STAGE(PG8_SA(0, 1), cA + hstep, voffA);
        if (wr == 1) PG8_BAR;
        PG8_WAIT_V(4); PG8_BAR;
        PG8_STAGE(PG8_SB(1, 0), cB + kstep, voffB); PG8_STAGE(PG8_SA(1, 0), cA + kstep, voffA); PG8_STAGE(PG8_SB(1, 1), cB + hstep + kstep, voffB);
        PG8_WAIT_V(6); PG8_BAR;
    }
    for (;;) {
        const bool has_next = S.next(ui + 1, nxt);
        const char* nA = has_next ? (const char*)g.A + (size_t)nxt.pm * tstep : cA; const char* nB = has_next ? (const char*)g.Bt + (size_t)nxt.pn * tstep : cB;
        for (int t = 0; t < nt; t += 2) {
            const bool last = (t == nt - 2);
            const char* a1 = cA + (size_t)(t + 1) * kstep;
            const char* a2 = last ? nA : cA + (size_t)(t + 2) * kstep; const char* b2 = last ? nB : cB + (size_t)(t + 2) * kstep;
            const char* a3 = a2 + kstep; const char* b3 = b2 + kstep;
            if (last && has_next) S.a_ready(nxt);
            if constexpr (SP2) {
            PG8_LDB(B0, 0, 0); PG8_LDB(B1, 0, 1); PG8_SCHED; PG8_LDA(At, 0, 0); PG8_STAGE(PG8_SA(1, 1), a1 + hstep, voffA);
            PG8_WAIT_V(8); PG8_WAIT_L(0); PG8_BAR; PG8_MMA(0, 0, At, B0); PG8_MMA(0, 1, At, B1); PG8_BAR; PG8_SCHED;
            PG8_LDA(At, 0, 1); PG8_STAGE(PG8_SB(0, 0), b2, voffB); PG8_STAGE(PG8_SB(0, 1), b2 + hstep, voffB); PG8_STAGE(PG8_SA(0, 0), a2, voffA);
            PG8_WAIT_V(8); PG8_WAIT_L(0); PG8_BAR; PG8_MMA(1, 0, At, B0); PG8_MMA(1, 1, At, B1); PG8_BAR; PG8_SCHED;
            PG8_LDB(B0, 1, 0); PG8_LDB(B1, 1, 1); PG8_SCHED; PG8_LDA(At, 1, 0); PG8_STAGE(PG8_SA(0, 1), a2 + hstep, voffA);
            PG8_WAIT_V(8); PG8_WAIT_L(0); PG8_BAR; PG8_MMA(0, 0, At, B0); PG8_MMA(0, 1, At, B1); PG8_BAR; PG8_SCHED;
            PG8_LDA(At, 1, 1); PG8_STAGE(PG8_SB(1, 0), b3, voffB); PG8_STAGE(PG8_SB(1, 1), b3 + hstep, voffB); PG8_STAGE(PG8_SA(1, 0), a3, voffA);
            PG8_WAIT_V(8); PG8_WAIT_L(0); PG8_BAR; PG8_MMA(1, 0, At, B0); PG8_MMA(1, 1, At, B1); PG8_BAR; PG8_SCHED;
            } else {
            PG8_LDB(B0, 0, 0); PG8_SCHED; PG8_LDA(At, 0, 0); PG8_STAGE(PG8_SA(1, 1), a1 + hstep, voffA);
            PG8_WAIT_L(8); PG8_BAR; PG8_WAIT_L(0); PG8_MMA(0, 0, At, B0); PG8_BAR; PG8_SCHED;
            PG8_LDB(B1, 0, 1); PG8_STAGE(PG8_SB(0, 0), b2, voffB);
            PG8_BAR; PG8_WAIT_L(0); PG8_MMA(0, 1, At, B1); PG8_BAR;
            PG8_LDA(At, 0, 1); PG8_STAGE(PG8_SA(0, 0), a2, voffA);
            PG8_BAR; PG8_WAIT_L(0); PG8_MMA(1, 0, At, B0); PG8_BAR; PG8_SCHED;
            PG8_STAGE(PG8_SB(0, 1), b2 + hstep, voffB);
            PG8_WAIT_V(6); PG8_BAR; PG8_MMA(1, 1, At, B1); PG8_BAR;
            PG8_LDB(B0, 1, 0); PG8_SCHED; PG8_LDA(At, 1, 0); PG8_STAGE(PG8_SA(0, 1), a2 + hstep, voffA);
            PG8_WAIT_L(8); PG8_BAR; PG8_WAIT_L(0); PG8_MMA(0, 0, At, B0); PG8_BAR; PG8_SCHED;
            PG8_LDB(B1, 1, 1); PG8_STAGE(PG8_SB(1, 0), b3, voffB);
            PG8_BAR; PG8_WAIT_L(0); PG8_MMA(0, 1, At, B1); PG8_BAR;
            PG8_LDA(At, 1, 1); PG8_STAGE(PG8_SA(1, 0), a3, voffA);
            PG8_BAR; PG8_WAIT_L(0); PG8_MMA(1, 0, At, B0); PG8_BAR; PG8_SCHED;
            PG8_STAGE(PG8_SB(1, 1), b3 + hstep, voffB);
            PG8_WAIT_V(6); PG8_BAR; PG8_MMA(1, 1, At, B1); PG8_BAR;
            }
        }
        if constexpr (ALIGN_EPI) { if (wr == 0) PG8_BAR; }
        if constexpr (!Epi::AFTER_DRAIN) { E(acc, cur, wr, wc, fr, fq); S.done(cur); }
        if (!has_next) break;
#pragma unroll
        for (int a = 0; a < 2; ++a)
#pragma unroll
            for (int b = 0; b < 2; ++b)
#pragma unroll
                for (int m = 0; m < 4; ++m)
#pragma unroll
                    for (int n = 0; n < 2; ++n) acc[a][b][m][n] = (f32x4){0.f, 0.f, 0.f, 0.f};
        cur = nxt; cA = nA; cB = nB; ++ui;
        if constexpr (ALIGN_EPI) { if (wr == 1) PG8_BAR; }
    }
    PG8_WAIT_V(0);
    if constexpr (!ALIGN_EPI) { if (wr == 0) PG8_BAR; }
    PG8_BAR;
    if constexpr (Epi::AFTER_DRAIN) { E.fused(acc, cur, wr, wc, fr, fq, lds, wid, lane); S.done(cur); }
#undef PG8_SA
#undef PG8_SB
#undef PG8_STAGE
#undef PG8_LDA
#undef PG8_LDB
#undef PG8_MMA
#undef PG8_WAIT_V
#undef PG8_WAIT_L
#undef PG8_BAR
#undef PG8_SCHED
}
}

struct EpiIn {
    static constexpr bool PERM = true, AFTER_DRAIN = false;
    Params P;
    template <int TYPE> __device__ __forceinline__ void run(const f32x4 (&acc)[2][2][4][2], const pg8::Unit& u, int wr, int wc, int fr, int fq) const {
        const int row0 = u.pm * pg8::BM + wr * 64 + fr, c0 = (u.pn & 1) * 256 + wc * 32 + 8 * fq;
#pragma unroll
        for (int ai = 0; ai < 2; ++ai)
#pragma unroll
            for (int m = 0; m < 4; ++m)
#pragma unroll
                for (int bj = 0; bj < 2; ++bj) {
                    const f32x4 v0 = acc[ai][bj][m][0], v1 = acc[ai][bj][m][1];
                    const float v[8] = {v0[0], v0[1], v0[2], v0[3], v1[0], v1[1], v1[2], v1[3]};
                    epi8(P, TYPE, row0 + ai * pg8::HALF + m * 16, c0 + bj * pg8::HALF, v);
                }
    }
    __device__ __forceinline__ void operator()(const f32x4 (&acc)[2][2][4][2], const pg8::Unit& u, int wr, int wc, int fr, int fq) const {
        switch (u.pn >> 1) {
            case 0: run<0>(acc, u, wr, wc, fr, fq); break; case 1: run<1>(acc, u, wr, wc, fr, fq); break;
            case 2: run<2>(acc, u, wr, wc, fr, fq); break; case 3: run<3>(acc, u, wr, wc, fr, fq); break;
            case 4: run<4>(acc, u, wr, wc, fr, fq); break; case 5: run<5>(acc, u, wr, wc, fr, fq); break;
            case 6: run<6>(acc, u, wr, wc, fr, fq); break; default: run<7>(acc, u, wr, wc, fr, fq); break;
        }
    }
};
struct EpiOut {
    static constexpr bool PERM = false, AFTER_DRAIN = false;
    Params P;
    __device__ __forceinline__ void operator()(const f32x4 (&acc)[2][2][4][2], const pg8::Unit& u, int wr, int wc, int fr, int fq) const {
        float* rowsq = (float*)(P.ws + WS_CTL) + CT_ROWSQ;
        const int col0 = u.pn * pg8::BM + wc * 32 + 4 * fq;
#pragma unroll
        for (int ai = 0; ai < 2; ++ai)
#pragma unroll
            for (int m = 0; m < 4; ++m) {
                const int r = u.pm * pg8::BM + ai * pg8::HALF + wr * 64 + m * 16 + fr; const size_t off = (size_t)r * DM + col0; float ss = 0.f;
#pragma unroll
                for (int bj = 0; bj < 2; ++bj)
#pragma unroll
                    for (int n = 0; n < 2; ++n) { const f32x4 xv = *(const f32x4*)(P.x + off + bj * pg8::HALF + n * 16); const f32x4 y = xv + acc[ai][bj][m][n];
                        ss += (y[0] * y[0] + y[1] * y[1]) + (y[2] * y[2] + y[3] * y[3]); *(f32x4*)(P.out + off + bj * pg8::HALF + n * 16) = y; }
                ss += __shfl_xor(ss, 16); ss += __shfl_xor(ss, 32);
                if (fq == 0) atomicAdd(rowsq + r, ss);
            }
    }
};

namespace att {
typedef short bf16x8 __attribute__((ext_vector_type(8)));
typedef short s16x4 __attribute__((ext_vector_type(4)));
typedef float f32x16 __attribute__((ext_vector_type(16)));
constexpr int QBLK = 32, KVBLK = 64, QB = 128;
constexpr int SHM_V = KVBLK * 128 * 2, SHM_K = KVBLK * 128 * 2;
constexpr int OFF_V = 0, OFF_K = 2 * SHM_V, OFF_WS = 2 * SHM_V + 2 * SHM_K, OFF_X = OFF_WS + 8 * 64 * 4, LDS_BYTES = OFF_X + 4 * 4096 * 4;
constexpr float THR = 8.f;
#define KSWZ(row, colB) ((row) * 256 + ((colB) ^ (((row) & 7) << 4)))
#define SBAR() __builtin_amdgcn_sched_barrier(0)
__device__ __forceinline__ int v_st(int k, int c) { const int kk = (k & ~0xC) | ((k & 4) << 1) | ((k & 8) >> 1); return ((kk >> 3) * 4 + (c >> 5)) * 512 + ((kk & 7) * 32 + (c & 31)) * 2; }
__device__ __forceinline__ int v_rd_base(int lane) { return ((lane & 3) << 3) | (((lane >> 2) & 3) << 6) | (((lane >> 4) & 1) << 5) | (((lane >> 5) & 1) << 8); }
constexpr int v_rd_off(int d0, int ks, int half) { return d0 * 512 + ks * 4096 + half * 2048; }
__device__ __forceinline__ int crow(int r, int hi) { return (r & 3) + 8 * (r >> 2) + 4 * hi; }
__device__ __forceinline__ unsigned cvtpk(float lo, float hi) { unsigned r; asm volatile("v_cvt_pk_bf16_f32 %0, %1, %2" : "=v"(r) : "v"(lo), "v"(hi)); return r; }
__device__ __forceinline__ void mask_tile(f32x16& p0, f32x16& p1, int dq) {
    const float NEG = -__builtin_inff();
#pragma unroll
    for (int r = 0; r < 16; ++r) { const int c = (r & 3) + 8 * (r >> 2); if (dq - c < 0) p0[r] = NEG; if (dq - c - 32 < 0) p1[r] = NEG; }
}
__device__ __forceinline__ void partialSM(f32x16& p0, f32x16& p1, float& m_reg, float& mn, float& alpha) {
    float pmax = p0[0];
#pragma unroll
    for (int r = 1; r < 16; ++r) pmax = fmaxf(pmax, p0[r]);
#pragma unroll
    for (int r = 0; r < 16; ++r) pmax = fmaxf(pmax, p1[r]);
    { auto rr = __builtin_amdgcn_permlane32_swap(__float_as_uint(pmax), __float_as_uint(pmax), false, false);
      pmax = fmaxf(__uint_as_float(rr[0]), __uint_as_float(rr[1])); }
    if (__builtin_expect(__all((pmax - m_reg) <= THR), 1)) { mn = m_reg; alpha = 1.f; }
    else { mn = fmaxf(m_reg, pmax); alpha = __builtin_amdgcn_exp2f(m_reg - mn); m_reg = mn; }
#pragma unroll
    for (int r = 0; r < 16; ++r) p0[r] = p0[r] - mn;
#pragma unroll
    for (int r = 0; r < 16; ++r) p1[r] = p1[r] - mn;
#pragma unroll
    for (int r = 0; r < 16; ++r) p0[r] = __builtin_amdgcn_exp2f(p0[r]);
}
__device__ __forceinline__ void finishSM(f32x16& p0, f32x16& p1, float alpha, float& l_reg, bf16x8& pa0, bf16x8& pa1, bf16x8& pa2, bf16x8& pa3) {
#pragma unroll
    for (int r = 0; r < 16; ++r) p1[r] = __builtin_amdgcn_exp2f(p1[r]);
    float ps = 0;
#pragma unroll
    for (int r = 0; r < 16; ++r) ps += p0[r];
#pragma unroll
    for (int r = 0; r < 16; ++r) ps += p1[r];
    { auto rr = __builtin_amdgcn_permlane32_swap(__float_as_uint(ps), __float_as_uint(ps), false, false);
      ps = __uint_as_float(rr[0]) + __uint_as_float(rr[1]); }
    l_reg = l_reg * alpha + ps;
#define PK4(P, B_, OUT) do { unsigned a0 = cvtpk(P[B_+0], P[B_+1]), a1 = cvtpk(P[B_+2], P[B_+3]);                          \
        unsigned b0 = cvtpk(P[B_+4], P[B_+5]), b1 = cvtpk(P[B_+6], P[B_+7]);                                             \
        auto r0 = __builtin_amdgcn_permlane32_swap(a0, b0, false, false); auto r1 = __builtin_amdgcn_permlane32_swap(a1, b1, false, false); \
        u32x4 w = {r0[0], r1[0], r0[1], r1[1]}; OUT = *reinterpret_cast<bf16x8*>(&w); } while (0)
    PK4(p0, 0, pa0); PK4(p0, 8, pa1); PK4(p1, 0, pa2); PK4(p1, 8, pa3);
#undef PK4
}
template <int KB>
__device__ __forceinline__ void qkt(f32x16& p0, f32x16& p1, const char* K_lds, int r32, int hi, int comp, const bf16x8* qr) {
    p0 = f32x16{}; p1 = f32x16{};
    const char* kb[4];
#pragma unroll
    for (int dd = 0; dd < 4; ++dd) kb[dd] = K_lds + KB * SHM_K + KSWZ(r32, (dd * 16 + hi * 8) * 2) + comp * 128;
#pragma unroll
    for (int d0 = 0; d0 < 4; ++d0) { const char* a = kb[d0];
        bf16x8 b0 = *reinterpret_cast<const bf16x8*>(a);
        bf16x8 b1 = *reinterpret_cast<const bf16x8*>(a + 32 * 256);
        p0 = __builtin_amdgcn_mfma_f32_32x32x16_bf16(b0, qr[d0], p0, 0, 0, 0);
        p1 = __builtin_amdgcn_mfma_f32_32x32x16_bf16(b1, qr[d0], p1, 0, 0, 0); }
}
template <int VB>
__device__ __forceinline__ void pv_tile(f32x16* o, int vb0, bf16x8 pa0, bf16x8 pa1, bf16x8 pa2, bf16x8 pa3) {
#define TRRD(dst, off) asm volatile("ds_read_b64_tr_b16 %0, %1 offset:%2" : "=&v"(dst) : "v"(vb0), "i"(off) : "memory")
#define PV_D0(d0) do { s16x4 l0, l1, l2, l3, h0, h1, h2, h3; constexpr int b_ = VB * SHM_V + v_rd_off(d0, 0, 0);   \
        TRRD(l0, b_); TRRD(h0, b_ + 2048); TRRD(l1, b_ + 4096); TRRD(h1, b_ + 6144); TRRD(l2, b_ + 8192); TRRD(h2, b_ + 10240); TRRD(l3, b_ + 12288); TRRD(h3, b_ + 14336); \
        asm volatile("s_waitcnt lgkmcnt(0)" ::: "memory"); SBAR();   \
        o[d0] = __builtin_amdgcn_mfma_f32_32x32x16_bf16(pa0, (bf16x8){l0[0], l0[1], l0[2], l0[3], h0[0], h0[1], h0[2], h0[3]}, o[d0], 0, 0, 0);   \
        o[d0] = __builtin_amdgcn_mfma_f32_32x32x16_bf16(pa1, (bf16x8){l1[0], l1[1], l1[2], l1[3], h1[0], h1[1], h1[2], h1[3]}, o[d0], 0, 0, 0);   \
        o[d0] = __builtin_amdgcn_mfma_f32_32x32x16_bf16(pa2, (bf16x8){l2[0], l2[1], l2[2], l2[3], h2[0], h2[1], h2[2], h2[3]}, o[d0], 0, 0, 0);   \
        o[d0] = __builtin_amdgcn_mfma_f32_32x32x16_bf16(pa3, (bf16x8){l3[0], l3[1], l3[2], l3[3], h3[0], h3[1], h3[2], h3[3]}, o[d0], 0, 0, 0); } while (0)
    PV_D0(0); PV_D0(1); PV_D0(2); PV_D0(3);
#undef PV_D0
#undef TRRD
}

__device__ __forceinline__ void attn_unit(const Params& P, int h, int qb, char* lds) {
    const int tid = threadIdx.x, wid = __builtin_amdgcn_readfirstlane(tid >> 6), lane = tid & 63, r32 = lane & 31, hi = lane >> 5;
    const int comp = wid >> 2, wq = wid & 3;
    const int q0 = qb * QB, NT = 2 * qb + 2;
    const int qlo = q0 + wq * QBLK, qm = qlo + r32 - 4 * hi;
    const bf16_t* DQ = (const bf16_t*)(P.ws + WS_DQ); const bf16_t* Kh = (const bf16_t*)(P.ws + WS_DK) + h * HD; const bf16_t* Vh = (const bf16_t*)(P.ws + WS_DV) + h * HD;
    char* V_lds = lds + OFF_V; char* K_lds = lds + OFF_K;
    float* ws = (float*)(lds + OFF_WS) + wid * 64; float* li_l = ws; float* al_l = ws + 32;
    float m_reg = -1e30f, l_reg = 0; f32x16 o[4] = {};
    const int sr = tid >> 4, sc = (tid & 15) * 8, vst0 = v_st(sr, sc), vst1 = v_st(32 + sr, sc), kws = KSWZ(sr, sc * 2);
    const int vb0 = (int)(uintptr_t)V_lds + v_rd_base(lane);
    bf16x8 qr[4];
#pragma unroll
    for (int d0 = 0; d0 < 4; ++d0) qr[d0] = *(const bf16x8*)(DQ + (size_t)(qlo + r32) * DH + h * HD + comp * 64 + d0 * 16 + hi * 8);
    bf16x8 st_v0, st_v1, st_k0, st_k1;
#define ROWP(p, k0, rr) ((p) + (size_t)((k0) + (rr)) * DH + sc)
#define VMW() asm volatile("s_waitcnt vmcnt(0)" ::: "memory")
#define SLOAD(k0) do { st_v0 = *(const bf16x8*)ROWP(Vh, k0, sr); st_v1 = *(const bf16x8*)ROWP(Vh, k0, 32 + sr); st_k0 = *(const bf16x8*)ROWP(Kh, k0, sr); st_k1 = *(const bf16x8*)ROWP(Kh, k0, 32 + sr); } while (0)
#define SWRITE(bf) do { *(bf16x8*)(V_lds + (bf) * SHM_V + vst0) = st_v0; *(bf16x8*)(V_lds + (bf) * SHM_V + vst1) = st_v1; \
                        *(bf16x8*)(K_lds + (bf) * SHM_K + kws) = st_k0; *(bf16x8*)(K_lds + (bf) * SHM_K + kws + 32 * 256) = st_k1; } while (0)
#define RESC(a) do { if (__any((a) < 1.f)) { if (hi == 0) al_l[r32] = (a); asm volatile("s_waitcnt lgkmcnt(0)" ::: "memory");              \
                     _Pragma("unroll") for (int d_ = 0; d_ < 4; ++d_) _Pragma("unroll") for (int r = 0; r < 16; ++r) o[d_][r] *= al_l[crow(r, hi)]; } } while (0)
#define KBASE(t) ((t) * KVBLK)
#define MASKT(P0_, P1_, t) do { const int kb_ = KBASE(t); if (kb_ + KVBLK - 1 > qlo) mask_tile(P0_, P1_, qm - kb_); } while (0)
    f32x16 pA0, pA1, pB0, pB1; float mnA, mnB, alA, alB; bf16x8 pa0, pa1, pa2, pa3;
    SLOAD(KBASE(0)); VMW(); SWRITE(0); SBAR();
    SLOAD(KBASE(1));
    __syncthreads();
    SBAR(); qkt<0>(pA0, pA1, K_lds, r32, hi, comp, qr);
    MASKT(pA0, pA1, 0); partialSM(pA0, pA1, m_reg, mnA, alA);
    VMW(); SWRITE(1);
    __syncthreads();
#define HALF_STEP(PX0, PX1, mnX, alX, PY0, PY1, alY, t, KB, VB, SB) do {                                                      \
        SBAR(); qkt<KB>(PX0, PX1, K_lds, r32, hi, comp, qr);                                                                  \
        finishSM(PY0, PY1, alY, l_reg, pa0, pa1, pa2, pa3); SBAR();                                                           \
        if ((t) + 1 < NT) { SLOAD(KBASE((t) + 1)); SBAR(); }                                                                  \
        pv_tile<VB>(o, vb0, pa0, pa1, pa2, pa3); MASKT(PX0, PX1, (t)); partialSM(PX0, PX1, m_reg, mnX, alX);                  \
        __syncthreads();                                                                                                      \
        if ((t) + 1 < NT) { VMW(); SWRITE(SB); }                                                                              \
        RESC(alX); __syncthreads(); } while (0)
    for (int t = 1; t + 1 < NT; t += 2) {
        HALF_STEP(pB0, pB1, mnB, alB, pA0, pA1, alA, t, 1, 0, 0);
        HALF_STEP(pA0, pA1, mnA, alA, pB0, pB1, alB, t + 1, 0, 1, 1);
    }
    SBAR(); qkt<1>(pB0, pB1, K_lds, r32, hi, comp, qr); SBAR();
    finishSM(pA0, pA1, alA, l_reg, pa0, pa1, pa2, pa3); SBAR();
    pv_tile<0>(o, vb0, pa0, pa1, pa2, pa3);
    MASKT(pB0, pB1, NT - 1); partialSM(pB0, pB1, m_reg, mnB, alB); RESC(alB);
    finishSM(pB0, pB1, alB, l_reg, pa0, pa1, pa2, pa3); SBAR(); pv_tile<1>(o, vb0, pa0, pa1, pa2, pa3);
    if (hi == 0) li_l[r32] = l_reg; asm volatile("s_waitcnt lgkmcnt(0)" ::: "memory");
    float rli[16];
#pragma unroll
    for (int r = 0; r < 16; ++r) rli[r] = __builtin_amdgcn_rcpf(li_l[crow(r, hi)]);
    float* X = (float*)(lds + OFF_X) + wq * 4096;
    if (comp == 1) {
        const float lam = ((const float*)(P.ws + WS_CTL))[CT_LAM];
#pragma unroll
        for (int d0 = 0; d0 < 4; ++d0)
#pragma unroll
            for (int r = 0; r < 16; ++r) X[(d0 * 16 + r) * 64 + lane] = o[d0][r] * rli[r] * lam;
    }
    __syncthreads();
    if (comp == 0) {
        float ss[16];
#pragma unroll
        for (int r = 0; r < 16; ++r) { float s = 0.f;
#pragma unroll
            for (int d0 = 0; d0 < 4; ++d0) { const float v = o[d0][r] * rli[r] - X[(d0 * 16 + r) * 64 + lane]; o[d0][r] = v; s += v * v; }
            ss[r] = s; }
#pragma unroll
        for (int r = 0; r < 16; ++r) { float s = ss[r]; s += __shfl_xor(s, 1); s += __shfl_xor(s, 2); s += __shfl_xor(s, 4); s += __shfl_xor(s, 8); s += __shfl_xor(s, 16);
            ss[r] = (1.0f - LAMBDA_INIT) / sqrtf(s * (1.0f / HD) + SUBLN_EPS); }
        const bf16_t* DG = (const bf16_t*)(P.ws + WS_DG) + h * HD; bf16_t* MIX = (bf16_t*)(P.ws + WS_MIX) + DH + h * HD;
        float nw[4];
#pragma unroll
        for (int d0 = 0; d0 < 4; ++d0) nw[d0] = P.diff_norm_w[d0 * 32 + r32];
#pragma unroll
        for (int r = 0; r < 16; ++r) { const int t = qlo + crow(r, hi);
#pragma unroll
            for (int d0 = 0; d0 < 4; ++d0) { const int d = d0 * 32 + r32;
                const float y = o[d0][r] * ss[r] * nw[d0] * bf2f(DG[(size_t)t * DH + d]);
                const float yn = __shfl_xor(y, 1);
                if ((r32 & 1) == 0) *(unsigned*)(MIX + (size_t)t * DM + d) = pk2(y, yn); } }
    }
    __syncthreads();
#undef ROWP
#undef VMW
#undef SLOAD
#undef SWRITE
#undef RESC
#undef KBASE
#undef MASKT
#undef HALF_STEP
}
__device__ __forceinline__ void attn_phase(const Params& P, int vcu, int nblk, char* lds) {
    for (int it = vcu; it < 256; it += nblk) { const int h = it >> 6, j = it & 63; attn_unit(P, h, 127 - j, lds); attn_unit(P, h, j, lds); }
}
#undef KSWZ
#undef SBAR
}

namespace hg {
typedef short bf16x8 __attribute__((ext_vector_type(8)));
typedef short s16x4 __attribute__((ext_vector_type(4)));
typedef float f32x16 __attribute__((ext_vector_type(16)));
typedef __attribute__((address_space(3))) unsigned char lds_u8;
constexpr int RS_Q = 272, RS_T = 320, RS_P = 144, RS_O = 528;
constexpr int OFF_QT = 0, OFF_KT = 17408, OFF_OO = 0, OFF_KH = 34816, OFF_VV = 55296, OFF_ST = 75776, OFF_PP = 110592, OFF_GT = 119808, OFF_BM = 123904, OFF_BL = 124416, LDS_BYTES = 124928;
__device__ __forceinline__ int crow(int r, int hi) { return (r & 3) + 8 * (r >> 2) + 4 * hi; }
__device__ __forceinline__ bf16x8 ld128(const lds_u8* p) { return *(const __attribute__((address_space(3))) bf16x8*)p; }
typedef short v4i16_t __attribute__((ext_vector_type(4)));
__device__ __forceinline__ s16x4 vtr(const lds_u8* p) { return __builtin_bit_cast(s16x4, __builtin_amdgcn_ds_read_tr16_b64_v4i16((__attribute__((address_space(3))) v4i16_t*)p)); }
__device__ __forceinline__ bf16x8 tr_frag(const lds_u8* base, int RS, int kbase, int nbase, int lane) {
    const lds_u8* p = base + (kbase + 8 * (lane >> 5) + ((lane & 15) >> 2)) * RS + (nbase + 16 * ((lane >> 4) & 1) + 4 * (lane & 3)) * 2;
    const s16x4 lo = vtr(p), hi = vtr(p + 4 * RS);
    return (bf16x8){lo[0], lo[1], lo[2], lo[3], hi[0], hi[1], hi[2], hi[3]};
}
#define MFMA32(a, b, c) __builtin_amdgcn_mfma_f32_32x32x16_bf16((a), (b), (c), 0, 0, 0)

template <bool FULL>
__device__ __forceinline__ void chunk_prep(const Params& P, int h, int tc, lds_u8* lds, float& bs0, float& bs1) {
    const int tid = threadIdx.x, d2 = tid & 63, rg = tid >> 6;
    const float* Gp = (const float*)(P.ws + WS_G) + (size_t)(tc + 8 * rg) * DH + h * HD + 2 * d2;
    const bf16_t* Qp = (const bf16_t*)(P.ws + WS_HQ) + (size_t)(tc + 8 * rg) * DH + h * HD + 2 * d2;
    const bf16_t* Vp = (const bf16_t*)(P.ws + WS_HI) + (size_t)(tc + (tid >> 4)) * DH + h * HD + (tid & 15) * 8;
    f32x2 g[8]; unsigned qraw[8];
#pragma unroll
    for (int i = 0; i < 8; ++i) { g[i] = *(const f32x2*)(Gp + (size_t)i * DH); if (FULL) qraw[i] = *(const unsigned*)(Qp + (size_t)i * DH); }
    const u32x4 va = *(const u32x4*)Vp, vb = *(const u32x4*)(Vp + (size_t)32 * DH);
    f32x2 cs[8]; float c0 = 0.f, c1 = 0.f;
#pragma unroll
    for (int i = 0; i < 8; ++i) { c0 += g[i].x; c1 += g[i].y; cs[i] = (f32x2){c0, c1}; }
    __attribute__((address_space(3))) float* GT = (__attribute__((address_space(3))) float*)(lds + OFF_GT);
    *(__attribute__((address_space(3))) f32x2*)(GT + rg * 128 + 2 * d2) = (f32x2){c0, c1};
    *(__attribute__((address_space(3))) u32x4*)(lds + OFF_VV + (tid >> 4) * RS_T + (tid & 15) * 16) = va;
    *(__attribute__((address_space(3))) u32x4*)(lds + OFF_VV + ((tid >> 4) + 32) * RS_T + (tid & 15) * 16) = vb;
    __syncthreads();
    float p0 = 0.f, p1 = 0.f, m0 = 0.f, m1 = 0.f, t0 = 0.f, t1 = 0.f;
#pragma unroll
    for (int j = 0; j < 8; ++j) { const f32x2 t = *(__attribute__((address_space(3))) f32x2*)(GT + j * 128 + 2 * d2);
        if (j < rg) { p0 += t.x; p1 += t.y; } if (j < 4) { m0 += t.x; m1 += t.y; } t0 += t.x; t1 += t.y; }
    if (rg == 0) { *(__attribute__((address_space(3))) f32x2*)(lds + OFF_BM + d2 * 8) = (f32x2){m0, m1}; *(__attribute__((address_space(3))) f32x2*)(lds + OFF_BL + d2 * 8) = (f32x2){t0, t1}; }
    bs0 += t0; bs1 += t1;
#pragma unroll
    for (int i = 0; i < 8; ++i) {
        const int row = 8 * rg + i; const float b0 = p0 + cs[i].x, b1 = p1 + cs[i].y;
        const float k0 = 1.0f - __expf(g[i].x), k1 = 1.0f - __expf(g[i].y);
        *(__attribute__((address_space(3))) unsigned*)(lds + OFF_KH + row * RS_T + d2 * 4) = pk2(k0 * __expf(t0 - b0), k1 * __expf(t1 - b1));
        if (FULL) {
            const float q0 = __uint_as_float(qraw[i] << 16), q1 = __uint_as_float(qraw[i] & 0xffff0000u);
            *(__attribute__((address_space(3))) unsigned*)(lds + OFF_QT + row * RS_Q + d2 * 4) = pk2(q0 * __expf(b0 - m0), q1 * __expf(b1 - m1));
            *(__attribute__((address_space(3))) unsigned*)(lds + OFF_KT + row * RS_Q + d2 * 4) = pk2(k0 * __expf(m0 - b0), k1 * __expf(m1 - b1));
        }
    }
    __syncthreads();
}
__device__ __forceinline__ void state_update(lds_u8* lds, f32x16 (&S)[2], int w, int lane) {
    const int db = w >> 1, hi = lane >> 5;
    const __attribute__((address_space(3))) float* BL = (const __attribute__((address_space(3))) float*)(lds + OFF_BL);
#pragma unroll
    for (int g4 = 0; g4 < 4; ++g4) { const f32x4 bl = *(const __attribute__((address_space(3))) f32x4*)(BL + 32 * db + 8 * g4 + 4 * hi);
#pragma unroll
        for (int q = 0; q < 4; ++q) { const float f = __expf(bl[q]); S[0][4 * g4 + q] *= f; S[1][4 * g4 + q] *= f; } }
#pragma unroll
    for (int ks = 0; ks < 4; ++ks) {
        const bf16x8 a = tr_frag(lds + OFF_KH, RS_T, 16 * ks, 32 * db, lane);
        const bf16x8 b0 = tr_frag(lds + OFF_VV, RS_T, 16 * ks, 32 * (2 * (w & 1)), lane), b1 = tr_frag(lds + OFF_VV, RS_T, 16 * ks, 32 * (2 * (w & 1) + 1), lane);
        S[0] = MFMA32(a, b0, S[0]); S[1] = MFMA32(a, b1, S[1]);
    }
}
__device__ __forceinline__ float* us_ptr(const Params& P, int sc, int h, int w, int j, int lane) {
    return (float*)(P.ws + WS_US) + ((size_t)(sc * NH + h) * HD + 32 * (w >> 1)) * HD + 32 * (2 * (w & 1) + j) + (lane & 31);
}
__device__ __forceinline__ void local_item(const Params& P, int sc, int h, lds_u8* lds) {
    const int tid = threadIdx.x, w = __builtin_amdgcn_readfirstlane(tid >> 6), lane = tid & 63, hi = lane >> 5;
    f32x16 S[2] = {}; float bs0 = 0.f, bs1 = 0.f;
    for (int c = 0; c < 4; ++c) {
        chunk_prep<false>(P, h, sc * 256 + c * 64, lds, bs0, bs1);
        state_update(lds, S, w, lane);
        __syncthreads();
    }
#pragma unroll
    for (int j = 0; j < 2; ++j) { float* up = us_ptr(P, sc, h, w, j, lane);
#pragma unroll
        for (int r = 0; r < 16; ++r) up[(size_t)crow(r, hi) * HD] = S[j][r]; }
    if (tid < 64) *(f32x2*)((float*)(P.ws + WS_BS) + (size_t)(sc * NH + h) * HD + 2 * tid) = (f32x2){bs0, bs1};
}
__device__ __forceinline__ void local_phase(const Params& P, int vcu, int nblk, lds_u8* lds) { for (int it = vcu; it < 256; it += nblk) local_item(P, it >> 2, it & 3, lds); }
__device__ __forceinline__ void scan_phase(const Params& P, int bid, int nblk) {
    const int tid = threadIdx.x; if (tid >= 256) return;
    float* US = (float*)(P.ws + WS_US); const float* BS = (const float*)(P.ws + WS_BS);
    for (int i = bid * 256 + tid; i < NH * HD * HD; i += nblk * 256) {
        const int hd = i >> 7; float s = 0.f;
        for (int sc0 = 0; sc0 < 64; sc0 += 8) {
            float u[8], a[8];
#pragma unroll
            for (int k = 0; k < 8; ++k) { u[k] = US[(size_t)(sc0 + k) * (NH * HD * HD) + i]; a[k] = BS[(size_t)(sc0 + k) * (NH * HD) + hd]; }
#pragma unroll
            for (int k = 0; k < 8; ++k) { US[(size_t)(sc0 + k) * (NH * HD * HD) + i] = s; s = __expf(a[k]) * s + u[k]; }
        }
    }
}
__device__ __forceinline__ void out_item(const Params& P, int sc, int h, lds_u8* lds) {
    const int tid = threadIdx.x, w = __builtin_amdgcn_readfirstlane(tid >> 6), lane = tid & 63, r32 = lane & 31, hi = lane >> 5;
    f32x16 S[2]; float bs0 = 0.f, bs1 = 0.f;
#pragma unroll
    for (int j = 0; j < 2; ++j) { const float* up = us_ptr(P, sc, h, w, j, lane);
#pragma unroll
        for (int r = 0; r < 16; ++r) S[j][r] = up[(size_t)crow(r, hi) * HD]; }
    const int tb = w >> 2, eb = w & 3, db = w >> 1;
    for (int c = 0; c < 4; ++c) {
        const int tc = sc * 256 + c * 64;
        chunk_prep<true>(P, h, tc, lds, bs0, bs1);
        { const __attribute__((address_space(3))) float* BM = (const __attribute__((address_space(3))) float*)(lds + OFF_BM);
#pragma unroll
          for (int g4 = 0; g4 < 4; ++g4) { const int d0 = 32 * db + 8 * g4 + 4 * hi; const f32x4 bm = *(const __attribute__((address_space(3))) f32x4*)(BM + d0);
              const float f0 = __expf(bm[0]), f1 = __expf(bm[1]), f2 = __expf(bm[2]), f3 = __expf(bm[3]);
#pragma unroll
              for (int j = 0; j < 2; ++j) { const int e = 32 * (2 * (w & 1) + j) + r32;
                  *(__attribute__((address_space(3))) u32x2*)(lds + OFF_ST + e * RS_Q + d0 * 2) = (u32x2){pk2(S[j][4 * g4] * f0, S[j][4 * g4 + 1] * f1), pk2(S[j][4 * g4 + 2] * f2, S[j][4 * g4 + 3] * f3)}; } } }
        if (w < 3) {
            const int sb = (w == 2) ? 1 : 0, tb2 = (w >= 1) ? 1 : 0; f32x16 acc = {};
#pragma unroll
            for (int ks = 0; ks < 8; ++ks) { const bf16x8 a = ld128(lds + OFF_KT + (32 * sb + r32) * RS_Q + (16 * ks + 8 * hi) * 2), b = ld128(lds + OFF_QT + (32 * tb2 + r32) * RS_Q + (16 * ks + 8 * hi) * 2);
                acc = MFMA32(a, b, acc); }
            const int t = 32 * tb2 + r32;
#pragma unroll
            for (int g4 = 0; g4 < 4; ++g4) { const int s0 = 32 * sb + 8 * g4 + 4 * hi; float v[4];
#pragma unroll
                for (int q = 0; q < 4; ++q) v[q] = (s0 + q <= t) ? acc[4 * g4 + q] : 0.f;
                *(__attribute__((address_space(3))) u32x2*)(lds + OFF_PP + t * RS_P + s0 * 2) = (u32x2){pk2(v[0], v[1]), pk2(v[2], v[3])}; }
        }
        __syncthreads();
        f32x16 o = {};
#pragma unroll
        for (int ks = 0; ks < 8; ++ks) { const bf16x8 a = ld128(lds + OFF_QT + (32 * tb + r32) * RS_Q + (16 * ks + 8 * hi) * 2), b = ld128(lds + OFF_ST + (32 * eb + r32) * RS_Q + (16 * ks + 8 * hi) * 2);
            o = MFMA32(a, b, o); }
#pragma unroll
        for (int ks = 0; ks < 4; ++ks) if (ks < 2 * (tb + 1)) { const bf16x8 a = ld128(lds + OFF_PP + (32 * tb + r32) * RS_P + (16 * ks + 8 * hi) * 2), b = tr_frag(lds + OFF_VV, RS_T, 16 * ks, 32 * eb, lane);
            o = MFMA32(a, b, o); }
        state_update(lds, S, w, lane);
        __syncthreads();
        { __attribute__((address_space(3))) float* OO = (__attribute__((address_space(3))) float*)(lds + OFF_OO);
#pragma unroll
          for (int r = 0; r < 16; ++r) OO[(32 * tb + crow(r, hi)) * (RS_O / 4) + 32 * eb + r32] = o[r]; }
        __syncthreads();
        { const int t = tid >> 3, e0 = (tid & 7) * 16; const __attribute__((address_space(3))) f32x4* orow = (const __attribute__((address_space(3))) f32x4*)(lds + OFF_OO + t * RS_O + e0 * 4);
          f32x4 v[4]; float ss = 0.f;
#pragma unroll
          for (int k = 0; k < 4; ++k) { v[k] = orow[k]; ss += (v[k].x * v[k].x + v[k].y * v[k].y) + (v[k].z * v[k].z + v[k].w * v[k].w); }
          ss += __shfl_xor(ss, 1); ss += __shfl_xor(ss, 2); ss += __shfl_xor(ss, 4);
          const float rs = 1.0f / sqrtf(ss * (1.0f / HD) + NORM_EPS);
          const bf16_t* hgp = (const bf16_t*)(P.ws + WS_HG) + (size_t)(tc + t) * DH + h * HD + e0; const u32x4 ga = *(const u32x4*)hgp, gb = *(const u32x4*)(hgp + 8);
          const f32x4* nw = (const f32x4*)(P.hgrn_norm_w + e0); float y[16];
#pragma unroll
          for (int k = 0; k < 4; ++k) { const f32x4 n4 = nw[k]; const unsigned g01 = (k < 2) ? ga[2 * k] : gb[2 * (k - 2)], g23 = (k < 2) ? ga[2 * k + 1] : gb[2 * (k - 2) + 1];
              y[4 * k] = v[k].x * rs * n4.x * __uint_as_float(g01 << 16); y[4 * k + 1] = v[k].y * rs * n4.y * __uint_as_float(g01 & 0xffff0000u);
              y[4 * k + 2] = v[k].z * rs * n4.z * __uint_as_float(g23 << 16); y[4 * k + 3] = v[k].w * rs * n4.w * __uint_as_float(g23 & 0xffff0000u); }
          bf16_t* mp = (bf16_t*)(P.ws + WS_MIX) + (size_t)(tc + t) * DM + h * HD + e0;
          *(u32x4*)mp = (u32x4){pk2(y[0], y[1]), pk2(y[2], y[3]), pk2(y[4], y[5]), pk2(y[6], y[7])};
          *(u32x4*)(mp + 8) = (u32x4){pk2(y[8], y[9]), pk2(y[10], y[11]), pk2(y[12], y[13]), pk2(y[14], y[15])}; }
        __syncthreads();
    }
}
__device__ __forceinline__ void out_phase(const Params& P, int vcu, int nblk, lds_u8* lds) { for (int it = vcu; it < 256; it += nblk) out_item(P, it >> 2, it & 3, lds); }
#undef MFMA32
}

#include <hip/hip_cooperative_groups.h>
namespace cg = cooperative_groups;
constexpr int NWAVES = 8;
constexpr int LDS_BYTES = 147456;
constexpr int N_PHASES = 7;
struct Args { Params P; int ph_lo, ph_hi, flags, pad; };

__device__ __forceinline__ void final_norm_phase(const Params& P, int bid, int nblk) {
    const int lane = threadIdx.x & 63, wave = threadIdx.x >> 6, gw = bid * NWAVES + wave, ngw = nblk * NWAVES;
    const float* rowsq = (const float*)(P.ws + WS_CTL) + CT_ROWSQ;
    for (int m = gw; m < T; m += ngw) {
        f32x4* yr = (f32x4*)(P.out + (size_t)m * DM) + lane; const f32x4* wr = (const f32x4*)P.final_norm_w + lane;
        const float rstd = 1.0f / sqrtf(rowsq[m] * (1.0f / DM) + NORM_EPS);
#pragma unroll
        for (int j = 0; j < 4; ++j) { const f32x4 v = yr[64 * j], w = wr[64 * j]; yr[64 * j] = (f32x4){v.x * rstd * w.x, v.y * rstd * w.y, v.z * rstd * w.z, v.w * rstd * w.w}; }
    }
}

__global__ void __launch_bounds__(NWAVES * 64, 2) mk_fwd(Args a) {
    extern __shared__ __attribute__((aligned(16))) unsigned char lds[];
    cg::grid_group grid = cg::this_grid();
    const Params& P = a.P;
    const int G = gridDim.x, bx = blockIdx.x;
    const int vcu = (G % 8 == 0) ? (bx % 8) * (G / 8) + bx / 8 : bx;
    const int lo = a.ph_lo, hi = a.ph_hi;
#define IN(k) (lo <= (k) && (k) < hi)
#define SEAM(k) do { if (IN(k) && IN((k) + 1)) grid.sync(); } while (0)
    if (IN(0)) {
        prologue_phase(P, bx, G, (float*)lds);
        float* rowsq = (float*)(P.ws + WS_CTL) + CT_ROWSQ;
        for (int i = bx * (NWAVES * 64) + threadIdx.x; i < T; i += G * NWAVES * 64) rowsq[i] = 0.f;
    }
    SEAM(0);
    if (IN(1)) {
        pg8::Gemm g{(const bf16_t*)(P.ws + WS_XN), (const bf16_t*)(P.ws + WS_WIN), T, DIN, DM}; pg8::StaticOrder S; S.init(T, DIN, G, bx);
        EpiIn E{P};
        pg8::gemm_phase<EpiIn, pg8::StaticOrder, true, true>((PG8_LAS unsigned char*)lds, g, S, E);
    }
    SEAM(1);
    if (IN(2)) hg::local_phase(P, vcu, G, (hg::lds_u8*)lds);
    SEAM(2);
    if (IN(3)) hg::scan_phase(P, bx, G);
    SEAM(3);
    if (IN(4)) { att::attn_phase(P, vcu, G, (char*)lds); hg::out_phase(P, vcu, G, (hg::lds_u8*)lds); }
    SEAM(4);
    if (IN(5)) {
        pg8::Gemm g{(const bf16_t*)(P.ws + WS_MIX), (const bf16_t*)(P.ws + WS_WOUT), T, DM, DM}; pg8::StaticOrder S; S.init(T, DM, G, bx);
        EpiOut E{P};
        pg8::gemm_phase<EpiOut, pg8::StaticOrder, false, true>((PG8_LAS unsigned char*)lds, g, S, E);
    }
    SEAM(5);
    if (IN(6)) final_norm_phase(P, bx, G);
#undef IN
#undef SEAM
}

static int g_grid = 0;
static void launch_phases(const Params& P, int lo, int hi, hipStream_t stream) {
    Args a{}; a.P = P; a.ph_lo = lo; a.ph_hi = hi; a.flags = 0; a.pad = 0;
    void* args[] = {&a};
    hipError_t e = hipLaunchCooperativeKernel((const void*)mk_fwd, dim3(g_grid), dim3(NWAVES * 64), args, LDS_BYTES, stream);
    if (e != hipSuccess) fprintf(stderr, "kernel_launch: cooperative launch [%d,%d) failed: %s (grid %d)\n", lo, hi, hipGetErrorString(e), g_grid);
}

extern "C" void kernel_launch(void* const* d_in, const int* in_sizes, int n_in, void* d_out, int out_size, void* d_ws, size_t ws_size, hipStream_t stream) {
    if (n_in != 12 || in_sizes[0] != T * DM || out_size != T * DM || ws_size < 256 * MiB) { fprintf(stderr, "kernel_launch: unexpected shapes (n_in %d in0 %d out %d ws %zu)\n", n_in, n_in > 0 ? in_sizes[0] : -1, out_size, ws_size); return; }
    if (g_grid == 0) {
        int dev = 0, cus = 0, per_cu = 0;
        if (hipGetDevice(&dev) != hipSuccess || hipDeviceGetAttribute(&cus, hipDeviceAttributeMultiprocessorCount, dev) != hipSuccess) { fprintf(stderr, "kernel_launch: device query failed\n"); g_grid = -1; return; }
        if (hipFuncSetAttribute((const void*)mk_fwd, hipFuncAttributeMaxDynamicSharedMemorySize, LDS_BYTES) != hipSuccess) { fprintf(stderr, "kernel_launch: hipFuncSetAttribute failed\n"); g_grid = -1; return; }
        if (hipOccupancyMaxActiveBlocksPerMultiprocessor(&per_cu, (const void*)mk_fwd, NWAVES * 64, LDS_BYTES) != hipSuccess || per_cu < 1) { fprintf(stderr, "kernel_launch: occupancy query says %d blocks per CU\n", per_cu); per_cu = 1; }
        (void)hipGetLastError();
        g_grid = cus * (per_cu < 1 ? 1 : 1);
    }
    if (g_grid < 0) return;
    Params P{};
    P.x = (const float*)d_in[0]; P.norm_w = (const float*)d_in[1]; P.w_in = (const float*)d_in[2]; P.lb_logits = (const float*)d_in[3]; P.hgrn_norm_w = (const float*)d_in[4];
    P.lq1 = (const float*)d_in[5]; P.lk1 = (const float*)d_in[6]; P.lq2 = (const float*)d_in[7]; P.lk2 = (const float*)d_in[8]; P.diff_norm_w = (const float*)d_in[9];
    P.w_out = (const float*)d_in[10]; P.final_norm_w = (const float*)d_in[11]; P.out = (float*)d_out; P.ws = (unsigned char*)d_ws;
    launch_phases(P, 0, N_PHASES, stream);
}
```

```cpp
#include <hip/hip_runtime.h>
#include <cstdio>
#include <cstdint>

typedef unsigned short bf16_t;
typedef float f32x4 __attribute__((ext_vector_type(4)));
typedef float f32x2 __attribute__((ext_vector_type(2)));
typedef unsigned u32x4 __attribute__((ext_vector_type(4)));
typedef unsigned u32x2 __attribute__((ext_vector_type(2)));
typedef __bf16 bf16x2_t __attribute__((ext_vector_type(2)));

constexpr int T = 16384, DM = 1024, DIN = 4096, DH = 512;
constexpr int NH = 4, HD = 128;
constexpr float NORM_EPS = 1e-6f, SUBLN_EPS = 1e-5f;
constexpr float LAMBDA_INIT = 0.2f;
constexpr float QSCALE = 0.125f * 1.4426950408889634f;

constexpr size_t MiB = 1u << 20;
constexpr size_t WS_CTL = 0;
constexpr size_t WS_COS = 1 * MiB, WS_SIN = 3 * MiB;
constexpr size_t WS_WOUT = 5 * MiB;
constexpr size_t WS_WIN = 8 * MiB;
constexpr size_t WS_XN = 16 * MiB;
constexpr size_t WS_MIX = 16 * MiB;
constexpr size_t WS_HQ = 48 * MiB;
constexpr size_t WS_G = 64 * MiB;
constexpr size_t WS_HI = 96 * MiB;
constexpr size_t WS_HG = 112 * MiB;
constexpr size_t WS_DQ = 128 * MiB;
constexpr size_t WS_DK = 144 * MiB;
constexpr size_t WS_DV = 160 * MiB;
constexpr size_t WS_DG = 176 * MiB;
constexpr size_t WS_US = 192 * MiB;
constexpr size_t WS_BS = 208 * MiB;
constexpr size_t WS_OTMP = 210 * MiB;
constexpr int CT_LAM = 16;
constexpr int CT_LB = 1024;
constexpr int CT_ROWSQ = 16384;

struct Params {
    const float* x; const float* norm_w; const float* w_in; const float* lb_logits; const float* hgrn_norm_w;
    const float* lq1; const float* lk1; const float* lq2; const float* lk2; const float* diff_norm_w; const float* w_out; const float* final_norm_w;
    float* out; unsigned char* ws;
};

__device__ __forceinline__ float bf2f(bf16_t h) { return __uint_as_float((unsigned)h << 16); }
__device__ __forceinline__ unsigned pk2(float lo, float hi) { f32x2 v = {lo, hi}; bf16x2_t b = __builtin_convertvector(v, bf16x2_t); return __builtin_bit_cast(unsigned, b); }
__device__ __forceinline__ bf16_t f2bf(float f) { return (bf16_t)(pk2(f, 0.f) & 0xffffu); }
__device__ __forceinline__ float wave_sum(float v) {
#pragma unroll
    for (int o = 1; o < 64; o <<= 1) v += __shfl_xor(v, o);
    return v;
}
__device__ __forceinline__ float sigmoidf_(float v) { return 1.0f / (1.0f + __expf(-v)); }
__device__ __forceinline__ float siluf_(float v) { return v / (1.0f + __expf(-v)); }

__host__ __device__ __forceinline__ int win_orig_col(int np) {
    if (np < 2048 || np >= 3072) return np;
    const int base = np & ~63, p = np & 63;
    return base + (p >> 1) + 32 * (p & 1);
}

__device__ __forceinline__ void epi8(const Params& P, int type, int t, int c, const float* v) {
    unsigned char* ws = P.ws;
    const size_t off = (size_t)t * DH + c;
    if (type == 1) {
        const float* lb = (const float*)(ws + WS_CTL) + CT_LB + c;
        float g[8];
#pragma unroll
        for (int j = 0; j < 8; ++j) { const float l = lb[j]; const float f = l + (1.0f - l) * sigmoidf_(v[j]); g[j] = __logf(f); }
        float* G = (float*)(ws + WS_G) + off;
        *(f32x4*)G = (f32x4){g[0], g[1], g[2], g[3]}; *(f32x4*)(G + 4) = (f32x4){g[4], g[5], g[6], g[7]};
        return;
    }
    float o[8];
    size_t base;
    if (type == 3 || type == 7) {
#pragma unroll
        for (int j = 0; j < 8; ++j) o[j] = siluf_(v[j]);
        base = (type == 3) ? WS_HG : WS_DG;
    } else if (type == 4 || type == 5) {
        const int i0 = (c & 63) >> 1;
        const f32x4 cs = *(const f32x4*)((const float*)(ws + WS_COS) + (size_t)t * 32 + i0);
        const f32x4 sn = *(const f32x4*)((const float*)(ws + WS_SIN) + (size_t)t * 32 + i0);
        const float sc = (type == 4) ? QSCALE : 1.0f;
#pragma unroll
        for (int j = 0; j < 4; ++j) { const float x1 = v[2 * j], x2 = v[2 * j + 1];
            o[2 * j] = (x1 * cs[j] - x2 * sn[j]) * sc; o[2 * j + 1] = (x2 * cs[j] + x1 * sn[j]) * sc; }
        base = (type == 4) ? WS_DQ : WS_DK;
    } else {
#pragma unroll
        for (int j = 0; j < 8; ++j) o[j] = v[j];
        base = (type == 0) ? WS_HQ : (type == 2) ? WS_HI : WS_DV;
    }
    u32x4 w = {pk2(o[0], o[1]), pk2(o[2], o[3]), pk2(o[4], o[5]), pk2(o[6], o[7])};
    *(u32x4*)((bf16_t*)(ws + base) + off) = w;
}

__device__ __forceinline__ void prologue_phase(const Params& P, int bid, int nblk, float* scr  ) {
    const int tid = threadIdx.x, lane = tid & 63, wave = tid >> 6, nwv = blockDim.x >> 6;
    const int gw = bid * nwv + wave, NGW = nblk * nwv;
    unsigned char* ws = P.ws;
    if (bid == 0 && wave == 0) {
        float a = P.lq1[lane] * P.lk1[lane], b = P.lq2[lane] * P.lk2[lane];
        a = wave_sum(a); b = wave_sum(b);
        if (lane == 0) ((float*)(ws + WS_CTL))[CT_LAM] = __expf(a) - __expf(b) + LAMBDA_INIT;
    }
    if (bid == 0) {
        for (int c = tid; c < DH; c += blockDim.x) { const float l0 = P.lb_logits[c], l1 = P.lb_logits[DH + c]; ((float*)(ws + WS_CTL))[CT_LB + c] = 1.0f / (1.0f + __expf(l1 - l0)); }
    }
    for (int idx = bid * blockDim.x + tid; idx < T * 32; idx += nblk * blockDim.x) {
        const int t = idx >> 5, i = idx & 31;
        const float invf = 1.0f / exp2f((float)i * (13.287712379549449f / 32.0f));
        const float ang = (float)t * invf;
        const double rev = (double)ang * 0.15915494309189535;
        const float fr = (float)(rev - __builtin_rint(rev));
        ((float*)(ws + WS_COS))[idx] = __builtin_amdgcn_cosf(fr);
        ((float*)(ws + WS_SIN))[idx] = __builtin_amdgcn_sinf(fr);
    }
    float* s = scr + wave * (64 * 33);
    constexpr int I_IN = (DM / 64) * (DIN / 32), I_OUT = (DM / 64) * (DM / 32);
    for (int it = gw; it < I_IN + I_OUT; it += NGW) {
        const bool isin = it < I_IN; const int r = isin ? it : it - I_IN;
        const float* W = isin ? P.w_in : P.w_out; const int N = isin ? DIN : DM;
        bf16_t* WT = (bf16_t*)(ws + (isin ? WS_WIN : WS_WOUT));
        const int nblkn = N / 32, kb = r / nblkn, nb = r % nblkn, k0 = 64 * kb, n0 = 32 * nb;
        const int ncol = isin ? win_orig_col(n0 + (lane & 31)) : n0 + (lane & 31);
#pragma unroll 8
        for (int i = 0; i < 32; ++i) { const int kk = 2 * i + (lane >> 5); s[kk * 33 + (lane & 31)] = W[(size_t)(k0 + kk) * N + ncol]; }
        __builtin_amdgcn_wave_barrier(); asm volatile("s_waitcnt lgkmcnt(0)" ::: "memory");
        const int c = lane & 7;
#pragma unroll
        for (int j = 0; j < 4; ++j) { const int n = (lane >> 3) + 8 * j; const float* q = s + (8 * c) * 33 + n;
            u32x4 o; o.x = pk2(q[0 * 33], q[1 * 33]); o.y = pk2(q[2 * 33], q[3 * 33]); o.z = pk2(q[4 * 33], q[5 * 33]); o.w = pk2(q[6 * 33], q[7 * 33]);
            *(u32x4*)(WT + (size_t)(n0 + n) * DM + k0 + 8 * c) = o; }
        __builtin_amdgcn_wave_barrier(); asm volatile("s_waitcnt lgkmcnt(0)" ::: "memory");
    }
    for (int m = gw; m < T; m += NGW) {
        const f32x4* xr = (const f32x4*)(P.x + (size_t)m * DM) + lane; const f32x4* wr = (const f32x4*)P.norm_w + lane;
        f32x4 v[4]; float ss = 0.f;
#pragma unroll
        for (int j = 0; j < 4; ++j) { v[j] = xr[64 * j]; ss += (v[j].x * v[j].x + v[j].y * v[j].y) + (v[j].z * v[j].z + v[j].w * v[j].w); }
        const float rstd = 1.0f / sqrtf(wave_sum(ss) * (1.0f / DM) + NORM_EPS);
        u32x2* o8 = (u32x2*)((bf16_t*)(ws + WS_XN) + (size_t)m * DM) + lane;
#pragma unroll
        for (int j = 0; j < 4; ++j) { const f32x4 w = wr[64 * j]; u32x2 o; o.x = pk2(v[j].x * rstd * w.x, v[j].y * rstd * w.y); o.y = pk2(v[j].z * rstd * w.z, v[j].w * rstd * w.w); o8[64 * j] = o; }
    }
}

__global__ void __launch_bounds__(512) k_prologue(Params P) {
    __shared__ float scr[8 * 64 * 33];
    prologue_phase(P, blockIdx.x, gridDim.x, scr);
}

__global__ void __launch_bounds__(256) k_naive_gemm_in(Params P) {
    __shared__ float As[64][33], Bs[64][33];
    const bf16_t* A = (const bf16_t*)(P.ws + WS_XN); const bf16_t* B = (const bf16_t*)(P.ws + WS_WIN);
    const int tid = threadIdx.x, ty = tid >> 3, tx = tid & 7, m0 = blockIdx.y * 64, n0 = blockIdx.x * 64;
    float acc[2][8] = {};
    const int lr = tid >> 2, lk = (tid & 3) * 8;
    for (int k0 = 0; k0 < DM; k0 += 32) {
        const u32x4 a = *(const u32x4*)(A + (size_t)(m0 + lr) * DM + k0 + lk), b = *(const u32x4*)(B + (size_t)(n0 + lr) * DM + k0 + lk);
#pragma unroll
        for (int j = 0; j < 4; ++j) { As[lr][lk + 2 * j] = __uint_as_float(a[j] << 16); As[lr][lk + 2 * j + 1] = __uint_as_float(a[j] & 0xffff0000u);
            Bs[lr][lk + 2 * j] = __uint_as_float(b[j] << 16); Bs[lr][lk + 2 * j + 1] = __uint_as_float(b[j] & 0xffff0000u); }
        __syncthreads();
#pragma unroll 8
        for (int k = 0; k < 32; ++k) { const float a0 = As[2 * ty][k], a1 = As[2 * ty + 1][k];
#pragma unroll
            for (int j = 0; j < 8; ++j) { const float bv = Bs[8 * tx + j][k]; acc[0][j] += a0 * bv; acc[1][j] += a1 * bv; } }
        __syncthreads();
    }
    const int nc = n0 + 8 * tx, type = nc >> 9, c = nc & 511;
    epi8(P, type, m0 + 2 * ty, c, acc[0]); epi8(P, type, m0 + 2 * ty + 1, c, acc[1]);
}

__global__ void __launch_bounds__(128) k_naive_hgrn(Params P) {
    __shared__ float qs[32][128], fs[32][128];
    const int h = blockIdx.x, e = threadIdx.x;
    const bf16_t* HQ = (const bf16_t*)(P.ws + WS_HQ); const float* G = (const float*)(P.ws + WS_G); const bf16_t* HI = (const bf16_t*)(P.ws + WS_HI);
    float* OT = (float*)(P.ws + WS_OTMP);
    float S[128];
#pragma unroll
    for (int d = 0; d < 128; ++d) S[d] = 0.f;
    for (int t0 = 0; t0 < T; t0 += 32) {
        for (int i = 0; i < 32; ++i) { qs[i][e] = bf2f(HQ[(size_t)(t0 + i) * DH + h * HD + e]); fs[i][e] = __expf(G[(size_t)(t0 + i) * DH + h * HD + e]); }
        __syncthreads();
        for (int i = 0; i < 32; ++i) {
            const float v = bf2f(HI[(size_t)(t0 + i) * DH + h * HD + e]); float o = 0.f;
#pragma unroll
            for (int d = 0; d < 128; ++d) { const float f = fs[i][d]; S[d] = f * S[d] + (1.0f - f) * v; o += qs[i][d] * S[d]; }
            OT[(size_t)(t0 + i) * DH + h * HD + e] = o;
        }
        __syncthreads();
    }
}
__global__ void __launch_bounds__(256) k_naive_hgrn_norm(Params P) {
    const int lane = threadIdx.x & 63, gw = (blockIdx.x * blockDim.x + threadIdx.x) >> 6, ngw = (gridDim.x * blockDim.x) >> 6;
    const float* OT = (const float*)(P.ws + WS_OTMP); const bf16_t* HG = (const bf16_t*)(P.ws + WS_HG); bf16_t* MIX = (bf16_t*)(P.ws + WS_MIX);
    for (int r = gw; r < T * NH; r += ngw) {
        const int t = r >> 2, h = r & 3; const size_t off = (size_t)t * DH + h * HD + 2 * lane;
        const float a = OT[off], b = OT[off + 1];
        const float rs = 1.0f / sqrtf(wave_sum(a * a + b * b) * (1.0f / HD) + NORM_EPS);
        const float y0 = a * rs * P.hgrn_norm_w[2 * lane] * bf2f(HG[off]), y1 = b * rs * P.hgrn_norm_w[2 * lane + 1] * bf2f(HG[off + 1]);
        *(unsigned*)(MIX + (size_t)t * DM + h * HD + 2 * lane) = pk2(y0, y1);
    }
}

__global__ void __launch_bounds__(256) k_naive_attn(Params P) {
    __shared__ float Kt[32][128], Vt[32][128];
    const int tid = threadIdx.x, tl = tid >> 2, vq = tid & 3, h = blockIdx.y, t0 = (gridDim.x - 1 - blockIdx.x) * 64, t = t0 + tl;
    const bf16_t* DQ = (const bf16_t*)(P.ws + WS_DQ); const bf16_t* DK = (const bf16_t*)(P.ws + WS_DK); const bf16_t* DV = (const bf16_t*)(P.ws + WS_DV);
    const bf16_t* DG = (const bf16_t*)(P.ws + WS_DG); bf16_t* MIX = (bf16_t*)(P.ws + WS_MIX);
    const float lam = ((const float*)(P.ws + WS_CTL))[CT_LAM];
    float q1[64], q2[64], o1[32], o2[32];
#pragma unroll
    for (int d = 0; d < 64; ++d) { q1[d] = bf2f(DQ[(size_t)t * DH + h * HD + d]); q2[d] = bf2f(DQ[(size_t)t * DH + h * HD + 64 + d]); }
#pragma unroll
    for (int j = 0; j < 32; ++j) { o1[j] = 0.f; o2[j] = 0.f; }
    float m1 = -1e30f, m2 = -1e30f, l1 = 0.f, l2 = 0.f;
    const int nt = (t0 + 64) / 32;
    for (int kt = 0; kt < nt; ++kt) {
        const int s0 = kt * 32;
        for (int i = tid; i < 32 * 128; i += 256) { const int r = i >> 7, c = i & 127; Kt[r][c] = bf2f(DK[(size_t)(s0 + r) * DH + h * HD + c]); Vt[r][c] = bf2f(DV[(size_t)(s0 + r) * DH + h * HD + c]); }
        __syncthreads();
        for (int s = 0; s < 32; ++s) {
            if (s0 + s <= t) {
                float a = 0.f, b = 0.f;
#pragma unroll
                for (int d = 0; d < 64; ++d) { a += q1[d] * Kt[s][d]; b += q2[d] * Kt[s][64 + d]; }
                { const float mn = fmaxf(m1, a), al = exp2f(m1 - mn), p = exp2f(a - mn); l1 = l1 * al + p; m1 = mn;
#pragma unroll
                  for (int j = 0; j < 32; ++j) o1[j] = o1[j] * al + p * Vt[s][vq * 32 + j]; }
                { const float mn = fmaxf(m2, b), al = exp2f(m2 - mn), p = exp2f(b - mn); l2 = l2 * al + p; m2 = mn;
#pragma unroll
                  for (int j = 0; j < 32; ++j) o2[j] = o2[j] * al + p * Vt[s][vq * 32 + j]; }
            }
        }
        __syncthreads();
    }
    const float i1 = 1.0f / l1, i2 = lam / l2; float ss = 0.f;
#pragma unroll
    for (int j = 0; j < 32; ++j) { o1[j] = o1[j] * i1 - o2[j] * i2; ss += o1[j] * o1[j]; }
    ss += __shfl_xor(ss, 1); ss += __shfl_xor(ss, 2);
    const float rs = (1.0f - LAMBDA_INIT) / sqrtf(ss * (1.0f / HD) + SUBLN_EPS);
#pragma unroll
    for (int j = 0; j < 32; j += 2) {
        const int c = vq * 32 + j;
        const float y0 = o1[j] * rs * P.diff_norm_w[c] * bf2f(DG[(size_t)t * DH + h * HD + c]), y1 = o1[j + 1] * rs * P.diff_norm_w[c + 1] * bf2f(DG[(size_t)t * DH + h * HD + c + 1]);
        *(unsigned*)(MIX + (size_t)t * DM + DH + h * HD + c) = pk2(y0, y1);
    }
}

__global__ void __launch_bounds__(256) k_naive_gemm_out(Params P) {
    __shared__ float As[64][33], Bs[32][65];
    const bf16_t* A = (const bf16_t*)(P.ws + WS_MIX);
    const int tid = threadIdx.x, ty = tid >> 3, tx = tid & 7, m0 = blockIdx.y * 64, n0 = blockIdx.x * 64;
    float acc[2][8] = {};
    const int lr = tid >> 2, lk = (tid & 3) * 8;
    for (int k0 = 0; k0 < DM; k0 += 32) {
        const u32x4 a = *(const u32x4*)(A + (size_t)(m0 + lr) * DM + k0 + lk);
#pragma unroll
        for (int j = 0; j < 4; ++j) { As[lr][lk + 2 * j] = __uint_as_float(a[j] << 16); As[lr][lk + 2 * j + 1] = __uint_as_float(a[j] & 0xffff0000u); }
        for (int i = tid; i < 32 * 64; i += 256) { const int kk = i >> 6, nn = i & 63; Bs[kk][nn] = P.w_out[(size_t)(k0 + kk) * DM + n0 + nn]; }
        __syncthreads();
#pragma unroll 8
        for (int k = 0; k < 32; ++k) { const float a0 = As[2 * ty][k], a1 = As[2 * ty + 1][k];
#pragma unroll
            for (int j = 0; j < 8; ++j) { const float bv = Bs[k][8 * tx + j]; acc[0][j] += a0 * bv; acc[1][j] += a1 * bv; } }
        __syncthreads();
    }
#pragma unroll
    for (int r = 0; r < 2; ++r) { const size_t off = (size_t)(m0 + 2 * ty + r) * DM + n0 + 8 * tx;
#pragma unroll
        for (int j = 0; j < 8; ++j) P.out[off + j] = P.x[off + j] + acc[r][j]; }
}
__global__ void __launch_bounds__(256) k_final_norm(Params P) {
    const int lane = threadIdx.x & 63, gw = (blockIdx.x * blockDim.x + threadIdx.x) >> 6, ngw = (gridDim.x * blockDim.x) >> 6;
    for (int m = gw; m < T; m += ngw) {
        f32x4* yr = (f32x4*)(P.out + (size_t)m * DM) + lane; const f32x4* wr = (const f32x4*)P.final_norm_w + lane;
        f32x4 v[4]; float ss = 0.f;
#pragma unroll
        for (int j = 0; j < 4; ++j) { v[j] = yr[64 * j]; ss += (v[j].x * v[j].x + v[j].y * v[j].y) + (v[j].z * v[j].z + v[j].w * v[j].w); }
        const float rstd = 1.0f / sqrtf(wave_sum(ss) * (1.0f / DM) + NORM_EPS);
#pragma unroll
        for (int j = 0; j < 4; ++j) { const f32x4 w = wr[64 * j]; yr[64 * j] = (f32x4){v[j].x * rstd * w.x, v[j].y * rstd * w.y, v[j].z * rstd * w.z, v[j].w * rstd * w.w}; }
    }
}


namespace pg8 {
#define PG8_LAS __attribute__((address_space(3)))
typedef short bf16x8 __attribute__((ext_vector_type(8)));
constexpr int BM = 256, BK = 64, HALF = 128, HTB = HALF * BK * 2  , STAGE_BYTES = 8 * HTB, NXCD = 8, WGM = 8;
__host__ __device__ __forceinline__ int lds_byte(int r, int c) { const int st = (r >> 4) * 2 + (c >> 5), rr = r & 15, cc = c & 31, ob = rr * 64 + cc * 2; return st * 1024 + (ob ^ (((ob >> 9) & 1) << 5)); }
__host__ __device__ __forceinline__ void stage_rc(int b, int& R, int& C) { const int st = b / 1024, sb = b % 1024, swz = sb ^ (((sb >> 9) & 1) << 5); R = (st >> 1) * 16 + swz / 64; C = (st & 1) * 32 + (swz % 64) / 2; }
__host__ __device__ __forceinline__ int perm32(int rho) { const int n = rho >> 4, i = rho & 15; return 8 * (i >> 2) + 4 * n + (i & 3); }
struct Unit { int pm, pn; };
struct Gemm { const bf16_t* A; const bf16_t* Bt; int M, N, K; };
struct StaticOrder {
    int nM, nN, nwg, G, c;
    __host__ __device__ void init(int M, int N, int G_, int c_) { nM = M / BM; nN = N / BM; nwg = nM * nN; G = G_; c = c_; }
    __host__ __device__ bool next(int i, Unit& u) const {
        const long L = (long)i * G + c; if (L >= nwg) return false;
        int wgid = (int)L; { const int q = nwg / NXCD, r = nwg % NXCD, xcd = wgid % NXCD, off = wgid / NXCD; wgid = (xcd < r ? xcd * (q + 1) : r * (q + 1) + (xcd - r) * q) + off; }
        const int nig = WGM * nN, gid = wgid / nig, fm = gid * WGM, gsz = (nM - fm) < WGM ? (nM - fm) : WGM;
        u.pm = fm + ((wgid % nig) % gsz); u.pn = (wgid % nig) / gsz; return true;
    }
    __device__ __forceinline__ void a_ready(const Unit&) const {}
    __device__ __forceinline__ void done(const Unit&) const {}
};
template <class Epi, class Sched, bool ALIGN_EPI = false, bool SP2 = false>
__device__ __forceinline__ void gemm_phase(PG8_LAS unsigned char* lds, const Gemm g, const Sched& S, const Epi& E) {
    const int tid = threadIdx.x, wid = __builtin_amdgcn_readfirstlane(tid >> 6), lane = tid & 63, wr = wid >> 2, wc = wid & 3, fr = lane & 15, fq = lane >> 4;
    const int K = g.K, nt = K / BK;
    unsigned voffA[2], voffB[2];
#pragma unroll
    for (int i = 0; i < 2; ++i) { int R, C; stage_rc(tid * 16 + i * 8192, R, C); const int Rb = Epi::PERM ? ((R & ~31) + perm32(R & 31)) : R;
        voffA[i] = (unsigned)(R * K + C) * 2u; voffB[i] = (unsigned)(Rb * K + C) * 2u; }
    const size_t kstep = (size_t)(BK * 2);
    const size_t hstep = (size_t)HALF * K * 2;
    const size_t tstep = 2 * hstep;
    const unsigned ldsw = (unsigned)wid * 1024u;
    const int aoff = lds_byte(wr * 64 + fr, fq * 8), boff = lds_byte(wc * 32 + fr, fq * 8);
#define PG8_SA(b, h) (((b) * 2 + (h)) * HTB)
#define PG8_SB(b, h) ((4 + (b) * 2 + (h)) * HTB)
#define PG8_STAGE(bufoff, gbase, voff) do { _Pragma("unroll") for (int _i = 0; _i < 2; ++_i) \
        __builtin_amdgcn_global_load_lds((const unsigned*)((const char*)(gbase) + (voff)[_i]), (PG8_LAS unsigned*)(lds + (bufoff) + ldsw + _i * 8192), 16, 0, 0); } while (0)
#define PG8_LDA(dst, b, h) do { _Pragma("unroll") for (int m = 0; m < 4; ++m) _Pragma("unroll") for (int k = 0; k < 2; ++k) dst[m][k] = *(const PG8_LAS bf16x8*)(lds + PG8_SA(b, h) + aoff + m * 2048 + k * 1024); } while (0)
#define PG8_LDB(dst, b, h) do { _Pragma("unroll") for (int n = 0; n < 2; ++n) _Pragma("unroll") for (int k = 0; k < 2; ++k) dst[n][k] = *(const PG8_LAS bf16x8*)(lds + PG8_SB(b, h) + boff + n * 2048 + k * 1024); } while (0)
#define PG8_MMA(ai, bj, At, Bt) do { __builtin_amdgcn_s_setprio(1); _Pragma("unroll") for (int m = 0; m < 4; ++m) _Pragma("unroll") for (int n = 0; n < 2; ++n) _Pragma("unroll") for (int k = 0; k < 2; ++k) \
        acc[ai][bj][m][n] = __builtin_amdgcn_mfma_f32_16x16x32_bf16(Bt[n][k], At[m][k], acc[ai][bj][m][n], 0, 0, 0); __builtin_amdgcn_s_setprio(0); } while (0)
#define PG8_WAIT_V(n) asm volatile("s_waitcnt vmcnt(" #n ")" ::: "memory")
#define PG8_WAIT_L(n) asm volatile("s_waitcnt lgkmcnt(" #n ")" ::: "memory")
#define PG8_BAR __builtin_amdgcn_s_barrier()
#define PG8_SCHED __builtin_amdgcn_sched_barrier(0)
    Unit cur, nxt; int ui = 0;
    if (!S.next(0, cur)) return;
    f32x4 acc[2][2][4][2];
#pragma unroll
    for (int a = 0; a < 2; ++a)
#pragma unroll
        for (int b = 0; b < 2; ++b)
#pragma unroll
            for (int m = 0; m < 4; ++m)
#pragma unroll
                for (int n = 0; n < 2; ++n) acc[a][b][m][n] = (f32x4){0.f, 0.f, 0.f, 0.f};
    bf16x8 At[4][2], B0[2][2], B1[2][2];
    const char* cA = (const char*)g.A + (size_t)cur.pm * tstep; const char* cB = (const char*)g.Bt + (size_t)cur.pn * tstep;
    S.a_ready(cur);
    if constexpr (SP2) {
        PG8_STAGE(PG8_SB(0, 0), cB, voffB); PG8_STAGE(PG8_SB(0, 1), cB + hstep, voffB); PG8_STAGE(PG8_SA(0, 0), cA, voffA); PG8_STAGE(PG8_SA(0, 1), cA + hstep, voffA);
        if (wr == 1) PG8_BAR;
        PG8_WAIT_V(2); PG8_BAR;
        PG8_STAGE(PG8_SB(1, 0), cB + kstep, voffB); PG8_STAGE(PG8_SA(1, 0), cA + kstep, voffA); PG8_STAGE(PG8_SB(1, 1), cB + hstep + kstep, voffB);
        PG8_WAIT_V(6); PG8_BAR;
    } else {
        PG8_STAGE(PG8_SB(0, 0), cB, voffB); PG8_STAGE(PG8_SA(0, 0), cA, voffA); PG8_STAGE(PG8_SB(0, 1), cB + hstep, voffB); PG8_STAGE(PG8_SA(0, 1), cA + hstep, voffA);
        if (wr == 1) PG8_BAR;
        PG8_WAIT_V(4); PG8_BAR;
        PG8_STAGE(PG8_SB(1, 0), cB + kstep, voffB); PG8_STAGE(PG8_SA(1, 0), cA + kstep, voffA); PG8_STAGE(PG8_SB(1, 1), cB + hstep + kstep, voffB);
        PG8_WAIT_V(6); PG8_BAR;
    }
    for (;;) {
        const bool has_next = S.next(ui + 1, nxt);
        const char* nA = has_next ? (const char*)g.A + (size_t)nxt.pm * tstep : cA; const char* nB = has_next ? (const char*)g.Bt + (size_t)nxt.pn * tstep : cB;
        for (int t = 0; t < nt; t += 2) {
            const bool last = (t == nt - 2);
            const char* a1 = cA + (size_t)(t + 1) * kstep;
            const char* a2 = last ? nA : cA + (size_t)(t + 2) * kstep; const char* b2 = last ? nB : cB + (size_t)(t + 2) * kstep;
            const char* a3 = a2 + kstep; const char* b3 = b2 + kstep;
            if (last && has_next) S.a_ready(nxt);
            if constexpr (SP2) {
            PG8_LDB(B0, 0, 0); PG8_LDB(B1, 0, 1); PG8_SCHED; PG8_LDA(At, 0, 0); PG8_STAGE(PG8_SA(1, 1), a1 + hstep, voffA);
            PG8_WAIT_V(8); PG8_WAIT_L(0); PG8_BAR; PG8_MMA(0, 0, At, B0); PG8_MMA(0, 1, At, B1); PG8_BAR; PG8_SCHED;
            PG8_LDA(At, 0, 1); PG8_STAGE(PG8_SB(0, 0), b2, voffB); PG8_STAGE(PG8_SB(0, 1), b2 + hstep, voffB); PG8_STAGE(PG8_SA(0, 0), a2, voffA);
            PG8_WAIT_V(8); PG8_WAIT_L(0); PG8_BAR; PG8_MMA(1, 0, At, B0); PG8_MMA(1, 1, At, B1); PG8_BAR; PG8_SCHED;
            PG8_LDB(B0, 1, 0); PG8_LDB(B1, 1, 1); PG8_SCHED; PG8_LDA(At, 1, 0); PG8_STAGE(PG8_SA(0, 1), a2 + hstep, voffA);
            PG8_WAIT_V(8); PG8_WAIT_L(0); PG8_BAR; PG8_MMA(0, 0, At, B0); PG8_MMA(0, 1, At, B1); PG8_BAR; PG8_SCHED;
            PG8_LDA(At, 1, 1); PG8_STAGE(PG8_SB(1, 0), b3, voffB); PG8_STAGE(PG8_SB(1, 1), b3 + hstep, voffB); PG8_STAGE(PG8_SA(1, 0), a3, voffA);
            PG8_WAIT_V(8); PG8_WAIT_L(0); PG8_BAR; PG8_MMA(1, 0, At, B0); PG8_MMA(1, 1, At, B1); PG8_BAR; PG8_SCHED;
            } else {
            PG8_LDB(B0, 0, 0); PG8_SCHED; PG8_LDA(At, 0, 0); PG8_STAGE(PG8_SA(1, 1), a1 + hstep, voffA);
            PG8_WAIT_L(8); PG8_BAR; PG8_WAIT_L(0); PG8_MMA(0, 0, At, B0); PG8_BAR; PG8_SCHED;
            PG8_LDB(B1, 0, 1); PG8_STAGE(PG8_SB(0, 0), b2, voffB);
            PG8_BAR; PG8_WAIT_L(0); PG8_MMA(0, 1, At, B1); PG8_BAR;
            PG8_LDA(At, 0, 1); PG8_STAGE(PG8_SA(0, 0), a2, voffA);
            PG8_BAR; PG8_WAIT_L(0); PG8_MMA(1, 0, At, B0); PG8_BAR; PG8_SCHED;
            PG8_STAGE(PG8_SB(0, 1), b2 + hstep, voffB);
            PG8_WAIT_V(6); PG8_BAR; PG8_MMA(1, 1, At, B1); PG8_BAR;
            PG8_LDB(B0, 1, 0); PG8_SCHED; PG8_LDA(At, 1, 0); PG8_STAGE(PG8_SA(0, 1), a2 + hstep, voffA);
            PG8_WAIT_L(8); PG8_BAR; PG8_WAIT_L(0); PG8_MMA(0, 0, At, B0); PG8_BAR; PG8_SCHED;
            PG8_LDB(B1, 1, 1); PG8_STAGE(PG8_SB(1, 0), b3, voffB);
            PG8_BAR; PG8_WAIT_L(0); PG8_MMA(0, 1, At, B1); PG8_BAR;
            PG8_LDA(At, 1, 1); PG8_STAGE(PG8_SA(1, 0), a3, voffA);
            PG8_BAR; PG8_WAIT_L(0); PG8_MMA(1, 0, At, B0); PG8_BAR; PG8_SCHED;
            PG8_STAGE(PG8_SB(1, 1), b3 + hstep, voffB);
            PG8_WAIT_V(6); PG8_BAR; PG8_MMA(1, 1, At, B1); PG8_BAR;
            }
        }
        if constexpr (ALIGN_EPI) { if (wr == 0) PG8_BAR; }
        if constexpr (!Epi::AFTER_DRAIN) { E(acc, cur, wr, wc, fr, fq); S.done(cur); }
        if (!has_next) break;
#pragma unroll
        for (int a = 0; a < 2; ++a)
#pragma unroll
            for (int b = 0; b < 2; ++b)
#pragma unroll
                for (int m = 0; m < 4; ++m)
#pragma unroll
                    for (int n = 0; n < 2; ++n) acc[a][b][m][n] = (f32x4){0.f, 0.f, 0.f, 0.f};
        cur = nxt; cA = nA; cB = nB; ++ui;
        if constexpr (ALIGN_EPI) { if (wr == 1) PG8_BAR; }
    }
    PG8_WAIT_V(0);
    if constexpr (!ALIGN_EPI) { if (wr == 0) PG8_BAR; }
    PG8_BAR;
    if constexpr (Epi::AFTER_DRAIN) { E.fused(acc, cur, wr, wc, fr, fq, lds, wid, lane); S.done(cur); }
#undef PG8_SA
#undef PG8_SB
#undef PG8_STAGE
#undef PG8_LDA
#undef PG8_LDB
#undef PG8_MMA
#undef PG8_WAIT_V
#undef PG8_WAIT_L
#undef PG8_BAR
#undef PG8_SCHED
}
}

struct EpiIn {
    static constexpr bool PERM = true, AFTER_DRAIN = false;
    Params P;
    template <int TYPE> __device__ __forceinline__ void run(const f32x4 (&acc)[2][2][4][2], const pg8::Unit& u, int wr, int wc, int fr, int fq) const {
        const int row0 = u.pm * pg8::BM + wr * 64 + fr, c0 = (u.pn & 1) * 256 + wc * 32 + 8 * fq;
#pragma unroll
        for (int ai = 0; ai < 2; ++ai)
#pragma unroll
            for (int m = 0; m < 4; ++m)
#pragma unroll
                for (int bj = 0; bj < 2; ++bj) {
                    const f32x4 v0 = acc[ai][bj][m][0], v1 = acc[ai][bj][m][1];
                    const float v[8] = {v0[0], v0[1], v0[2], v0[3], v1[0], v1[1], v1[2], v1[3]};
                    epi8(P, TYPE, row0 + ai * pg8::HALF + m * 16, c0 + bj * pg8::HALF, v);
                }
    }
    __device__ __forceinline__ void operator()(const f32x4 (&acc)[2][2][4][2], const pg8::Unit& u, int wr, int wc, int fr, int fq) const {
        switch (u.pn >> 1) {
            case 0: run<0>(acc, u, wr, wc, fr, fq); break; case 1: run<1>(acc, u, wr, wc, fr, fq); break;
            case 2: run<2>(acc, u, wr, wc, fr, fq); break; case 3: run<3>(acc, u, wr, wc, fr, fq); break;
            case 4: run<4>(acc, u, wr, wc, fr, fq); break; case 5: run<5>(acc, u, wr, wc, fr, fq); break;
            case 6: run<6>(acc, u, wr, wc, fr, fq); break; default: run<7>(acc, u, wr, wc, fr, fq); break;
        }
    }
};
struct EpiOut {
    static constexpr bool PERM = false, AFTER_DRAIN = false;
    Params P;
    __device__ __forceinline__ void operator()(const f32x4 (&acc)[2][2][4][2], const pg8::Unit& u, int wr, int wc, int fr, int fq) const {
        float* rowsq = (float*)(P.ws + WS_CTL) + CT_ROWSQ;
        const int col0 = u.pn * pg8::BM + wc * 32 + 4 * fq;
#pragma unroll
        for (int ai = 0; ai < 2; ++ai)
#pragma unroll
            for (int m = 0; m < 4; ++m) {
                const int r = u.pm * pg8::BM + ai * pg8::HALF + wr * 64 + m * 16 + fr; const size_t off = (size_t)r * DM + col0; float ss = 0.f;
#pragma unroll
                for (int bj = 0; bj < 2; ++bj)
#pragma unroll
                    for (int n = 0; n < 2; ++n) { const f32x4 xv = *(const f32x4*)(P.x + off + bj * pg8::HALF + n * 16); const f32x4 y = xv + acc[ai][bj][m][n];
                        ss += (y[0] * y[0] + y[1] * y[1]) + (y[2] * y[2] + y[3] * y[3]); *(f32x4*)(P.out + off + bj * pg8::HALF + n * 16) = y; }
                ss += __shfl_xor(ss, 16); ss += __shfl_xor(ss, 32);
                if (fq == 0) atomicAdd(rowsq + r, ss);
            }
    }
};

namespace att {
typedef short bf16x8 __attribute__((ext_vector_type(8)));
typedef short s16x4 __attribute__((ext_vector_type(4)));
typedef float f32x16 __attribute__((ext_vector_type(16)));
constexpr int QBLK = 32, KVBLK = 64, QB = 128;
constexpr int SHM_V = KVBLK * 128 * 2, SHM_K = KVBLK * 128 * 2;
constexpr int OFF_V = 0, OFF_K = 2 * SHM_V, OFF_WS = 2 * SHM_V + 2 * SHM_K, OFF_X = OFF_WS + 8 * 64 * 4, LDS_BYTES = OFF_X + 4 * 4096 * 4;
constexpr float THR = 8.f;
#define KSWZ(row, colB) ((row) * 256 + ((colB) ^ (((row) & 7) << 4)))
#define SBAR() __builtin_amdgcn_sched_barrier(0)
__device__ __forceinline__ int v_st(int k, int c) { const int kk = (k & ~0xC) | ((k & 4) << 1) | ((k & 8) >> 1); return ((kk >> 3) * 4 + (c >> 5)) * 512 + ((kk & 7) * 32 + (c & 31)) * 2; }
__device__ __forceinline__ int v_rd_base(int lane) { return ((lane & 3) << 3) | (((lane >> 2) & 3) << 6) | (((lane >> 4) & 1) << 5) | (((lane >> 5) & 1) << 8); }
constexpr int v_rd_off(int d0, int ks, int half) { return d0 * 512 + ks * 4096 + half * 2048; }
__device__ __forceinline__ int crow(int r, int hi) { return (r & 3) + 8 * (r >> 2) + 4 * hi; }
__device__ __forceinline__ unsigned cvtpk(float lo, float hi) { unsigned r; asm volatile("v_cvt_pk_bf16_f32 %0, %1, %2" : "=v"(r) : "v"(lo), "v"(hi)); return r; }
__device__ __forceinline__ void mask_tile(f32x16& p0, f32x16& p1, int dq) {
    const float NEG = -__builtin_inff();
#pragma unroll
    for (int r = 0; r < 16; ++r) { const int c = (r & 3) + 8 * (r >> 2); if (dq - c < 0) p0[r] = NEG; if (dq - c - 32 < 0) p1[r] = NEG; }
}
__device__ __forceinline__ void partialSM(f32x16& p0, f32x16& p1, float& m_reg, float& mn, float& alpha) {
    float pmax = p0[0];
#pragma unroll
    for (int r = 1; r < 16; ++r) pmax = fmaxf(pmax, p0[r]);
#pragma unroll
    for (int r = 0; r < 16; ++r) pmax = fmaxf(pmax, p1[r]);
    { auto rr = __builtin_amdgcn_permlane32_swap(__float_as_uint(pmax), __float_as_uint(pmax), false, false);
      pmax = fmaxf(__uint_as_float(rr[0]), __uint_as_float(rr[1])); }
    if (__builtin_expect(__all((pmax - m_reg) <= THR), 1)) { mn = m_reg; alpha = 1.f; }
    else { mn = fmaxf(m_reg, pmax); alpha = __builtin_amdgcn_exp2f(m_reg - mn); m_reg = mn; }
#pragma unroll
    for (int r = 0; r < 16; ++r) p0[r] = p0[r] - mn;
#pragma unroll
    for (int r = 0; r < 16; ++r) p1[r] = p1[r] - mn;
#pragma unroll
    for (int r = 0; r < 16; ++r) p0[r] = __builtin_amdgcn_exp2f(p0[r]);
}
__device__ __forceinline__ void finishSM(f32x16& p0, f32x16& p1, float alpha, float& l_reg, bf16x8& pa0, bf16x8& pa1, bf16x8& pa2, bf16x8& pa3) {
#pragma unroll
    for (int r = 0; r < 16; ++r) p1[r] = __builtin_amdgcn_exp2f(p1[r]);
    float ps = 0;
#pragma unroll
    for (int r = 0; r < 16; ++r) ps += p0[r];
#pragma unroll
    for (int r = 0; r < 16; ++r) ps += p1[r];
    { auto rr = __builtin_amdgcn_permlane32_swap(__float_as_uint(ps), __float_as_uint(ps), false, false);
      ps = __uint_as_float(rr[0]) + __uint_as_float(rr[1]); }
    l_reg = l_reg * alpha + ps;
#define PK4(P, B_, OUT) do { unsigned a0 = cvtpk(P[B_+0], P[B_+1]), a1 = cvtpk(P[B_+2], P[B_+3]);                          \
        unsigned b0 = cvtpk(P[B_+4], P[B_+5]), b1 = cvtpk(P[B_+6], P[B_+7]);                                             \
        auto r0 = __builtin_amdgcn_permlane32_swap(a0, b0, false, false); auto r1 = __builtin_amdgcn_permlane32_swap(a1, b1, false, false); \
        u32x4 w = {r0[0], r1[0], r0[1], r1[1]}; OUT = *reinterpret_cast<bf16x8*>(&w); } while (0)
    PK4(p0, 0, pa0); PK4(p0, 8, pa1); PK4(p1, 0, pa2); PK4(p1, 8, pa3);
#undef PK4
}
template <int KB>
__device__ __forceinline__ void qkt(f32x16& p0, f32x16& p1, const char* K_lds, int r32, int hi, int comp, const bf16x8* qr) {
    p0 = f32x16{}; p1 = f32x16{};
    const char* kb[4];
#pragma unroll
    for (int dd = 0; dd < 4; ++dd) kb[dd] = K_lds + KB * SHM_K + KSWZ(r32, (dd * 16 + hi * 8) * 2) + comp * 128;
#pragma unroll
    for (int d0 = 0; d0 < 4; ++d0) { const char* a = kb[d0];
        bf16x8 b0 = *reinterpret_cast<const bf16x8*>(a);
        bf16x8 b1 = *reinterpret_cast<const bf16x8*>(a + 32 * 256);
        p0 = __builtin_amdgcn_mfma_f32_32x32x16_bf16(b0, qr[d0], p0, 0, 0, 0);
        p1 = __builtin_amdgcn_mfma_f32_32x32x16_bf16(b1, qr[d0], p1, 0, 0, 0); }
}
template <int VB>
__device__ __forceinline__ void pv_tile(f32x16* o, int vb0, bf16x8 pa0, bf16x8 pa1, bf16x8 pa2, bf16x8 pa3) {
#define TRRD(dst, off) asm volatile("ds_read_b64_tr_b16 %0, %1 offset:%2" : "=&v"(dst) : "v"(vb0), "i"(off) : "memory")
#define PV_D0(d0) do { s16x4 l0, l1, l2, l3, h0, h1, h2, h3; constexpr int b_ = VB * SHM_V + v_rd_off(d0, 0, 0);   \
        TRRD(l0, b_); TRRD(h0, b_ + 2048); TRRD(l1, b_ + 4096); TRRD(h1, b_ + 6144); TRRD(l2, b_ + 8192); TRRD(h2, b_ + 10240); TRRD(l3, b_ + 12288); TRRD(h3, b_ + 14336); \
        asm volatile("s_waitcnt lgkmcnt(0)" ::: "memory"); SBAR();   \
        o[d0] = __builtin_amdgcn_mfma_f32_32x32x16_bf16(pa0, (bf16x8){l0[0], l0[1], l0[2], l0[3], h0[0], h0[1], h0[2], h0[3]}, o[d0], 0, 0, 0);   \
        o[d0] = __builtin_amdgcn_mfma_f32_32x32x16_bf16(pa1, (bf16x8){l1[0], l1[1], l1[2], l1[3], h1[0], h1[1], h1[2], h1[3]}, o[d0], 0, 0, 0);   \
        o[d0] = __builtin_amdgcn_mfma_f32_32x32x16_bf16(pa2, (bf16x8){l2[0], l2[1], l2[2], l2[3], h2[0], h2[1], h2[2], h2[3]}, o[d0], 0, 0, 0);   \
        o[d0] = __builtin_amdgcn_mfma_f32_32x32x16_bf16(pa3, (bf16x8){l3[0], l3[1], l3[2], l3[3], h3[0], h3[1], h3[2], h3[3]}, o[d0], 0, 0, 0); } while (0)
    PV_D0(0); PV_D0(1); PV_D0(2); PV_D0(3);
#undef PV_D0
#undef TRRD
}

__device__ __forceinline__ void attn_unit(const Params& P, int h, int qb, char* lds) {
    const int tid = threadIdx.x, wid = __builtin_amdgcn_readfirstlane(tid >> 6), lane = tid & 63, r32 = lane & 31, hi = lane >> 5;
    const int comp = wid >> 2, wq = wid & 3;
    const int q0 = qb * QB, NT = 2 * qb + 2;
    const int qlo = q0 + wq * QBLK, qm = qlo + r32 - 4 * hi;
    const bf16_t* DQ = (const bf16_t*)(P.ws + WS_DQ); const bf16_t* Kh = (const bf16_t*)(P.ws + WS_DK) + h * HD; const bf16_t* Vh = (const bf16_t*)(P.ws + WS_DV) + h * HD;
    char* V_lds = lds + OFF_V; char* K_lds = lds + OFF_K;
    float* ws = (float*)(lds + OFF_WS) + wid * 64; float* li_l = ws; float* al_l = ws + 32;
    float m_reg = -1e30f, l_reg = 0; f32x16 o[4] = {};
    const int sr = tid >> 4, sc = (tid & 15) * 8, vst0 = v_st(sr, sc), vst1 = v_st(32 + sr, sc), kws = KSWZ(sr, sc * 2);
    const int vb0 = (int)(uintptr_t)V_lds + v_rd_base(lane);
    bf16x8 qr[4];
#pragma unroll
    for (int d0 = 0; d0 < 4; ++d0) qr[d0] = *(const bf16x8*)(DQ + (size_t)(qlo + r32) * DH + h * HD + comp * 64 + d0 * 16 + hi * 8);
    bf16x8 st_v0, st_v1, st_k0, st_k1;
#define ROWP(p, k0, rr) ((p) + (size_t)((k0) + (rr)) * DH + sc)
#define VMW() asm volatile("s_waitcnt vmcnt(0)" ::: "memory")
#define SLOAD(k0) do { st_v0 = *(const bf16x8*)ROWP(Vh, k0, sr); st_v1 = *(const bf16x8*)ROWP(Vh, k0, 32 + sr); st_k0 = *(const bf16x8*)ROWP(Kh, k0, sr); st_k1 = *(const bf16x8*)ROWP(Kh, k0, 32 + sr); } while (0)
#define SWRITE(bf) do { *(bf16x8*)(V_lds + (bf) * SHM_V + vst0) = st_v0; *(bf16x8*)(V_lds + (bf) * SHM_V + vst1) = st_v1; \
                        *(bf16x8*)(K_lds + (bf) * SHM_K + kws) = st_k0; *(bf16x8*)(K_lds + (bf) * SHM_K + kws + 32 * 256) = st_k1; } while (0)
#define RESC(a) do { if (__any((a) < 1.f)) { if (hi == 0) al_l[r32] = (a); asm volatile("s_waitcnt lgkmcnt(0)" ::: "memory");              \
                     _Pragma("unroll") for (int d_ = 0; d_ < 4; ++d_) _Pragma("unroll") for (int r = 0; r < 16; ++r) o[d_][r] *= al_l[crow(r, hi)]; } } while (0)
#define KBASE(t) ((t) * KVBLK)
#define MASKT(P0_, P1_, t) do { const int kb_ = KBASE(t); if (kb_ + KVBLK - 1 > qlo) mask_tile(P0_, P1_, qm - kb_); } while (0)
    f32x16 pA0, pA1, pB0, pB1; float mnA, mnB, alA, alB; bf16x8 pa0, pa1, pa2, pa3;
    SLOAD(KBASE(0)); VMW(); SWRITE(0); SBAR();
    SLOAD(KBASE(1));
    __syncthreads();
    SBAR(); qkt<0>(pA0, pA1, K_lds, r32, hi, comp, qr);
    MASKT(pA0, pA1, 0); partialSM(pA0, pA1, m_reg, mnA, alA);
    VMW(); SWRITE(1);
    __syncthreads();
#define HALF_STEP(PX0, PX1, mnX, alX, PY0, PY1, alY, t, KB, VB, SB) do {                                                      \
        SBAR(); qkt<KB>(PX0, PX1, K_lds, r32, hi, comp, qr);                                                                  \
        finishSM(PY0, PY1, alY, l_reg, pa0, pa1, pa2, pa3); SBAR();                                                           \
        if ((t) + 1 < NT) { SLOAD(KBASE((t) + 1)); SBAR(); }                                                                  \
        pv_tile<VB>(o, vb0, pa0, pa1, pa2, pa3); MASKT(PX0, PX1, (t)); partialSM(PX0, PX1, m_reg, mnX, alX);                  \
        __syncthreads();                                                                                                      \
        if ((t) + 1 < NT) { VMW(); SWRITE(SB); }                                                                              \
        RESC(alX); __syncthreads(); } while (0)
    for (int t = 1; t + 1 < NT; t += 2) {
        HALF_STEP(pB0, pB1, mnB, alB, pA0, pA1, alA, t, 1, 0, 0);
        HALF_STEP(pA0, pA1, mnA, alA, pB0, pB1, alB, t + 1, 0, 1, 1);
    }
    SBAR(); qkt<1>(pB0, pB1, K_lds, r32, hi, comp, qr); SBAR();
    finishSM(pA0, pA1, alA, l_reg, pa0, pa1, pa2, pa3); SBAR();
    pv_tile<0>(o, vb0, pa0, pa1, pa2, pa3);
    MASKT(pB0, pB1, NT - 1); partialSM(pB0, pB1, m_reg, mnB, alB); RESC(alB);
    finishSM(pB0, pB1, alB, l_reg, pa0, pa1, pa2, pa3); SBAR(); pv_tile<1>(o, vb0, pa0, pa1, pa2, pa3);
    if (hi == 0) li_l[r32] = l_reg; asm volatile("s_waitcnt lgkmcnt(0)" ::: "memory");
    float rli[16];
#pragma unroll
    for (int r = 0; r < 16; ++r) rli[r] = __builtin_amdgcn_rcpf(li_l[crow(r, hi)]);
    float* X = (float*)(lds + OFF_X) + wq * 4096;
    if (comp == 1) {
        const float lam = ((const float*)(P.ws + WS_CTL))[CT_LAM];
#pragma unroll
        for (int d0 = 0; d0 < 4; ++d0)
#pragma unroll
            for (int r = 0; r < 16; ++r) X[(d0 * 16 + r) * 64 + lane] = o[d0][r] * rli[r] * lam;
    }
    __syncthreads();
    if (comp == 0) {
        float ss[16];
#pragma unroll
        for (int r = 0; r < 16; ++r) { float s = 0.f;
#pragma unroll
            for (int d0 = 0; d0 < 4; ++d0) { const float v = o[d0][r] * rli[r] - X[(d0 * 16 + r) * 64 + lane]; o[d0][r] = v; s += v * v; }
            ss[r] = s; }
#pragma unroll
        for (int r = 0; r < 16; ++r) { float s = ss[r]; s += __shfl_xor(s, 1); s += __shfl_xor(s, 2); s += __shfl_xor(s, 4); s += __shfl_xor(s, 8); s += __shfl_xor(s, 16);
            ss[r] = (1.0f - LAMBDA_INIT) / sqrtf(s * (1.0f / HD) + SUBLN_EPS); }
        const bf16_t* DG = (const bf16_t*)(P.ws + WS_DG) + h * HD; bf16_t* MIX = (bf16_t*)(P.ws + WS_MIX) + DH + h * HD;
        float nw[4];
#pragma unroll
        for (int d0 = 0; d0 < 4; ++d0) nw[d0] = P.diff_norm_w[d0 * 32 + r32];
#pragma unroll
        for (int r = 0; r < 16; ++r) { const int t = qlo + crow(r, hi);
#pragma unroll
            for (int d0 = 0; d0 < 4; ++d0) { const int d = d0 * 32 + r32;
                const float y = o[d0][r] * ss[r] * nw[d0] * bf2f(DG[(size_t)t * DH + d]);
                const float yn = __shfl_xor(y, 1);
                if ((r32 & 1) == 0) *(unsigned*)(MIX + (size_t)t * DM + d) = pk2(y, yn); } }
    }
    __syncthreads();
#undef ROWP
#undef VMW
#undef SLOAD
#undef SWRITE
#undef RESC
#undef KBASE
#undef MASKT
#undef HALF_STEP
}
__device__ __forceinline__ void attn_phase(const Params& P, int vcu, int nblk, char* lds) {
    for (int it = vcu; it < 256; it += nblk) { const int h = it >> 6, j = it & 63; attn_unit(P, h, 127 - j, lds); attn_unit(P, h, j, lds); }
}
#undef KSWZ
#undef SBAR
}

namespace hg {
typedef short bf16x8 __attribute__((ext_vector_type(8)));
typedef short s16x4 __attribute__((ext_vector_type(4)));
typedef float f32x16 __attribute__((ext_vector_type(16)));
typedef __attribute__((address_space(3))) unsigned char lds_u8;
constexpr int RS_Q = 272, RS_T = 320, RS_P = 144, RS_O = 528;
constexpr int OFF_QT = 0, OFF_KT = 17408, OFF_OO = 0, OFF_KH = 34816, OFF_VV = 55296, OFF_ST = 75776, OFF_PP = 110592, OFF_GT = 119808, OFF_BM = 123904, OFF_BL = 124416, LDS_BYTES = 124928;
__device__ __forceinline__ int crow(int r, int hi) { return (r & 3) + 8 * (r >> 2) + 4 * hi; }
__device__ __forceinline__ bf16x8 ld128(const lds_u8* p) { return *(const __attribute__((address_space(3))) bf16x8*)p; }
typedef short v4i16_t __attribute__((ext_vector_type(4)));
__device__ __forceinline__ s16x4 vtr(const lds_u8* p) { return __builtin_bit_cast(s16x4, __builtin_amdgcn_ds_read_tr16_b64_v4i16((__attribute__((address_space(3))) v4i16_t*)p)); }
__device__ __forceinline__ bf16x8 tr_frag(const lds_u8* base, int RS, int kbase, int nbase, int lane) {
    const lds_u8* p = base + (kbase + 8 * (lane >> 5) + ((lane & 15) >> 2)) * RS + (nbase + 16 * ((lane >> 4) & 1) + 4 * (lane & 3)) * 2;
    const s16x4 lo = vtr(p), hi = vtr(p + 4 * RS);
    return (bf16x8){lo[0], lo[1], lo[2], lo[3], hi[0], hi[1], hi[2], hi[3]};
}
#define MFMA32(a, b, c) __builtin_amdgcn_mfma_f32_32x32x16_bf16((a), (b), (c), 0, 0, 0)

template <bool FULL>
__device__ __forceinline__ void chunk_prep(const Params& P, int h, int tc, lds_u8* lds, float& bs0, float& bs1) {
    const int tid = threadIdx.x, d2 = tid & 63, rg = tid >> 6;
    const float* Gp = (const float*)(P.ws + WS_G) + (size_t)(tc + 8 * rg) * DH + h * HD + 2 * d2;
    const bf16_t* Qp = (const bf16_t*)(P.ws + WS_HQ) + (size_t)(tc + 8 * rg) * DH + h * HD + 2 * d2;
    const bf16_t* Vp = (const bf16_t*)(P.ws + WS_HI) + (size_t)(tc + (tid >> 4)) * DH + h * HD + (tid & 15) * 8;
    f32x2 g[8]; unsigned qraw[8];
#pragma unroll
    for (int i = 0; i < 8; ++i) { g[i] = *(const f32x2*)(Gp + (size_t)i * DH); if (FULL) qraw[i] = *(const unsigned*)(Qp + (size_t)i * DH); }
    const u32x4 va = *(const u32x4*)Vp, vb = *(const u32x4*)(Vp + (size_t)32 * DH);
    f32x2 cs[8]; float c0 = 0.f, c1 = 0.f;
#pragma unroll
    for (int i = 0; i < 8; ++i) { c0 += g[i].x; c1 += g[i].y; cs[i] = (f32x2){c0, c1}; }
    __attribute__((address_space(3))) float* GT = (__attribute__((address_space(3))) float*)(lds + OFF_GT);
    *(__attribute__((address_space(3))) f32x2*)(GT + rg * 128 + 2 * d2) = (f32x2){c0, c1};
    *(__attribute__((address_space(3))) u32x4*)(lds + OFF_VV + (tid >> 4) * RS_T + (tid & 15) * 16) = va;
    *(__attribute__((address_space(3))) u32x4*)(lds + OFF_VV + ((tid >> 4) + 32) * RS_T + (tid & 15) * 16) = vb;
    __syncthreads();
    float p0 = 0.f, p1 = 0.f, m0 = 0.f, m1 = 0.f, t0 = 0.f, t1 = 0.f;
#pragma unroll
    for (int j = 0; j < 8; ++j) { const f32x2 t = *(__attribute__((address_space(3))) f32x2*)(GT + j * 128 + 2 * d2);
        if (j < rg) { p0 += t.x; p1 += t.y; } if (j < 4) { m0 += t.x; m1 += t.y; } t0 += t.x; t1 += t.y; }
    if (rg == 0) { *(__attribute__((address_space(3))) f32x2*)(lds + OFF_BM + d2 * 8) = (f32x2){m0, m1}; *(__attribute__((address_space(3))) f32x2*)(lds + OFF_BL + d2 * 8) = (f32x2){t0, t1}; }
    bs0 += t0; bs1 += t1;
#pragma unroll
    for (int i = 0; i < 8; ++i) {
        const int row = 8 * rg + i; const float b0 = p0 + cs[i].x, b1 = p1 + cs[i].y;
        const float k0 = 1.0f - __expf(g[i].x), k1 = 1.0f - __expf(g[i].y);
        *(__attribute__((address_space(3))) unsigned*)(lds + OFF_KH + row * RS_T + d2 * 4) = pk2(k0 * __expf(t0 - b0), k1 * __expf(t1 - b1));
        if (FULL) {
            const float q0 = __uint_as_float(qraw[i] << 16), q1 = __uint_as_float(qraw[i] & 0xffff0000u);
            *(__attribute__((address_space(3))) unsigned*)(lds + OFF_QT + row * RS_Q + d2 * 4) = pk2(q0 * __expf(b0 - m0), q1 * __expf(b1 - m1));
            *(__attribute__((address_space(3))) unsigned*)(lds + OFF_KT + row * RS_Q + d2 * 4) = pk2(k0 * __expf(m0 - b0), k1 * __expf(m1 - b1));
        }
    }
    __syncthreads();
}
__device__ __forceinline__ void state_update(lds_u8* lds, f32x16 (&S)[2], int w, int lane) {
    const int db = w >> 1, hi = lane >> 5;
    const __attribute__((address_space(3))) float* BL = (const __attribute__((address_space(3))) float*)(lds + OFF_BL);
#pragma unroll
    for (int g4 = 0; g4 < 4; ++g4) { const f32x4 bl = *(const __attribute__((address_space(3))) f32x4*)(BL + 32 * db + 8 * g4 + 4 * hi);
#pragma unroll
        for (int q = 0; q < 4; ++q) { const float f = __expf(bl[q]); S[0][4 * g4 + q] *= f; S[1][4 * g4 + q] *= f; } }
#pragma unroll
    for (int ks = 0; ks < 4; ++ks) {
        const bf16x8 a = tr_frag(lds + OFF_KH, RS_T, 16 * ks, 32 * db, lane);
        const bf16x8 b0 = tr_frag(lds + OFF_VV, RS_T, 16 * ks, 32 * (2 * (w & 1)), lane), b1 = tr_frag(lds + OFF_VV, RS_T, 16 * ks, 32 * (2 * (w & 1) + 1), lane);
        S[0] = MFMA32(a, b0, S[0]); S[1] = MFMA32(a, b1, S[1]);
    }
}
__device__ __forceinline__ float* us_ptr(const Params& P, int sc, int h, int w, int j, int lane) {
    return (float*)(P.ws + WS_US) + ((size_t)(sc * NH + h) * HD + 32 * (w >> 1)) * HD + 32 * (2 * (w & 1) + j) + (lane & 31);
}
__device__ __forceinline__ void local_item(const Params& P, int sc, int h, lds_u8* lds) {
    const int tid = threadIdx.x, w = __builtin_amdgcn_readfirstlane(tid >> 6), lane = tid & 63, hi = lane >> 5;
    f32x16 S[2] = {}; float bs0 = 0.f, bs1 = 0.f;
    for (int c = 0; c < 4; ++c) {
        chunk_prep<false>(P, h, sc * 256 + c * 64, lds, bs0, bs1);
        state_update(lds, S, w, lane);
        __syncthreads();
    }
#pragma unroll
    for (int j = 0; j < 2; ++j) { float* up = us_ptr(P, sc, h, w, j, lane);
#pragma unroll
        for (int r = 0; r < 16; ++r) up[(size_t)crow(r, hi) * HD] = S[j][r]; }
    if (tid < 64) *(f32x2*)((float*)(P.ws + WS_BS) + (size_t)(sc * NH + h) * HD + 2 * tid) = (f32x2){bs0, bs1};
}
__device__ __forceinline__ void local_phase(const Params& P, int vcu, int nblk, lds_u8* lds) { for (int it = vcu; it < 256; it += nblk) local_item(P, it >> 2, it & 3, lds); }
__device__ __forceinline__ void scan_phase(const Params& P, int bid, int nblk) {
    const int tid = threadIdx.x; if (tid >= 256) return;
    float* US = (float*)(P.ws + WS_US); const float* BS = (const float*)(P.ws + WS_BS);
    for (int i = bid * 256 + tid; i < NH * HD * HD; i += nblk * 256) {
        const int hd = i >> 7; float s = 0.f;
        for (int sc0 = 0; sc0 < 64; sc0 += 8) {
            float u[8], a[8];
#pragma unroll
            for (int k = 0; k < 8; ++k) { u[k] = US[(size_t)(sc0 + k) * (NH * HD * HD) + i]; a[k] = BS[(size_t)(sc0 + k) * (NH * HD) + hd]; }
#pragma unroll
            for (int k = 0; k < 8; ++k) { US[(size_t)(sc0 + k) * (NH * HD * HD) + i] = s; s = __expf(a[k]) * s + u[k]; }
        }
    }
}
__device__ __forceinline__ void out_item(const Params& P, int sc, int h, lds_u8* lds) {
    const int tid = threadIdx.x, w = __builtin_amdgcn_readfirstlane(tid >> 6), lane = tid & 63, r32 = lane & 31, hi = lane >> 5;
    f32x16 S[2]; float bs0 = 0.f, bs1 = 0.f;
#pragma unroll
    for (int j = 0; j < 2; ++j) { const float* up = us_ptr(P, sc, h, w, j, lane);
#pragma unroll
        for (int r = 0; r < 16; ++r) S[j][r] = up[(size_t)crow(r, hi) * HD]; }
    const int tb = w >> 2, eb = w & 3, db = w >> 1;
    for (int c = 0; c < 4; ++c) {
        const int tc = sc * 256 + c * 64;
        chunk_prep<true>(P, h, tc, lds, bs0, bs1);
        { const __attribute__((address_space(3))) float* BM = (const __attribute__((address_space(3))) float*)(lds + OFF_BM);
#pragma unroll
          for (int g4 = 0; g4 < 4; ++g4) { const int d0 = 32 * db + 8 * g4 + 4 * hi; const f32x4 bm = *(const __attribute__((address_space(3))) f32x4*)(BM + d0);
              const float f0 = __expf(bm[0]), f1 = __expf(bm[1]), f2 = __expf(bm[2]), f3 = __expf(bm[3]);
#pragma unroll
              for (int j = 0; j < 2; ++j) { const int e = 32 * (2 * (w & 1) + j) + r32;
                  *(__attribute__((address_space(3))) u32x2*)(lds + OFF_ST + e * RS_Q + d0 * 2) = (u32x2){pk2(S[j][4 * g4] * f0, S[j][4 * g4 + 1] * f1), pk2(S[j][4 * g4 + 2] * f2, S[j][4 * g4 + 3] * f3)}; } } }
        if (w < 3) {
            const int sb = (w == 2) ? 1 : 0, tb2 = (w >= 1) ? 1 : 0; f32x16 acc = {};
#pragma unroll
            for (int ks = 0; ks < 8; ++ks) { const bf16x8 a = ld128(lds + OFF_KT + (32 * sb + r32) * RS_Q + (16 * ks + 8 * hi) * 2), b = ld128(lds + OFF_QT + (32 * tb2 + r32) * RS_Q + (16 * ks + 8 * hi) * 2);
                acc = MFMA32(a, b, acc); }
            const int t = 32 * tb2 + r32;
#pragma unroll
            for (int g4 = 0; g4 < 4; ++g4) { const int s0 = 32 * sb + 8 * g4 + 4 * hi; float v[4];
#pragma unroll
                for (int q = 0; q < 4; ++q) v[q] = (s0 + q <= t) ? acc[4 * g4 + q] : 0.f;
                *(__attribute__((address_space(3))) u32x2*)(lds + OFF_PP + t * RS_P + s0 * 2) = (u32x2){pk2(v[0], v[1]), pk2(v[2], v[3])}; }
        }
        __syncthreads();
        f32x16 o = {};
#pragma unroll
        for (int ks = 0; ks < 8; ++ks) { const bf16x8 a = ld128(lds + OFF_QT + (32 * tb + r32) * RS_Q + (16 * ks + 8 * hi) * 2), b = ld128(lds + OFF_ST + (32 * eb + r32) * RS_Q + (16 * ks + 8 * hi) * 2);
            o = MFMA32(a, b, o); }
#pragma unroll
        for (int ks = 0; ks < 4; ++ks) if (ks < 2 * (tb + 1)) { const bf16x8 a = ld128(lds + OFF_PP + (32 * tb + r32) * RS_P + (16 * ks + 8 * hi) * 2), b = tr_frag(lds + OFF_VV, RS_T, 16 * ks, 32 * eb, lane);
            o = MFMA32(a, b, o); }
        state_update(lds, S, w, lane);
        __syncthreads();
        { __attribute__((address_space(3))) float* OO = (__attribute__((address_space(3))) float*)(lds + OFF_OO);
#pragma unroll
          for (int r = 0; r < 16; ++r) OO[(32 * tb + crow(r, hi)) * (RS_O / 4) + 32 * eb + r32] = o[r]; }
        __syncthreads();
        { const int t = tid >> 3, e0 = (tid & 7) * 16; const __attribute__((address_space(3))) f32x4* orow = (const __attribute__((address_space(3))) f32x4*)(lds + OFF_OO + t * RS_O + e0 * 4);
          f32x4 v[4]; float ss = 0.f;
#pragma unroll
          for (int k = 0; k < 4; ++k) { v[k] = orow[k]; ss += (v[k].x * v[k].x + v[k].y * v[k].y) + (v[k].z * v[k].z + v[k].w * v[k].w); }
          ss += __shfl_xor(ss, 1); ss += __shfl_xor(ss, 2); ss += __shfl_xor(ss, 4);
          const float rs = 1.0f / sqrtf(ss * (1.0f / HD) + NORM_EPS);
          const bf16_t* hgp = (const bf16_t*)(P.ws + WS_HG) + (size_t)(tc + t) * DH + h * HD + e0; const u32x4 ga = *(const u32x4*)hgp, gb = *(const u32x4*)(hgp + 8);
          const f32x4* nw = (const f32x4*)(P.hgrn_norm_w + e0); float y[16];
#pragma unroll
          for (int k = 0; k < 4; ++k) { const f32x4 n4 = nw[k]; const unsigned g01 = (k < 2) ? ga[2 * k] : gb[2 * (k - 2)], g23 = (k < 2) ? ga[2 * k + 1] : gb[2 * (k - 2) + 1];
              y[4 * k] = v[k].x * rs * n4.x * __uint_as_float(g01 << 16); y[4 * k + 1] = v[k].y * rs * n4.y * __uint_as_float(g01 & 0xffff0000u);
              y[4 * k + 2] = v[k].z * rs * n4.z * __uint_as_float(g23 << 16); y[4 * k + 3] = v[k].w * rs * n4.w * __uint_as_float(g23 & 0xffff0000u); }
          bf16_t* mp = (bf16_t*)(P.ws + WS_MIX) + (size_t)(tc + t) * DM + h * HD + e0;
          *(u32x4*)mp = (u32x4){pk2(y[0], y[1]), pk2(y[2], y[3]), pk2(y[4], y[5]), pk2(y[6], y[7])};
          *(u32x4*)(mp + 8) = (u32x4){pk2(y[8], y[9]), pk2(y[10], y[11]), pk2(y[12], y[13]), pk2(y[14], y[15])}; }
        __syncthreads();
    }
}
__device__ __forceinline__ void out_phase(const Params& P, int vcu, int nblk, lds_u8* lds) { for (int it = vcu; it < 256; it += nblk) out_item(P, it >> 2, it & 3, lds); }
#undef MFMA32
}


#define LAS __attribute__((address_space(3)))
#define XB_TMO      128
#define XB_XCNT(j)  (256  + 64 * (j))
#define XB_XSUB(j)  (1280 + 64 * (j))
#define XB_XGEN(j)  (2304 + 64 * (j))
#define XB_TOP      3328
#define XB_TOPGEN   3392
#define XCD_BAR_WORDS 3456
#define XB_SPIN_CAP (1u << 18)
__device__ __forceinline__ unsigned xb_ld(unsigned* p)              { return __hip_atomic_load(p, __ATOMIC_RELAXED, __HIP_MEMORY_SCOPE_AGENT); }
__device__ __forceinline__ unsigned xb_add(unsigned* p, unsigned v) { return __hip_atomic_fetch_add(p, v, __ATOMIC_RELAXED, __HIP_MEMORY_SCOPE_AGENT); }
__device__ __forceinline__ unsigned xb_xcc_id() { return (unsigned)__builtin_amdgcn_s_getreg((3 << 11) | 20) & 0xFu; }
#define XB_SPIN(cond, bar) do { unsigned _sp = 0; while (cond) { __builtin_amdgcn_s_sleep(1); \
    if ((++_sp & 255u) == 0u) { if (xb_ld(&(bar)[XB_TMO])) break; if (_sp > XB_SPIN_CAP) { atomicAdd(&(bar)[XB_TMO], 1u); break; } } } } while (0)
struct XcdBarrier { unsigned* bar; unsigned x; volatile LAS unsigned* st; };
__device__ __forceinline__ XcdBarrier xcd_barrier_post(unsigned* bar, volatile LAS unsigned* st) {
    XcdBarrier b; b.bar = bar; b.x = xb_xcc_id(); b.st = st;
    if (threadIdx.x == 0) (void)xb_add(&bar[XB_XCNT(b.x)], 1u);
    return b;
}
__device__ __forceinline__ void xcd_barrier_complete(unsigned* bar, unsigned x, unsigned& nloc, unsigned& nx) {
    const unsigned G = gridDim.x * gridDim.y * gridDim.z;
    unsigned sum, cnt, mine, sp = 0u;
    for (;;) {
        sum = 0u; cnt = 0u; mine = 0u;
#pragma unroll
        for (unsigned j = 0; j < 16; ++j) { const unsigned c = xb_ld(&bar[XB_XCNT(j)]); sum += c; cnt += (c > 0u) ? 1u : 0u; mine = (j == x) ? c : mine; }
        if (sum == G) break;
        __builtin_amdgcn_s_sleep(1);
        if ((++sp & 255u) == 0u) { if (xb_ld(&bar[XB_TMO])) break; if (sp > XB_SPIN_CAP) { atomicAdd(&bar[XB_TMO], 1u); break; } }
    }
    nloc = mine > 0u ? mine : 1u; nx = cnt > 0u ? cnt : 1u;
}
__device__ __forceinline__ void xcd_barrier(const XcdBarrier& b) {
    asm volatile("s_waitcnt vmcnt(0)" ::: "memory");
    __syncthreads();
    if (threadIdx.x == 0) {
        unsigned* bar = b.bar;
        __builtin_amdgcn_s_waitcnt(0);
        unsigned nloc = b.st[0], nx = b.st[1];
        if (nloc == 0u) { xcd_barrier_complete(bar, b.x, nloc, nx); b.st[0] = nloc; b.st[1] = nx; }
        const unsigned old = xb_add(&bar[XB_XSUB(b.x)], 1u);
        const unsigned gen = old / nloc;
        if (old + 1u == (gen + 1u) * nloc) {
            __builtin_amdgcn_fence(__ATOMIC_RELEASE, "agent");
            asm volatile("s_waitcnt vmcnt(0)" ::: "memory");
            const unsigned og = xb_add(&bar[XB_TOP], 1u);
            const unsigned tg = og / nx;
            if (og + 1u == (tg + 1u) * nx) xb_add(&bar[XB_TOPGEN], 1u);
            else XB_SPIN(xb_ld(&bar[XB_TOPGEN]) == tg, bar);
            __builtin_amdgcn_fence(__ATOMIC_ACQUIRE, "agent");
            xb_add(&bar[XB_XGEN(b.x)], 1u);
            asm volatile("s_waitcnt vmcnt(0)" ::: "memory");
        } else {
            XB_SPIN(xb_ld(&bar[XB_XGEN(b.x)]) == gen, bar);
            __builtin_amdgcn_fence(__ATOMIC_ACQUIRE, "agent");
            asm volatile("s_waitcnt vmcnt(0)" ::: "memory");
        }
    }
    __syncthreads();
}
constexpr int CW_BAR = 131072;
constexpr int MISC_OFF = 147456 - 64;
constexpr int NWAVES = 8;
constexpr int LDS_BYTES = 147456;
constexpr int N_PHASES = 7;
struct Args { Params P; int ph_lo, ph_hi, flags, pad; };

__device__ __forceinline__ void final_norm_phase(const Params& P, int bid, int nblk) {
    const int lane = threadIdx.x & 63, wave = threadIdx.x >> 6, gw = bid * NWAVES + wave, ngw = nblk * NWAVES;
    const float* rowsq = (const float*)(P.ws + WS_CTL) + CT_ROWSQ;
    for (int m = gw; m < T; m += ngw) {
        f32x4* yr = (f32x4*)(P.out + (size_t)m * DM) + lane; const f32x4* wr = (const f32x4*)P.final_norm_w + lane;
        const float rstd = 1.0f / sqrtf(rowsq[m] * (1.0f / DM) + NORM_EPS);
#pragma unroll
        for (int j = 0; j < 4; ++j) { const f32x4 v = yr[64 * j], w = wr[64 * j]; yr[64 * j] = (f32x4){v.x * rstd * w.x, v.y * rstd * w.y, v.z * rstd * w.z, v.w * rstd * w.w}; }
    }
}

__global__ void __launch_bounds__(NWAVES * 64, 2) mk_fwd(Args a) {
    extern __shared__ __attribute__((aligned(16))) unsigned char lds[];
    const Params& P = a.P;
    const int G = gridDim.x, bx = blockIdx.x;
    const int vcu = (G % 8 == 0) ? (bx % 8) * (G / 8) + bx / 8 : bx;
    const int lo = a.ph_lo, hi = a.ph_hi;
#define IN(k) (lo <= (k) && (k) < hi)
#define SEAM(k) do { if (IN(k) && IN((k) + 1)) xcd_barrier(bar); } while (0)
    if (threadIdx.x < 16) ((LAS unsigned*)((LAS unsigned char*)lds + MISC_OFF))[threadIdx.x] = 0u;
    __syncthreads();
    const XcdBarrier bar = xcd_barrier_post((unsigned*)(P.ws + WS_CTL) + CW_BAR, (volatile LAS unsigned*)((LAS unsigned char*)lds + MISC_OFF));
    if (IN(0)) {
        prologue_phase(P, bx, G, (float*)lds);
        float* rowsq = (float*)(P.ws + WS_CTL) + CT_ROWSQ;
        for (int i = bx * (NWAVES * 64) + threadIdx.x; i < T; i += G * NWAVES * 64) rowsq[i] = 0.f;
    }
    SEAM(0);
    if (IN(1)) {
        pg8::Gemm g{(const bf16_t*)(P.ws + WS_XN), (const bf16_t*)(P.ws + WS_WIN), T, DIN, DM}; pg8::StaticOrder S; S.init(T, DIN, G, bx);
        EpiIn E{P};
        pg8::gemm_phase<EpiIn, pg8::StaticOrder, true, true>((PG8_LAS unsigned char*)lds, g, S, E);
    }
    SEAM(1);
    if (IN(2)) hg::local_phase(P, vcu, G, (hg::lds_u8*)lds);
    SEAM(2);
    if (IN(3)) hg::scan_phase(P, bx, G);
    SEAM(3);
    if (IN(4)) { att::attn_phase(P, vcu, G, (char*)lds); hg::out_phase(P, vcu, G, (hg::lds_u8*)lds); }
    SEAM(4);
    if (IN(5)) {
        pg8::Gemm g{(const bf16_t*)(P.ws + WS_MIX), (const bf16_t*)(P.ws + WS_WOUT), T, DM, DM}; pg8::StaticOrder S; S.init(T, DM, G, bx);
        EpiOut E{P};
        pg8::gemm_phase<EpiOut, pg8::StaticOrder, false, true>((PG8_LAS unsigned char*)lds, g, S, E);
    }
    SEAM(5);
    if (IN(6)) final_norm_phase(P, bx, G);
#undef IN
#undef SEAM
}

static int g_grid = 0;
static void launch_phases(const Params& P, int lo, int hi, hipStream_t stream) {
    Args a{}; a.P = P; a.ph_lo = lo; a.ph_hi = hi; a.flags = 0; a.pad = 0;
    if (hipMemsetAsync(P.ws + WS_CTL + (size_t)CW_BAR * 4, 0, XCD_BAR_WORDS * 4, stream) != hipSuccess) { fprintf(stderr, "kernel_launch: memset of the barrier words failed\n"); return; }
    hipLaunchKernelGGL(mk_fwd, dim3(g_grid), dim3(NWAVES * 64), LDS_BYTES, stream, a);
    const hipError_t e = hipPeekAtLastError();
    if (e != hipSuccess) fprintf(stderr, "kernel_launch: launch [%d,%d) failed: %s (grid %d)\n", lo, hi, hipGetErrorString(e), g_grid);
}

extern "C" void kernel_launch(void* const* d_in, const int* in_sizes, int n_in, void* d_out, int out_size, void* d_ws, size_t ws_size, hipStream_t stream) {
    if (n_in != 12 || in_sizes[0] != T * DM || out_size != T * DM || ws_size < 256 * MiB) { fprintf(stderr, "kernel_launch: unexpected shapes (n_in %d in0 %d out %d ws %zu)\n", n_in, n_in > 0 ? in_sizes[0] : -1, out_size, ws_size); return; }
    if (g_grid == 0) {
        int dev = 0, cus = 0, per_cu = 0;
        if (hipGetDevice(&dev) != hipSuccess || hipDeviceGetAttribute(&cus, hipDeviceAttributeMultiprocessorCount, dev) != hipSuccess) { fprintf(stderr, "kernel_launch: device query failed\n"); g_grid = -1; return; }
        if (hipFuncSetAttribute((const void*)mk_fwd, hipFuncAttributeMaxDynamicSharedMemorySize, LDS_BYTES) != hipSuccess) { fprintf(stderr, "kernel_launch: hipFuncSetAttribute failed\n"); g_grid = -1; return; }
        if (hipOccupancyMaxActiveBlocksPerMultiprocessor(&per_cu, (const void*)mk_fwd, NWAVES * 64, LDS_BYTES) != hipSuccess || per_cu < 1) { fprintf(stderr, "kernel_launch: occupancy query says %d blocks per CU\n", per_cu); per_cu = 1; }
        (void)hipGetLastError();
        g_grid = cus * (per_cu < 1 ? 1 : 1);
    }
    if (g_grid < 0) return;
    Params P{};
    P.x = (const float*)d_in[0]; P.norm_w = (const float*)d_in[1]; P.w_in = (const float*)d_in[2]; P.lb_logits = (const float*)d_in[3]; P.hgrn_norm_w = (const float*)d_in[4];
    P.lq1 = (const float*)d_in[5]; P.lk1 = (const float*)d_in[6]; P.lq2 = (const float*)d_in[7]; P.lk2 = (const float*)d_in[8]; P.diff_norm_w = (const float*)d_in[9];
    P.w_out = (const float*)d_in[10]; P.final_norm_w = (const float*)d_in[11]; P.out = (float*)d_out; P.ws = (unsigned char*)d_ws;
    launch_phases(P, 0, N_PHASES, stream);
}
```

```cpp
#include <hip/hip_runtime.h>
#include <cstdio>
#include <cstdint>

typedef unsigned short bf16_t;
typedef float f32x4 __attribute__((ext_vector_type(4)));
typedef float f32x2 __attribute__((ext_vector_type(2)));
typedef unsigned u32x4 __attribute__((ext_vector_type(4)));
typedef unsigned u32x2 __attribute__((ext_vector_type(2)));
typedef __bf16 bf16x2_t __attribute__((ext_vector_type(2)));

constexpr int T = 16384, DM = 1024, DIN = 4096, DH = 512;
constexpr int NH = 4, HD = 128;
constexpr float NORM_EPS = 1e-6f, SUBLN_EPS = 1e-5f;
constexpr float LAMBDA_INIT = 0.2f;
constexpr float QSCALE = 0.125f * 1.4426950408889634f;

constexpr size_t MiB = 1u << 20;
constexpr size_t WS_CTL = 0;
constexpr size_t WS_COS = 1 * MiB, WS_SIN = 3 * MiB;
constexpr size_t WS_WOUT = 5 * MiB;
constexpr size_t WS_WIN = 8 * MiB;
constexpr size_t WS_XN = 16 * MiB;
constexpr size_t WS_MIX = 16 * MiB;
constexpr size_t WS_HQ = 48 * MiB;
constexpr size_t WS_G = 64 * MiB;
constexpr size_t WS_HI = 96 * MiB;
constexpr size_t WS_HG = 112 * MiB;
constexpr size_t WS_DQ = 128 * MiB;
constexpr size_t WS_DK = 144 * MiB;
constexpr size_t WS_DV = 160 * MiB;
constexpr size_t WS_DG = 176 * MiB;
constexpr size_t WS_US = 192 * MiB;
constexpr size_t WS_BS = 208 * MiB;
constexpr size_t WS_OTMP = 210 * MiB;
constexpr int CT_LAM = 16;
constexpr int CT_LB = 1024;
constexpr int CT_ROWSQ = 16384;

struct Params {
    const float* x; const float* norm_w; const float* w_in; const float* lb_logits; const float* hgrn_norm_w;
    const float* lq1; const float* lk1; const float* lq2; const float* lk2; const float* diff_norm_w; const float* w_out; const float* final_norm_w;
    float* out; unsigned char* ws;
};

__device__ __forceinline__ float bf2f(bf16_t h) { return __uint_as_float((unsigned)h << 16); }
__device__ __forceinline__ unsigned pk2(float lo, float hi) { f32x2 v = {lo, hi}; bf16x2_t b = __builtin_convertvector(v, bf16x2_t); return __builtin_bit_cast(unsigned, b); }
__device__ __forceinline__ bf16_t f2bf(float f) { return (bf16_t)(pk2(f, 0.f) & 0xffffu); }
__device__ __forceinline__ float wave_sum(float v) {
#pragma unroll
    for (int o = 1; o < 64; o <<= 1) v += __shfl_xor(v, o);
    return v;
}
__device__ __forceinline__ int opaque_tid() { int t = threadIdx.x; asm volatile("" : "+v"(t)); return t; }
__device__ __forceinline__ float sigmoidf_(float v) { return 1.0f / (1.0f + __expf(-v)); }
__device__ __forceinline__ float siluf_(float v) { return v / (1.0f + __expf(-v)); }

__host__ __device__ __forceinline__ int win_orig_col(int np) {
    if (np < 2048 || np >= 3072) return np;
    const int base = np & ~63, p = np & 63;
    return base + (p >> 1) + 32 * (p & 1);
}

__device__ __forceinline__ void epi8(const Params& P, int type, int t, int c, const float* v) {
    unsigned char* ws = P.ws;
    const size_t off = (size_t)t * DH + c;
    if (type == 1) {
        const float* lb = (const float*)(ws + WS_CTL) + CT_LB + c;
        float g[8];
#pragma unroll
        for (int j = 0; j < 8; ++j) { const float l = lb[j]; const float f = l + (1.0f - l) * sigmoidf_(v[j]); g[j] = __logf(f); }
        float* G = (float*)(ws + WS_G) + off;
        *(f32x4*)G = (f32x4){g[0], g[1], g[2], g[3]}; *(f32x4*)(G + 4) = (f32x4){g[4], g[5], g[6], g[7]};
        return;
    }
    float o[8];
    size_t base;
    if (type == 3 || type == 7) {
#pragma unroll
        for (int j = 0; j < 8; ++j) o[j] = siluf_(v[j]);
        base = (type == 3) ? WS_HG : WS_DG;
    } else if (type == 4 || type == 5) {
        const int i0 = (c & 63) >> 1;
        const f32x4 cs = *(const f32x4*)((const float*)(ws + WS_COS) + (size_t)t * 32 + i0);
        const f32x4 sn = *(const f32x4*)((const float*)(ws + WS_SIN) + (size_t)t * 32 + i0);
        const float sc = (type == 4) ? QSCALE : 1.0f;
#pragma unroll
        for (int j = 0; j < 4; ++j) { const float x1 = v[2 * j], x2 = v[2 * j + 1];
            o[2 * j] = (x1 * cs[j] - x2 * sn[j]) * sc; o[2 * j + 1] = (x2 * cs[j] + x1 * sn[j]) * sc; }
        base = (type == 4) ? WS_DQ : WS_DK;
    } else {
#pragma unroll
        for (int j = 0; j < 8; ++j) o[j] = v[j];
        base = (type == 0) ? WS_HQ : (type == 2) ? WS_HI : WS_DV;
    }
    u32x4 w = {pk2(o[0], o[1]), pk2(o[2], o[3]), pk2(o[4], o[5]), pk2(o[6], o[7])};
    *(u32x4*)((bf16_t*)(ws + base) + off) = w;
}

__device__ __forceinline__ void prologue_phase(const Params& P, int bid, int nblk, float* scr  ) {
    const int tid = threadIdx.x, lane = tid & 63, wave = tid >> 6, nwv = blockDim.x >> 6;
    const int gw = bid * nwv + wave, NGW = nblk * nwv;
    unsigned char* ws = P.ws;
    if (bid == 0 && wave == 0) {
        float a = P.lq1[lane] * P.lk1[lane], b = P.lq2[lane] * P.lk2[lane];
        a = wave_sum(a); b = wave_sum(b);
        if (lane == 0) ((float*)(ws + WS_CTL))[CT_LAM] = __expf(a) - __expf(b) + LAMBDA_INIT;
    }
    if (bid == 0) {
        for (int c = tid; c < DH; c += blockDim.x) { const float l0 = P.lb_logits[c], l1 = P.lb_logits[DH + c]; ((float*)(ws + WS_CTL))[CT_LB + c] = 1.0f / (1.0f + __expf(l1 - l0)); }
    }
    for (int idx = bid * blockDim.x + tid; idx < T * 32; idx += nblk * blockDim.x) {
        const int t = idx >> 5, i = idx & 31;
        const float invf = 1.0f / exp2f((float)i * (13.287712379549449f / 32.0f));
        const float ang = (float)t * invf;
        const double rev = (double)ang * 0.15915494309189535;
        const float fr = (float)(rev - __builtin_rint(rev));
        ((float*)(ws + WS_COS))[idx] = __builtin_amdgcn_cosf(fr);
        ((float*)(ws + WS_SIN))[idx] = __builtin_amdgcn_sinf(fr);
    }
    float* s = scr + wave * (64 * 33);
    constexpr int I_IN = (DM / 64) * (DIN / 32), I_OUT = (DM / 64) * (DM / 32);
    for (int it = gw; it < I_IN + I_OUT; it += NGW) {
        const bool isin = it < I_IN; const int r = isin ? it : it - I_IN;
        const float* W = isin ? P.w_in : P.w_out; const int N = isin ? DIN : DM;
        bf16_t* WT = (bf16_t*)(ws + (isin ? WS_WIN : WS_WOUT));
        const int nblkn = N / 32, kb = r / nblkn, nb = r % nblkn, k0 = 64 * kb, n0 = 32 * nb;
        const int ncol = isin ? win_orig_col(n0 + (lane & 31)) : n0 + (lane & 31);
#pragma unroll 8
        for (int i = 0; i < 32; ++i) { const int kk = 2 * i + (lane >> 5); s[kk * 33 + (lane & 31)] = W[(size_t)(k0 + kk) * N + ncol]; }
        __builtin_amdgcn_wave_barrier(); asm volatile("s_waitcnt lgkmcnt(0)" ::: "memory");
        const int c = lane & 7;
#pragma unroll
        for (int j = 0; j < 4; ++j) { const int n = (lane >> 3) + 8 * j; const float* q = s + (8 * c) * 33 + n;
            u32x4 o; o.x = pk2(q[0 * 33], q[1 * 33]); o.y = pk2(q[2 * 33], q[3 * 33]); o.z = pk2(q[4 * 33], q[5 * 33]); o.w = pk2(q[6 * 33], q[7 * 33]);
            *(u32x4*)(WT + (size_t)(n0 + n) * DM + k0 + 8 * c) = o; }
        __builtin_amdgcn_wave_barrier(); asm volatile("s_waitcnt lgkmcnt(0)" ::: "memory");
    }
    for (int m = gw; m < T; m += NGW) {
        const f32x4* xr = (const f32x4*)(P.x + (size_t)m * DM) + lane; const f32x4* wr = (const f32x4*)P.norm_w + lane;
        f32x4 v[4]; float ss = 0.f;
#pragma unroll
        for (int j = 0; j < 4; ++j) { v[j] = xr[64 * j]; ss += (v[j].x * v[j].x + v[j].y * v[j].y) + (v[j].z * v[j].z + v[j].w * v[j].w); }
        const float rstd = 1.0f / sqrtf(wave_sum(ss) * (1.0f / DM) + NORM_EPS);
        u32x2* o8 = (u32x2*)((bf16_t*)(ws + WS_XN) + (size_t)m * DM) + lane;
#pragma unroll
        for (int j = 0; j < 4; ++j) { const f32x4 w = wr[64 * j]; u32x2 o; o.x = pk2(v[j].x * rstd * w.x, v[j].y * rstd * w.y); o.y = pk2(v[j].z * rstd * w.z, v[j].w * rstd * w.w); o8[64 * j] = o; }
    }
}

__global__ void __launch_bounds__(512) k_prologue(Params P) {
    __shared__ float scr[8 * 64 * 33];
    prologue_phase(P, blockIdx.x, gridDim.x, scr);
}

__global__ void __launch_bounds__(256) k_naive_gemm_in(Params P) {
    __shared__ float As[64][33], Bs[64][33];
    const bf16_t* A = (const bf16_t*)(P.ws + WS_XN); const bf16_t* B = (const bf16_t*)(P.ws + WS_WIN);
    const int tid = threadIdx.x, ty = tid >> 3, tx = tid & 7, m0 = blockIdx.y * 64, n0 = blockIdx.x * 64;
    float acc[2][8] = {};
    const int lr = tid >> 2, lk = (tid & 3) * 8;
    for (int k0 = 0; k0 < DM; k0 += 32) {
        const u32x4 a = *(const u32x4*)(A + (size_t)(m0 + lr) * DM + k0 + lk), b = *(const u32x4*)(B + (size_t)(n0 + lr) * DM + k0 + lk);
#pragma unroll
        for (int j = 0; j < 4; ++j) { As[lr][lk + 2 * j] = __uint_as_float(a[j] << 16); As[lr][lk + 2 * j + 1] = __uint_as_float(a[j] & 0xffff0000u);
            Bs[lr][lk + 2 * j] = __uint_as_float(b[j] << 16); Bs[lr][lk + 2 * j + 1] = __uint_as_float(b[j] & 0xffff0000u); }
        __syncthreads();
#pragma unroll 8
        for (int k = 0; k < 32; ++k) { const float a0 = As[2 * ty][k], a1 = As[2 * ty + 1][k];
#pragma unroll
            for (int j = 0; j < 8; ++j) { const float bv = Bs[8 * tx + j][k]; acc[0][j] += a0 * bv; acc[1][j] += a1 * bv; } }
        __syncthreads();
    }
    const int nc = n0 + 8 * tx, type = nc >> 9, c = nc & 511;
    epi8(P, type, m0 + 2 * ty, c, acc[0]); epi8(P, type, m0 + 2 * ty + 1, c, acc[1]);
}

__global__ void __launch_bounds__(128) k_naive_hgrn(Params P) {
    __shared__ float qs[32][128], fs[32][128];
    const int h = blockIdx.x, e = threadIdx.x;
    const bf16_t* HQ = (const bf16_t*)(P.ws + WS_HQ); const float* G = (const float*)(P.ws + WS_G); const bf16_t* HI = (const bf16_t*)(P.ws + WS_HI);
    float* OT = (float*)(P.ws + WS_OTMP);
    float S[128];
#pragma unroll
    for (int d = 0; d < 128; ++d) S[d] = 0.f;
    for (int t0 = 0; t0 < T; t0 += 32) {
        for (int i = 0; i < 32; ++i) { qs[i][e] = bf2f(HQ[(size_t)(t0 + i) * DH + h * HD + e]); fs[i][e] = __expf(G[(size_t)(t0 + i) * DH + h * HD + e]); }
        __syncthreads();
        for (int i = 0; i < 32; ++i) {
            const float v = bf2f(HI[(size_t)(t0 + i) * DH + h * HD + e]); float o = 0.f;
#pragma unroll
            for (int d = 0; d < 128; ++d) { const float f = fs[i][d]; S[d] = f * S[d] + (1.0f - f) * v; o += qs[i][d] * S[d]; }
            OT[(size_t)(t0 + i) * DH + h * HD + e] = o;
        }
        __syncthreads();
    }
}
__global__ void __launch_bounds__(256) k_naive_hgrn_norm(Params P) {
    const int lane = threadIdx.x & 63, gw = (blockIdx.x * blockDim.x + threadIdx.x) >> 6, ngw = (gridDim.x * blockDim.x) >> 6;
    const float* OT = (const float*)(P.ws + WS_OTMP); const bf16_t* HG = (const bf16_t*)(P.ws + WS_HG); bf16_t* MIX = (bf16_t*)(P.ws + WS_MIX);
    for (int r = gw; r < T * NH; r += ngw) {
        const int t = r >> 2, h = r & 3; const size_t off = (size_t)t * DH + h * HD + 2 * lane;
        const float a = OT[off], b = OT[off + 1];
        const float rs = 1.0f / sqrtf(wave_sum(a * a + b * b) * (1.0f / HD) + NORM_EPS);
        const float y0 = a * rs * P.hgrn_norm_w[2 * lane] * bf2f(HG[off]), y1 = b * rs * P.hgrn_norm_w[2 * lane + 1] * bf2f(HG[off + 1]);
        *(unsigned*)(MIX + (size_t)t * DM + h * HD + 2 * lane) = pk2(y0, y1);
    }
}

__global__ void __launch_bounds__(256) k_naive_attn(Params P) {
    __shared__ float Kt[32][128], Vt[32][128];
    const int tid = threadIdx.x, tl = tid >> 2, vq = tid & 3, h = blockIdx.y, t0 = (gridDim.x - 1 - blockIdx.x) * 64, t = t0 + tl;
    const bf16_t* DQ = (const bf16_t*)(P.ws + WS_DQ); const bf16_t* DK = (const bf16_t*)(P.ws + WS_DK); const bf16_t* DV = (const bf16_t*)(P.ws + WS_DV);
    const bf16_t* DG = (const bf16_t*)(P.ws + WS_DG); bf16_t* MIX = (bf16_t*)(P.ws + WS_MIX);
    const float lam = ((const float*)(P.ws + WS_CTL))[CT_LAM];
    float q1[64], q2[64], o1[32], o2[32];
#pragma unroll
    for (int d = 0; d < 64; ++d) { q1[d] = bf2f(DQ[(size_t)t * DH + h * HD + d]); q2[d] = bf2f(DQ[(size_t)t * DH + h * HD + 64 + d]); }
#pragma unroll
    for (int j = 0; j < 32; ++j) { o1[j] = 0.f; o2[j] = 0.f; }
    float m1 = -1e30f, m2 = -1e30f, l1 = 0.f, l2 = 0.f;
    const int nt = (t0 + 64) / 32;
    for (int kt = 0; kt < nt; ++kt) {
        const int s0 = kt * 32;
        for (int i = tid; i < 32 * 128; i += 256) { const int r = i >> 7, c = i & 127; Kt[r][c] = bf2f(DK[(size_t)(s0 + r) * DH + h * HD + c]); Vt[r][c] = bf2f(DV[(size_t)(s0 + r) * DH + h * HD + c]); }
        __syncthreads();
        for (int s = 0; s < 32; ++s) {
            if (s0 + s <= t) {
                float a = 0.f, b = 0.f;
#pragma unroll
                for (int d = 0; d < 64; ++d) { a += q1[d] * Kt[s][d]; b += q2[d] * Kt[s][64 + d]; }
                { const float mn = fmaxf(m1, a), al = exp2f(m1 - mn), p = exp2f(a - mn); l1 = l1 * al + p; m1 = mn;
#pragma unroll
                  for (int j = 0; j < 32; ++j) o1[j] = o1[j] * al + p * Vt[s][vq * 32 + j]; }
                { const float mn = fmaxf(m2, b), al = exp2f(m2 - mn), p = exp2f(b - mn); l2 = l2 * al + p; m2 = mn;
#pragma unroll
                  for (int j = 0; j < 32; ++j) o2[j] = o2[j] * al + p * Vt[s][vq * 32 + j]; }
            }
        }
        __syncthreads();
    }
    const float i1 = 1.0f / l1, i2 = lam / l2; float ss = 0.f;
#pragma unroll
    for (int j = 0; j < 32; ++j) { o1[j] = o1[j] * i1 - o2[j] * i2; ss += o1[j] * o1[j]; }
    ss += __shfl_xor(ss, 1); ss += __shfl_xor(ss, 2);
    const float rs = (1.0f - LAMBDA_INIT) / sqrtf(ss * (1.0f / HD) + SUBLN_EPS);
#pragma unroll
    for (int j = 0; j < 32; j += 2) {
        const int c = vq * 32 + j;
        const float y0 = o1[j] * rs * P.diff_norm_w[c] * bf2f(DG[(size_t)t * DH + h * HD + c]), y1 = o1[j + 1] * rs * P.diff_norm_w[c + 1] * bf2f(DG[(size_t)t * DH + h * HD + c + 1]);
        *(unsigned*)(MIX + (size_t)t * DM + DH + h * HD + c) = pk2(y0, y1);
    }
}

__global__ void __launch_bounds__(256) k_naive_gemm_out(Params P) {
    __shared__ float As[64][33], Bs[32][65];
    const bf16_t* A = (const bf16_t*)(P.ws + WS_MIX);
    const int tid = threadIdx.x, ty = tid >> 3, tx = tid & 7, m0 = blockIdx.y * 64, n0 = blockIdx.x * 64;
    float acc[2][8] = {};
    const int lr = tid >> 2, lk = (tid & 3) * 8;
    for (int k0 = 0; k0 < DM; k0 += 32) {
        const u32x4 a = *(const u32x4*)(A + (size_t)(m0 + lr) * DM + k0 + lk);
#pragma unroll
        for (int j = 0; j < 4; ++j) { As[lr][lk + 2 * j] = __uint_as_float(a[j] << 16); As[lr][lk + 2 * j + 1] = __uint_as_float(a[j] & 0xffff0000u); }
        for (int i = tid; i < 32 * 64; i += 256) { const int kk = i >> 6, nn = i & 63; Bs[kk][nn] = P.w_out[(size_t)(k0 + kk) * DM + n0 + nn]; }
        __syncthreads();
#pragma unroll 8
        for (int k = 0; k < 32; ++k) { const float a0 = As[2 * ty][k], a1 = As[2 * ty + 1][k];
#pragma unroll
            for (int j = 0; j < 8; ++j) { const float bv = Bs[k][8 * tx + j]; acc[0][j] += a0 * bv; acc[1][j] += a1 * bv; } }
        __syncthreads();
    }
#pragma unroll
    for (int r = 0; r < 2; ++r) { const size_t off = (size_t)(m0 + 2 * ty + r) * DM + n0 + 8 * tx;
#pragma unroll
        for (int j = 0; j < 8; ++j) P.out[off + j] = P.x[off + j] + acc[r][j]; }
}
__global__ void __launch_bounds__(256) k_final_norm(Params P) {
    const int lane = threadIdx.x & 63, gw = (blockIdx.x * blockDim.x + threadIdx.x) >> 6, ngw = (gridDim.x * blockDim.x) >> 6;
    for (int m = gw; m < T; m += ngw) {
        f32x4* yr = (f32x4*)(P.out + (size_t)m * DM) + lane; const f32x4* wr = (const f32x4*)P.final_norm_w + lane;
        f32x4 v[4]; float ss = 0.f;
#pragma unroll
        for (int j = 0; j < 4; ++j) { v[j] = yr[64 * j]; ss += (v[j].x * v[j].x + v[j].y * v[j].y) + (v[j].z * v[j].z + v[j].w * v[j].w); }
        const float rstd = 1.0f / sqrtf(wave_sum(ss) * (1.0f / DM) + NORM_EPS);
#pragma unroll
        for (int j = 0; j < 4; ++j) { const f32x4 w = wr[64 * j]; yr[64 * j] = (f32x4){v[j].x * rstd * w.x, v[j].y * rstd * w.y, v[j].z * rstd * w.z, v[j].w * rstd * w.w}; }
    }
}


namespace pg8 {
#define PG8_LAS __attribute__((address_space(3)))
typedef short bf16x8 __attribute__((ext_vector_type(8)));
constexpr int BM = 256, BK = 64, HALF = 128, HTB = HALF * BK * 2  , STAGE_BYTES = 8 * HTB, NXCD = 8, WGM = 8;
__host__ __device__ __forceinline__ int lds_byte(int r, int c) { const int st = (r >> 4) * 2 + (c >> 5), rr = r & 15, cc = c & 31, ob = rr * 64 + cc * 2; return st * 1024 + (ob ^ (((ob >> 9) & 1) << 5)); }
__host__ __device__ __forceinline__ void stage_rc(int b, int& R, int& C) { const int st = b / 1024, sb = b % 1024, swz = sb ^ (((sb >> 9) & 1) << 5); R = (st >> 1) * 16 + swz / 64; C = (st & 1) * 32 + (swz % 64) / 2; }
__host__ __device__ __forceinline__ int perm32(int rho) { const int n = rho >> 4, i = rho & 15; return 8 * (i >> 2) + 4 * n + (i & 3); }
struct Unit { int pm, pn; };
struct Gemm { const bf16_t* A; const bf16_t* Bt; int M, N, K; };
struct StaticOrder {
    int nM, nN, nwg, G, c;
    __host__ __device__ void init(int M, int N, int G_, int c_) { nM = M / BM; nN = N / BM; nwg = nM * nN; G = G_; c = c_; }
    __host__ __device__ bool next(int i, Unit& u) const {
        const long L = (long)i * G + c; if (L >= nwg) return false;
        int wgid = (int)L; { const int q = nwg / NXCD, r = nwg % NXCD, xcd = wgid % NXCD, off = wgid / NXCD; wgid = (xcd < r ? xcd * (q + 1) : r * (q + 1) + (xcd - r) * q) + off; }
        const int nig = WGM * nN, gid = wgid / nig, fm = gid * WGM, gsz = (nM - fm) < WGM ? (nM - fm) : WGM;
        u.pm = fm + ((wgid % nig) % gsz); u.pn = (wgid % nig) / gsz; return true;
    }
    __device__ __forceinline__ void a_ready(const Unit&) const {}
    __device__ __forceinline__ void done(const Unit&) const {}
};
template <class Epi, class Sched, bool ALIGN_EPI = false, bool SP2 = false>
__device__ __forceinline__ void gemm_phase(PG8_LAS unsigned char* lds, const Gemm g, const Sched& S, const Epi& E) {
    const int tid = opaque_tid(), wid = __builtin_amdgcn_readfirstlane(tid >> 6), lane = tid & 63, wr = wid >> 2, wc = wid & 3, fr = lane & 15, fq = lane >> 4;
    const int K = g.K, nt = K / BK;
    unsigned voffA[2], voffB[2];
#pragma unroll
    for (int i = 0; i < 2; ++i) { int R, C; stage_rc(tid * 16 + i * 8192, R, C); const int Rb = Epi::PERM ? ((R & ~31) + perm32(R & 31)) : R;
        voffA[i] = (unsigned)(R * K + C) * 2u; voffB[i] = (unsigned)(Rb * K + C) * 2u; }
    const size_t kstep = (size_t)(BK * 2);
    const size_t hstep = (size_t)HALF * K * 2;
    const size_t tstep = 2 * hstep;
    const unsigned ldsw = (unsigned)wid * 1024u;
    const int aoff = lds_byte(wr * 64 + fr, fq * 8), boff = lds_byte(wc * 32 + fr, fq * 8);
#define PG8_SA(b, h) (((b) * 2 + (h)) * HTB)
#define PG8_SB(b, h) ((4 + (b) * 2 + (h)) * HTB)
#define PG8_STAGE(bufoff, gbase, voff) do { _Pragma("unroll") for (int _i = 0; _i < 2; ++_i) \
        __builtin_amdgcn_global_load_lds((const unsigned*)((const char*)(gbase) + (voff)[_i]), (PG8_LAS unsigned*)(lds + (bufoff) + ldsw + _i * 8192), 16, 0, 0); } while (0)
#define PG8_LDA(dst, b, h) do { _Pragma("unroll") for (int m = 0; m < 4; ++m) _Pragma("unroll") for (int k = 0; k < 2; ++k) dst[m][k] = *(const PG8_LAS bf16x8*)(lds + PG8_SA(b, h) + aoff + m * 2048 + k * 1024); } while (0)
#define PG8_LDB(dst, b, h) do { _Pragma("unroll") for (int n = 0; n < 2; ++n) _Pragma("unroll") for (int k = 0; k < 2; ++k) dst[n][k] = *(const PG8_LAS bf16x8*)(lds + PG8_SB(b, h) + boff + n * 2048 + k * 1024); } while (0)
#define PG8_MMA(ai, bj, At, Bt) do { __builtin_amdgcn_s_setprio(1); _Pragma("unroll") for (int m = 0; m < 4; ++m) _Pragma("unroll") for (int n = 0; n < 2; ++n) _Pragma("unroll") for (int k = 0; k < 2; ++k) \
        acc[ai][bj][m][n] = __builtin_amdgcn_mfma_f32_16x16x32_bf16(Bt[n][k], At[m][k], acc[ai][bj][m][n], 0, 0, 0); __builtin_amdgcn_s_setprio(0); } while (0)
#define PG8_WAIT_V(n) asm volatile("s_waitcnt vmcnt(" #n ")" ::: "memory")
#define PG8_WAIT_L(n) asm volatile("s_waitcnt lgkmcnt(" #n ")" ::: "memory")
#define PG8_BAR __builtin_amdgcn_s_barrier()
#define PG8_SCHED __builtin_amdgcn_sched_barrier(0)
    Unit cur, nxt; int ui = 0;
    if (!S.next(0, cur)) return;
    f32x4 acc[2][2][4][2];
#pragma unroll
    for (int a = 0; a < 2; ++a)
#pragma unroll
        for (int b = 0; b < 2; ++b)
#pragma unroll
            for (int m = 0; m < 4; ++m)
#pragma unroll
                for (int n = 0; n < 2; ++n) acc[a][b][m][n] = (f32x4){0.f, 0.f, 0.f, 0.f};
    bf16x8 At[4][2], B0[2][2], B1[2][2];
    const char* cA = (const char*)g.A + (size_t)cur.pm * tstep; const char* cB = (const char*)g.Bt + (size_t)cur.pn * tstep;
    S.a_ready(cur);
    if constexpr (SP2) {
        PG8_STAGE(PG8_SB(0, 0), cB, voffB); PG8_STAGE(PG8_SB(0, 1), cB + hstep, voffB); PG8_STAGE(PG8_SA(0, 0), cA, voffA); PG8_STAGE(PG8_SA(0, 1), cA + hstep, voffA);
        if (wr == 1) PG8_BAR;
        PG8_WAIT_V(2); PG8_BAR;
        PG8_STAGE(PG8_SB(1, 0), cB + kstep, voffB); PG8_STAGE(PG8_SA(1, 0), cA + kstep, voffA); PG8_STAGE(PG8_SB(1, 1), cB + hstep + kstep, voffB);
        PG8_WAIT_V(6); PG8_BAR;
    } else {
        PG8_STAGE(PG8_SB(0, 0), cB, voffB); PG8_STAGE(PG8_SA(0, 0), cA, voffA); PG8_STAGE(PG8_SB(0, 1), cB + hstep, voffB); PG8_STAGE(PG8_SA(0, 1), cA + hstep, voffA);
        if (wr == 1) PG8_BAR;
        PG8_WAIT_V(4); PG8_BAR;
        PG8_STAGE(PG8_SB(1, 0), cB + kstep, voffB); PG8_STAGE(PG8_SA(1, 0), cA + kstep, voffA); PG8_STAGE(PG8_SB(1, 1), cB + hstep + kstep, voffB);
        PG8_WAIT_V(6); PG8_BAR;
    }
    for (;;) {
        const bool has_next = S.next(ui + 1, nxt);
        const char* nA = has_next ? (const char*)g.A + (size_t)nxt.pm * tstep : cA; const char* nB = has_next ? (const char*)g.Bt + (size_t)nxt.pn * tstep : cB;
        for (int t = 0; t < nt; t += 2) {
            const bool last = (t == nt - 2);
            const char* a1 = cA + (size_t)(t + 1) * kstep;
            const char* a2 = last ? nA : cA + (size_t)(t + 2) * kstep; const char* b2 = last ? nB : cB + (size_t)(t + 2) * kstep;
            const char* a3 = a2 + kstep; const char* b3 = b2 + kstep;
            if (last && has_next) S.a_ready(nxt);
            if constexpr (SP2) {
            PG8_LDB(B0, 0, 0); PG8_LDB(B1, 0, 1); PG8_SCHED; PG8_LDA(At, 0, 0); PG8_STAGE(PG8_SA(1, 1), a1 + hstep, voffA);
            PG8_WAIT_V(8); PG8_WAIT_L(0); PG8_BAR; PG8_MMA(0, 0, At, B0); PG8_MMA(0, 1, At, B1); PG8_BAR; PG8_SCHED;
            PG8_LDA(At, 0, 1); PG8_STAGE(PG8_SB(0, 0), b2, voffB); PG8_STAGE(PG8_SB(0, 1), b2 + hstep, voffB); PG8_STAGE(PG8_SA(0, 0), a2, voffA);
            PG8_WAIT_V(8); PG8_WAIT_L(0); PG8_BAR; PG8_MMA(1, 0, At, B0); PG8_MMA(1, 1, At, B1); PG8_BAR; PG8_SCHED;
            PG8_LDB(B0, 1, 0); PG8_LDB(B1, 1, 1); PG8_SCHED; PG8_LDA(At, 1, 0); PG8_STAGE(PG8_SA(0, 1), a2 + hstep, voffA);
            PG8_WAIT_V(8); PG8_WAIT_L(0); PG8_BAR; PG8_MMA(0, 0, At, B0); PG8_MMA(0, 1, At, B1); PG8_BAR; PG8_SCHED;
            PG8_LDA(At, 1, 1); PG8_STAGE(PG8_SB(1, 0), b3, voffB); PG8_STAGE(PG8_SB(1, 1), b3 + hstep, voffB); PG8_STAGE(PG8_SA(1, 0), a3, voffA);
            PG8_WAIT_V(8); PG8_WAIT_L(0); PG8_BAR; PG8_MMA(1, 0, At, B0); PG8_MMA(1, 1, At, B1); PG8_BAR; PG8_SCHED;
            } else {
            PG8_LDB(B0, 0, 0); PG8_SCHED; PG8_LDA(At, 0, 0); PG8_STAGE(PG8_SA(1, 1), a1 + hstep, voffA);
            PG8_WAIT_L(8); PG8_BAR; PG8_WAIT_L(0); PG8_MMA(0, 0, At, B0); PG8_BAR; PG8_SCHED;
            PG8_LDB(B1, 0, 1); PG8_STAGE(PG8_SB(0, 0), b2, voffB);
            PG8_BAR; PG8_WAIT_L(0); PG8_MMA(0, 1, At, B1); PG8_BAR;
            PG8_LDA(At, 0, 1); PG8_STAGE(PG8_SA(0, 0), a2, voffA);
            PG8_BAR; PG8_WAIT_L(0); PG8_MMA(1, 0, At, B0); PG8_BAR; PG8_SCHED;
            PG8_STAGE(PG8_SB(0, 1), b2 + hstep, voffB);
            PG8_WAIT_V(6); PG8_BAR; PG8_MMA(1, 1, At, B1); PG8_BAR;
            PG8_LDB(B0, 1, 0); PG8_SCHED; PG8_LDA(At, 1, 0); PG8_STAGE(PG8_SA(0, 1), a2 + hstep, voffA);
            PG8_WAIT_L(8); PG8_BAR; PG8_WAIT_L(0); PG8_MMA(0, 0, At, B0); PG8_BAR; PG8_SCHED;
            PG8_LDB(B1, 1, 1); PG8_STAGE(PG8_SB(1, 0), b3, voffB);
            PG8_BAR; PG8_WAIT_L(0); PG8_MMA(0, 1, At, B1); PG8_BAR;
            PG8_LDA(At, 1, 1); PG8_STAGE(PG8_SA(1, 0), a3, voffA);
            PG8_BAR; PG8_WAIT_L(0); PG8_MMA(1, 0, At, B0); PG8_BAR; PG8_SCHED;
            PG8_STAGE(PG8_SB(1, 1), b3 + hstep, voffB);
            PG8_WAIT_V(6); PG8_BAR; PG8_MMA(1, 1, At, B1); PG8_BAR;
            }
        }
        if constexpr (ALIGN_EPI) { if (wr == 0) PG8_BAR; }
        if constexpr (!Epi::AFTER_DRAIN) { E(acc, cur, wr, wc, fr, fq); S.done(cur); }
        if (!has_next) break;
#pragma unroll
        for (int a = 0; a < 2; ++a)
#pragma unroll
            for (int b = 0; b < 2; ++b)
#pragma unroll
                for (int m = 0; m < 4; ++m)
#pragma unroll
                    for (int n = 0; n < 2; ++n) acc[a][b][m][n] = (f32x4){0.f, 0.f, 0.f, 0.f};
        cur = nxt; cA = nA; cB = nB; ++ui;
        if constexpr (ALIGN_EPI) { if (wr == 1) PG8_BAR; }
    }
    PG8_WAIT_V(0);
    if constexpr (!ALIGN_EPI) { if (wr == 0) PG8_BAR; }
    PG8_BAR;
    if constexpr (Epi::AFTER_DRAIN) { E.fused(acc, cur, wr, wc, fr, fq, lds, wid, lane); S.done(cur); }
#undef PG8_SA
#undef PG8_SB
#undef PG8_STAGE
#undef PG8_LDA
#undef PG8_LDB
#undef PG8_MMA
#undef PG8_WAIT_V
#undef PG8_WAIT_L
#undef PG8_BAR
#undef PG8_SCHED
}
}

struct EpiIn {
    static constexpr bool PERM = true, AFTER_DRAIN = false;
    Params P;
    template <int TYPE> __device__ __forceinline__ void run(const f32x4 (&acc)[2][2][4][2], const pg8::Unit& u, int wr, int wc, int fr, int fq) const {
        const int row0 = u.pm * pg8::BM + wr * 64 + fr, c0 = (u.pn & 1) * 256 + wc * 32 + 8 * fq;
#pragma unroll
        for (int ai = 0; ai < 2; ++ai)
#pragma unroll
            for (int m = 0; m < 4; ++m)
#pragma unroll
                for (int bj = 0; bj < 2; ++bj) {
                    const f32x4 v0 = acc[ai][bj][m][0], v1 = acc[ai][bj][m][1];
                    const float v[8] = {v0[0], v0[1], v0[2], v0[3], v1[0], v1[1], v1[2], v1[3]};
                    epi8(P, TYPE, row0 + ai * pg8::HALF + m * 16, c0 + bj * pg8::HALF, v);
                }
    }
    __device__ __forceinline__ void operator()(const f32x4 (&acc)[2][2][4][2], const pg8::Unit& u, int wr, int wc, int fr, int fq) const {
        switch (u.pn >> 1) {
            case 0: run<0>(acc, u, wr, wc, fr, fq); break; case 1: run<1>(acc, u, wr, wc, fr, fq); break;
            case 2: run<2>(acc, u, wr, wc, fr, fq); break; case 3: run<3>(acc, u, wr, wc, fr, fq); break;
            case 4: run<4>(acc, u, wr, wc, fr, fq); break; case 5: run<5>(acc, u, wr, wc, fr, fq); break;
            case 6: run<6>(acc, u, wr, wc, fr, fq); break; default: run<7>(acc, u, wr, wc, fr, fq); break;
        }
    }
};
struct EpiOut {
    static constexpr bool PERM = false, AFTER_DRAIN = false;
    Params P;
    __device__ __forceinline__ void operator()(const f32x4 (&acc)[2][2][4][2], const pg8::Unit& u, int wr, int wc, int fr, int fq) const {
        float* rowsq = (float*)(P.ws + WS_CTL) + CT_ROWSQ;
        const int col0 = u.pn * pg8::BM + wc * 32 + 4 * fq;
#pragma unroll
        for (int ai = 0; ai < 2; ++ai)
#pragma unroll
            for (int m = 0; m < 4; ++m) {
                const int r = u.pm * pg8::BM + ai * pg8::HALF + wr * 64 + m * 16 + fr; const size_t off = (size_t)r * DM + col0; float ss = 0.f;
#pragma unroll
                for (int bj = 0; bj < 2; ++bj)
#pragma unroll
                    for (int n = 0; n < 2; ++n) { const f32x4 xv = *(const f32x4*)(P.x + off + bj * pg8::HALF + n * 16); const f32x4 y = xv + acc[ai][bj][m][n];
                        ss += (y[0] * y[0] + y[1] * y[1]) + (y[2] * y[2] + y[3] * y[3]); *(f32x4*)(P.out + off + bj * pg8::HALF + n * 16) = y; }
                ss += __shfl_xor(ss, 16); ss += __shfl_xor(ss, 32);
                if (fq == 0) atomicAdd(rowsq + r, ss);
            }
    }
};

namespace att {
typedef short bf16x8 __attribute__((ext_vector_type(8)));
typedef short s16x4 __attribute__((ext_vector_type(4)));
typedef float f32x16 __attribute__((ext_vector_type(16)));
constexpr int QBLK = 32, KVBLK = 64, QB = 128;
constexpr int SHM_V = KVBLK * 128 * 2, SHM_K = KVBLK * 128 * 2;
constexpr int OFF_V = 0, OFF_K = 2 * SHM_V, OFF_WS = 2 * SHM_V + 2 * SHM_K, OFF_X = OFF_WS + 8 * 64 * 4, XW = 4224  , LDS_BYTES = OFF_X + 4 * XW * 4;
constexpr float THR = 8.f;
#define KSWZ(row, colB) ((row) * 256 + ((colB) ^ (((row) & 7) << 4)))
#define SBAR() __builtin_amdgcn_sched_barrier(0)
__device__ __forceinline__ int v_st(int k, int c) { const int kk = (k & ~0xC) | ((k & 4) << 1) | ((k & 8) >> 1); return ((kk >> 3) * 4 + (c >> 5)) * 512 + ((kk & 7) * 32 + (c & 31)) * 2; }
__device__ __forceinline__ int v_rd_base(int lane) { return ((lane & 3) << 3) | (((lane >> 2) & 3) << 6) | (((lane >> 4) & 1) << 5) | (((lane >> 5) & 1) << 8); }
constexpr int v_rd_off(int d0, int ks, int half) { return d0 * 512 + ks * 4096 + half * 2048; }
__device__ __forceinline__ int crow(int r, int hi) { return (r & 3) + 8 * (r >> 2) + 4 * hi; }
__device__ __forceinline__ unsigned cvtpk(float lo, float hi) { unsigned r; asm volatile("v_cvt_pk_bf16_f32 %0, %1, %2" : "=v"(r) : "v"(lo), "v"(hi)); return r; }
__device__ __forceinline__ void mask_tile(f32x16& p0, f32x16& p1, int dq) {
    const float NEG = -__builtin_inff();
#pragma unroll
    for (int r = 0; r < 16; ++r) { const int c = (r & 3) + 8 * (r >> 2); if (dq - c < 0) p0[r] = NEG; if (dq - c - 32 < 0) p1[r] = NEG; }
}
__device__ __forceinline__ float rowmax32(const f32x16& p0, const f32x16& p1) {
    float a = fmaxf(fmaxf(p0[0], p0[1]), p1[0]), b = fmaxf(fmaxf(p0[2], p0[3]), p1[1]); a = fmaxf(fmaxf(a, p1[2]), p1[3]);
#pragma unroll
    for (int r = 4; r < 16; r += 4) { a = fmaxf(fmaxf(a, p0[r]), p0[r + 1]); b = fmaxf(fmaxf(b, p0[r + 2]), p0[r + 3]); a = fmaxf(fmaxf(a, p1[r]), p1[r + 1]); b = fmaxf(fmaxf(b, p1[r + 2]), p1[r + 3]); }
    float m = fmaxf(a, b);
    auto rr = __builtin_amdgcn_permlane32_swap(__float_as_uint(m), __float_as_uint(m), false, false);
    return fmaxf(__uint_as_float(rr[0]), __uint_as_float(rr[1]));
}
template <bool FIRST>
__device__ __forceinline__ float decide(f32x16& p0, f32x16& p1, float& l_reg, f32x16& negm) {
    const float rm = rowmax32(p0, p1); float alpha = 1.f;
    if (FIRST || __builtin_expect(__any(rm > THR), 0)) {
        const float dl = FIRST ? rm : fmaxf(rm, 0.f); const float nm = negm[0] - dl;
#pragma unroll
        for (int r = 0; r < 16; ++r) { p0[r] -= dl; p1[r] -= dl; }
#pragma unroll
        for (int r = 0; r < 16; ++r) negm[r] = nm;
        asm volatile("" : "+v"(negm));
        if (!FIRST) { alpha = __builtin_amdgcn_exp2f(-dl); l_reg *= alpha; }
    }
    return alpha;
}
__device__ __forceinline__ void finishP(const f32x16& p0, const f32x16& p1, float& l_reg, bf16x8& pa0, bf16x8& pa1, bf16x8& pa2, bf16x8& pa3) {
    float s0 = p0[0] + p0[1], s1 = p1[0] + p1[1];
#pragma unroll
    for (int r = 2; r < 16; r += 2) { s0 += p0[r] + p0[r + 1]; s1 += p1[r] + p1[r + 1]; }
    l_reg += s0 + s1;
#define PK4(P, B_, OUT) do { unsigned a0 = cvtpk(P[B_+0], P[B_+1]), a1 = cvtpk(P[B_+2], P[B_+3]);                          \
        unsigned b0 = cvtpk(P[B_+4], P[B_+5]), b1 = cvtpk(P[B_+6], P[B_+7]);                                             \
        auto r0 = __builtin_amdgcn_permlane32_swap(a0, b0, false, false); auto r1 = __builtin_amdgcn_permlane32_swap(a1, b1, false, false); \
        u32x4 w = {r0[0], r1[0], r0[1], r1[1]}; OUT = *reinterpret_cast<bf16x8*>(&w); } while (0)
    PK4(p0, 0, pa0); PK4(p0, 8, pa1); PK4(p1, 0, pa2); PK4(p1, 8, pa3);
#undef PK4
}
template <int KB>
__device__ __forceinline__ void qkt(f32x16& p0, f32x16& p1, const char* K_lds, int kx, const char* qf, const f32x16& negm) {
    p0 = negm; p1 = negm;
#pragma unroll
    for (int d0 = 0; d0 < 4; ++d0) { const char* a = K_lds + KB * SHM_K + (kx ^ (d0 * 32));
        bf16x8 b0 = *reinterpret_cast<const bf16x8*>(a);
        bf16x8 b1 = *reinterpret_cast<const bf16x8*>(a + 32 * 256);
        const bf16x8 q = *reinterpret_cast<const bf16x8*>(qf + d0 * 1024);
        p0 = __builtin_amdgcn_mfma_f32_32x32x16_bf16(b0, q, p0, 0, 0, 0);
        p1 = __builtin_amdgcn_mfma_f32_32x32x16_bf16(b1, q, p1, 0, 0, 0); }
}
typedef short v4i16_t __attribute__((ext_vector_type(4)));
typedef __attribute__((address_space(3))) const char* lds_cptr;
__device__ __forceinline__ s16x4 vtr(lds_cptr p) { return __builtin_bit_cast(s16x4, __builtin_amdgcn_ds_read_tr16_b64_v4i16((__attribute__((address_space(3))) v4i16_t*)p)); }
template <int VB, bool EXPS>
__device__ __forceinline__ void pv_tile(f32x16* o, lds_cptr vp0, bf16x8 pa0, bf16x8 pa1, bf16x8 pa2, bf16x8 pa3, f32x16& X0, f32x16& X1) {
#define VFR(d0, ks) ({ const s16x4 l_ = vtr(vp0 + VB * SHM_V + v_rd_off(d0, ks, 0)), h_ = vtr(vp0 + VB * SHM_V + v_rd_off(d0, ks, 1)); (bf16x8){l_[0], l_[1], l_[2], l_[3], h_[0], h_[1], h_[2], h_[3]}; })
#define E2(X, B_) do { if (EXPS) { X[B_] = __builtin_amdgcn_exp2f(X[B_]); X[B_ + 1] = __builtin_amdgcn_exp2f(X[B_ + 1]); } } while (0)
    bf16x8 fa0, fa1, fa2, fa3;
#define PVD(d0, XA, BA, XB, BB) do { fa0 = VFR(d0, 0); fa1 = VFR(d0, 1); fa2 = VFR(d0, 2); fa3 = VFR(d0, 3); SBAR();  \
    o[d0] = __builtin_amdgcn_mfma_f32_32x32x16_bf16(pa0, fa0, o[d0], 0, 0, 0); E2(XA, BA);          \
    o[d0] = __builtin_amdgcn_mfma_f32_32x32x16_bf16(pa1, fa1, o[d0], 0, 0, 0); E2(XA, BA + 2);      \
    o[d0] = __builtin_amdgcn_mfma_f32_32x32x16_bf16(pa2, fa2, o[d0], 0, 0, 0); E2(XB, BB);          \
    o[d0] = __builtin_amdgcn_mfma_f32_32x32x16_bf16(pa3, fa3, o[d0], 0, 0, 0); E2(XB, BB + 2); SBAR(); } while (0)
    PVD(0, X0, 0, X0, 4); PVD(1, X0, 8, X0, 12); PVD(2, X1, 0, X1, 4); PVD(3, X1, 8, X1, 12);
#undef PVD
#undef VFR
#undef E2
}

__device__ __forceinline__ void attn_unit(const Params& P, int h, int qb, char* lds) {
    const int tid = opaque_tid(), wid = __builtin_amdgcn_readfirstlane(tid >> 6), lane = tid & 63, r32 = lane & 31, hi = lane >> 5;
    const int comp = wid >> 2, wq = wid & 3;
    const int q0 = qb * QB, NT = 2 * qb + 2;
    const int qlo = q0 + wq * QBLK, qm = qlo + r32 - 4 * hi;
    const bf16_t* DQ = (const bf16_t*)(P.ws + WS_DQ);
    char* V_lds = lds + OFF_V; char* K_lds = lds + OFF_K;
    float* ws = (float*)(lds + OFF_WS) + wid * 64; float* li_l = ws; float* al_l = ws + 32;
    float l_reg = 0.f; f32x16 o[4]; f32x16 negm;
    { float zf = 0.f; asm volatile("" : "+v"(zf));
#pragma unroll
      for (int r = 0; r < 16; ++r) { negm[r] = zf; o[0][r] = zf; o[1][r] = zf; o[2][r] = zf; o[3][r] = zf; } }
    const int kx = r32 * 256 + comp * 128 + ((hi * 16) ^ ((r32 & 7) << 4));
    const lds_cptr vp0 = (lds_cptr)V_lds + v_rd_base(lane);
    char* qf = lds + OFF_X + wid * 4096 + lane * 16;
#pragma unroll
    for (int d0 = 0; d0 < 4; ++d0) *(bf16x8*)(qf + d0 * 1024) = *(const bf16x8*)(DQ + (size_t)(qlo + r32) * DH + h * HD + comp * 64 + d0 * 16 + hi * 8);
    const __amdgpu_buffer_rsrc_t rsK = __builtin_amdgcn_make_buffer_rsrc((void*)(P.ws + WS_DK), 0, (unsigned)((size_t)T * DH * 2), 0x00020000);
    const __amdgpu_buffer_rsrc_t rsV = __builtin_amdgcn_make_buffer_rsrc((void*)(P.ws + WS_DV), 0, (unsigned)((size_t)T * DH * 2), 0x00020000);
    int voK0, voK1, voV0, voV1;
    { const int c0 = (2 * wid) * 64 + lane, c1 = c0 + 64;
      auto ksrc = [&](int ci) { const int row = ci >> 4, cc = (ci & 15) ^ (row & 7); return (row * DH + h * HD + cc * 8) * 2; };
      auto vsrc = [&](int ci) { const int st = ci >> 5, kk = (st >> 2) * 8 + ((ci & 31) >> 2), c = (st & 3) * 32 + (ci & 3) * 8;
                                const int k = (kk & ~0xC) | ((kk & 4) << 1) | ((kk & 8) >> 1); return (k * DH + h * HD + c) * 2; };
      voK0 = ksrc(c0); voK1 = ksrc(c1); voV0 = vsrc(c0); voV1 = vsrc(c1); }
    const unsigned ldsK = (unsigned)(uintptr_t)K_lds + (unsigned)wid * 2048u, ldsV = (unsigned)(uintptr_t)V_lds + (unsigned)wid * 2048u;
#define DMA1(rs, vo, m0v, so) asm volatile("s_nop 4\n\ts_mov_b32 m0, %0\n\ts_nop 0\n\tbuffer_load_dwordx4 %1, %2, %3 offen lds" :: "s"(m0v), "v"(vo), "s"(rs), "s"(so) : "m0", "memory")
#define DMA_K(t, bf) do { const unsigned so_ = (unsigned)__builtin_amdgcn_readfirstlane((t) * KVBLK * DH * 2), m_ = (unsigned)__builtin_amdgcn_readfirstlane(ldsK + (bf) * SHM_K); DMA1(rsK, voK0, m_, so_); DMA1(rsK, voK1, m_ + 1024u, so_); } while (0)
#define DMA_V(t, bf) do { const unsigned so_ = (unsigned)__builtin_amdgcn_readfirstlane((t) * KVBLK * DH * 2), m_ = (unsigned)__builtin_amdgcn_readfirstlane(ldsV + (bf) * SHM_V); DMA1(rsV, voV0, m_, so_); DMA1(rsV, voV1, m_ + 1024u, so_); } while (0)
#define WAIT_BAR(N) asm volatile("s_waitcnt vmcnt(" #N ") lgkmcnt(0)\n\ts_barrier" ::: "memory")
#define RESC(a) do { if (__any((a) < 1.f)) { if (hi == 0) al_l[r32] = (a); asm volatile("s_waitcnt lgkmcnt(0)" ::: "memory");              \
                     _Pragma("unroll") for (int d_ = 0; d_ < 4; ++d_) _Pragma("unroll") for (int r = 0; r < 16; ++r) o[d_][r] *= al_l[4 * hi + (r & 3) + 8 * (r >> 2)]; } } while (0)
#define KBASE(t) ((t) * KVBLK)
#define MASKT(P0_, P1_, t) do { const int kb_ = KBASE(t); if (kb_ + KVBLK - 1 > qlo) mask_tile(P0_, P1_, qm - kb_); } while (0)
    f32x16 pA0, pA1, pB0, pB1; float alX; bf16x8 pa0, pa1, pa2, pa3;
    DMA_K(0, 0); DMA_V(0, 0); DMA_K(1, 1);
    WAIT_BAR(2);
    SBAR(); qkt<0>(pA0, pA1, K_lds, kx, qf, negm);
    MASKT(pA0, pA1, 0); (void)decide<true>(pA0, pA1, l_reg, negm);
#pragma unroll
    for (int r = 0; r < 16; ++r) { pA0[r] = __builtin_amdgcn_exp2f(pA0[r]); pA1[r] = __builtin_amdgcn_exp2f(pA1[r]); }
    DMA_V(1, 1);
    WAIT_BAR(2);
#define HALF_STEP(PX0, PX1, PY0, PY1, t, KB, VB, SB) do {                                                                    \
        DMA_K((t) + 1, SB);                                                                                                   \
        SBAR(); qkt<KB>(PX0, PX1, K_lds, kx, qf, negm);                                                                       \
        finishP(PY0, PY1, l_reg, pa0, pa1, pa2, pa3); SBAR();                                                                 \
        MASKT(PX0, PX1, (t)); alX = decide<false>(PX0, PX1, l_reg, negm); SBAR();                                             \
        pv_tile<VB, true>(o, vp0, pa0, pa1, pa2, pa3, PX0, PX1);                                                              \
        WAIT_BAR(2);                                                                                                          \
        DMA_V((t) + 1, SB);                                                                                                   \
        RESC(alX);                                                                                                            \
        WAIT_BAR(2); } while (0)
    for (int t = 1; t + 1 < NT; t += 2) {
        HALF_STEP(pB0, pB1, pA0, pA1, t, 1, 0, 0);
        HALF_STEP(pA0, pA1, pB0, pB1, t + 1, 0, 1, 1);
    }
    SBAR(); qkt<1>(pB0, pB1, K_lds, kx, qf, negm);
    finishP(pA0, pA1, l_reg, pa0, pa1, pa2, pa3); SBAR();
    MASKT(pB0, pB1, NT - 1); alX = decide<false>(pB0, pB1, l_reg, negm); SBAR();
    pv_tile<0, true>(o, vp0, pa0, pa1, pa2, pa3, pB0, pB1);
    RESC(alX);
    WAIT_BAR(0);
    finishP(pB0, pB1, l_reg, pa0, pa1, pa2, pa3); SBAR();
    pv_tile<1, false>(o, vp0, pa0, pa1, pa2, pa3, pB0, pB1);
    { auto rr = __builtin_amdgcn_permlane32_swap(__float_as_uint(l_reg), __float_as_uint(l_reg), false, false); l_reg = __uint_as_float(rr[0]) + __uint_as_float(rr[1]); }
    SBAR(); asm volatile("" ::: "memory");
    int le = lane; asm volatile("" : "+v"(le));
    const int r32e = le & 31, hie = le >> 5;
    float* wse = (float*)(lds + OFF_WS) + wid * 64;
    if (hie == 0) wse[r32e] = l_reg; asm volatile("s_waitcnt lgkmcnt(0)" ::: "memory");
    {
        float rli[16]; const float* lb_ = wse + 4 * hie;
#pragma unroll
        for (int r = 0; r < 16; ++r) rli[r] = __builtin_amdgcn_rcpf(lb_[(r & 3) + 8 * (r >> 2)]);
        if (comp == 1) { const float lam = ((const float*)(P.ws + WS_CTL))[CT_LAM];
#pragma unroll
            for (int r = 0; r < 16; ++r) rli[r] *= lam; }
#pragma unroll
        for (int d0 = 0; d0 < 4; ++d0)
#pragma unroll
            for (int r = 0; r < 16; ++r) o[d0][r] *= rli[r];
    }
    __syncthreads();
    float* X = (float*)(lds + OFF_X) + wq * XW;
    float* Xl = X + le;
    if (comp == 1) {
#pragma unroll
        for (int d0 = 0; d0 < 4; ++d0)
#pragma unroll
            for (int r = 0; r < 16; ++r) Xl[(d0 * 16 + r) * 64] = o[d0][r];
    }
    __syncthreads();
    if (comp == 0) {
#pragma unroll
        for (int r = 0; r < 16; ++r) { float s = 0.f;
#pragma unroll
            for (int d0 = 0; d0 < 4; ++d0) { const float v = o[d0][r] - Xl[(d0 * 16 + r) * 64]; o[d0][r] = v; s += v * v; }
            s += __shfl_xor(s, 1); s += __shfl_xor(s, 2); s += __shfl_xor(s, 4); s += __shfl_xor(s, 8); s += __shfl_xor(s, 16);
            const float rs = (1.0f - LAMBDA_INIT) / sqrtf(s * (1.0f / HD) + SUBLN_EPS);
#pragma unroll
            for (int d0 = 0; d0 < 4; ++d0) o[d0][r] *= rs; }
        asm volatile("s_waitcnt lgkmcnt(0)" ::: "memory"); SBAR();
        float* Xb = X + 4 * hie * 132 + r32e;
#pragma unroll
        for (int r = 0; r < 16; ++r)
#pragma unroll
            for (int d0 = 0; d0 < 4; ++d0) Xb[((r & 3) + 8 * (r >> 2)) * 132 + d0 * 32] = o[d0][r];
        asm volatile("s_waitcnt lgkmcnt(0)" ::: "memory"); SBAR();
        const int row = le >> 1, hf = le & 1, t = qlo + row;
        const bf16_t* DGp = (const bf16_t*)(P.ws + WS_DG) + (size_t)t * DH + h * HD + hf * 64; bf16_t* MXp = (bf16_t*)(P.ws + WS_MIX) + (size_t)t * DM + DH + h * HD + hf * 64;
        const float* nwp = P.diff_norm_w + hf * 64; const float* xr = X + row * 132 + hf * 64;
#pragma unroll
        for (int ps = 0; ps < 2; ++ps) {
            u32x4 g[4]; f32x4 y[8], nw[8];
#pragma unroll
            for (int k = 0; k < 4; ++k) g[k] = *(const u32x4*)(DGp + ps * 32 + k * 8);
#pragma unroll
            for (int k = 0; k < 8; ++k) { y[k] = *(const f32x4*)(xr + ps * 32 + k * 4); nw[k] = *(const f32x4*)(nwp + ps * 32 + k * 4); }
#pragma unroll
            for (int k = 0; k < 4; ++k) { u32x4 w;
#pragma unroll
                for (int j = 0; j < 2; ++j) { const f32x4 yy = y[2 * k + j] * nw[2 * k + j]; const unsigned g01 = g[k][2 * j], g23 = g[k][2 * j + 1];
                    w[2 * j] = pk2(yy.x * __uint_as_float(g01 << 16), yy.y * __uint_as_float(g01 & 0xffff0000u)); w[2 * j + 1] = pk2(yy.z * __uint_as_float(g23 << 16), yy.w * __uint_as_float(g23 & 0xffff0000u)); }
                *(u32x4*)(MXp + ps * 32 + k * 8) = w; }
            asm volatile("" ::: "memory");
        }
    }
    __syncthreads();
#undef DMA1
#undef DMA_K
#undef DMA_V
#undef WAIT_BAR
#undef RESC
#undef KBASE
#undef MASKT
#undef HALF_STEP
}
__device__ __forceinline__ void attn_phase(const Params& P, int vcu, int nblk, char* lds) {
    for (int it = vcu; it < 256; it += nblk) { const int h = it >> 6, j = it & 63; for (int u = 0; u < 2; ++u) attn_unit(P, h, u ? j : 127 - j, lds); }
}
#undef KSWZ
#undef SBAR
}

namespace hg {
typedef short bf16x8 __attribute__((ext_vector_type(8)));
typedef short s16x4 __attribute__((ext_vector_type(4)));
typedef float f32x16 __attribute__((ext_vector_type(16)));
typedef __attribute__((address_space(3))) unsigned char lds_u8;
constexpr int RS_Q = 272, RS_T = 320, RS_P = 144, RS_O = 528;
constexpr int OFF_QT = 0, OFF_KT = 17408, OFF_OO = 0, OFF_KH = 34816, OFF_VV = 55296, OFF_ST = 75776, OFF_PP = 110592, OFF_GT = 119808, OFF_BM = 123904, OFF_BL = 124416, LDS_BYTES = 124928;
__device__ __forceinline__ int crow(int r, int hi) { return (r & 3) + 8 * (r >> 2) + 4 * hi; }
__device__ __forceinline__ bf16x8 ld128(const lds_u8* p) { return *(const __attribute__((address_space(3))) bf16x8*)p; }
typedef short v4i16_t __attribute__((ext_vector_type(4)));
__device__ __forceinline__ s16x4 vtr(const lds_u8* p) { return __builtin_bit_cast(s16x4, __builtin_amdgcn_ds_read_tr16_b64_v4i16((__attribute__((address_space(3))) v4i16_t*)p)); }
__device__ __forceinline__ bf16x8 tr_frag(const lds_u8* base, int RS, int kbase, int nbase, int lane) {
    const lds_u8* p = base + (kbase + 8 * (lane >> 5) + ((lane & 15) >> 2)) * RS + (nbase + 16 * ((lane >> 4) & 1) + 4 * (lane & 3)) * 2;
    const s16x4 lo = vtr(p), hi = vtr(p + 4 * RS);
    return (bf16x8){lo[0], lo[1], lo[2], lo[3], hi[0], hi[1], hi[2], hi[3]};
}
#define MFMA32(a, b, c) __builtin_amdgcn_mfma_f32_32x32x16_bf16((a), (b), (c), 0, 0, 0)

template <bool FULL>
__device__ __forceinline__ void chunk_prep(const Params& P, int h, int tc, lds_u8* lds, float& bs0, float& bs1) {
    const int tid = opaque_tid(), d2 = tid & 63, rg = tid >> 6;
    const float* Gp = (const float*)(P.ws + WS_G) + (size_t)(tc + 8 * rg) * DH + h * HD + 2 * d2;
    const bf16_t* Qp = (const bf16_t*)(P.ws + WS_HQ) + (size_t)(tc + 8 * rg) * DH + h * HD + 2 * d2;
    const bf16_t* Vp = (const bf16_t*)(P.ws + WS_HI) + (size_t)(tc + (tid >> 4)) * DH + h * HD + (tid & 15) * 8;
    f32x2 g[8]; unsigned qraw[8];
#pragma unroll
    for (int i = 0; i < 8; ++i) { g[i] = *(const f32x2*)(Gp + (size_t)i * DH); if (FULL) qraw[i] = *(const unsigned*)(Qp + (size_t)i * DH); }
    const u32x4 va = *(const u32x4*)Vp, vb = *(const u32x4*)(Vp + (size_t)32 * DH);
    f32x2 cs[8]; float c0 = 0.f, c1 = 0.f;
#pragma unroll
    for (int i = 0; i < 8; ++i) { c0 += g[i].x; c1 += g[i].y; cs[i] = (f32x2){c0, c1}; }
    __attribute__((address_space(3))) float* GT = (__attribute__((address_space(3))) float*)(lds + OFF_GT);
    *(__attribute__((address_space(3))) f32x2*)(GT + rg * 128 + 2 * d2) = (f32x2){c0, c1};
    *(__attribute__((address_space(3))) u32x4*)(lds + OFF_VV + (tid >> 4) * RS_T + (tid & 15) * 16) = va;
    *(__attribute__((address_space(3))) u32x4*)(lds + OFF_VV + ((tid >> 4) + 32) * RS_T + (tid & 15) * 16) = vb;
    __syncthreads();
    float p0 = 0.f, p1 = 0.f, m0 = 0.f, m1 = 0.f, t0 = 0.f, t1 = 0.f;
#pragma unroll
    for (int j = 0; j < 8; ++j) { const f32x2 t = *(__attribute__((address_space(3))) f32x2*)(GT + j * 128 + 2 * d2);
        if (j < rg) { p0 += t.x; p1 += t.y; } if (j < 4) { m0 += t.x; m1 += t.y; } t0 += t.x; t1 += t.y; }
    if (rg == 0) { *(__attribute__((address_space(3))) f32x2*)(lds + OFF_BM + d2 * 8) = (f32x2){m0, m1}; *(__attribute__((address_space(3))) f32x2*)(lds + OFF_BL + d2 * 8) = (f32x2){t0, t1}; }
    bs0 += t0; bs1 += t1;
#pragma unroll
    for (int i = 0; i < 8; ++i) {
        const int row = 8 * rg + i; const float b0 = p0 + cs[i].x, b1 = p1 + cs[i].y;
        const float k0 = 1.0f - __expf(g[i].x), k1 = 1.0f - __expf(g[i].y);
        *(__attribute__((address_space(3))) unsigned*)(lds + OFF_KH + row * RS_T + d2 * 4) = pk2(k0 * __expf(t0 - b0), k1 * __expf(t1 - b1));
        if (FULL) {
            const float q0 = __uint_as_float(qraw[i] << 16), q1 = __uint_as_float(qraw[i] & 0xffff0000u);
            *(__attribute__((address_space(3))) unsigned*)(lds + OFF_QT + row * RS_Q + d2 * 4) = pk2(q0 * __expf(b0 - m0), q1 * __expf(b1 - m1));
            *(__attribute__((address_space(3))) unsigned*)(lds + OFF_KT + row * RS_Q + d2 * 4) = pk2(k0 * __expf(m0 - b0), k1 * __expf(m1 - b1));
        }
    }
    __syncthreads();
}
__device__ __forceinline__ void state_update(lds_u8* lds, f32x16 (&S)[2], int w, int lane) {
    const int db = w >> 1, hi = lane >> 5;
    const __attribute__((address_space(3))) float* BL = (const __attribute__((address_space(3))) float*)(lds + OFF_BL);
#pragma unroll
    for (int g4 = 0; g4 < 4; ++g4) { const f32x4 bl = *(const __attribute__((address_space(3))) f32x4*)(BL + 32 * db + 8 * g4 + 4 * hi);
#pragma unroll
        for (int q = 0; q < 4; ++q) { const float f = __expf(bl[q]); S[0][4 * g4 + q] *= f; S[1][4 * g4 + q] *= f; } }
#pragma unroll
    for (int ks = 0; ks < 4; ++ks) {
        const bf16x8 a = tr_frag(lds + OFF_KH, RS_T, 16 * ks, 32 * db, lane);
        const bf16x8 b0 = tr_frag(lds + OFF_VV, RS_T, 16 * ks, 32 * (2 * (w & 1)), lane), b1 = tr_frag(lds + OFF_VV, RS_T, 16 * ks, 32 * (2 * (w & 1) + 1), lane);
        S[0] = MFMA32(a, b0, S[0]); S[1] = MFMA32(a, b1, S[1]);
    }
}
__device__ __forceinline__ float* us_ptr(const Params& P, int sc, int h, int w, int j, int lane) {
    return (float*)(P.ws + WS_US) + ((size_t)(sc * NH + h) * HD + 32 * (w >> 1)) * HD + 32 * (2 * (w & 1) + j) + (lane & 31);
}
__device__ __forceinline__ void local_item(const Params& P, int sc, int h, lds_u8* lds) {
    const int tid = opaque_tid(), w = __builtin_amdgcn_readfirstlane(tid >> 6), lane = tid & 63, hi = lane >> 5;
    f32x16 S[2] = {}; float bs0 = 0.f, bs1 = 0.f;
    for (int c = 0; c < 4; ++c) {
        chunk_prep<false>(P, h, sc * 256 + c * 64, lds, bs0, bs1);
        state_update(lds, S, w, lane);
        __syncthreads();
    }
#pragma unroll
    for (int j = 0; j < 2; ++j) { float* up = us_ptr(P, sc, h, w, j, lane);
#pragma unroll
        for (int r = 0; r < 16; ++r) up[(size_t)crow(r, hi) * HD] = S[j][r]; }
    if (tid < 64) *(f32x2*)((float*)(P.ws + WS_BS) + (size_t)(sc * NH + h) * HD + 2 * tid) = (f32x2){bs0, bs1};
}
__device__ __forceinline__ void local_phase(const Params& P, int vcu, int nblk, lds_u8* lds) { for (int it = vcu; it < 256; it += nblk) local_item(P, it >> 2, it & 3, lds); }
__device__ __forceinline__ void scan_phase(const Params& P, int bid, int nblk) {
    const int tid = opaque_tid(); if (tid >= 256) return;
    float* US = (float*)(P.ws + WS_US); const float* BS = (const float*)(P.ws + WS_BS);
    for (int i = bid * 256 + tid; i < NH * HD * HD; i += nblk * 256) {
        const int hd = i >> 7; float s = 0.f;
        for (int sc0 = 0; sc0 < 64; sc0 += 8) {
            float u[8], a[8];
#pragma unroll
            for (int k = 0; k < 8; ++k) { u[k] = US[(size_t)(sc0 + k) * (NH * HD * HD) + i]; a[k] = BS[(size_t)(sc0 + k) * (NH * HD) + hd]; }
#pragma unroll
            for (int k = 0; k < 8; ++k) { US[(size_t)(sc0 + k) * (NH * HD * HD) + i] = s; s = __expf(a[k]) * s + u[k]; }
        }
    }
}
__device__ __forceinline__ void out_item(const Params& P, int sc, int h, lds_u8* lds) {
    const int tid = opaque_tid(), w = __builtin_amdgcn_readfirstlane(tid >> 6), lane = tid & 63, r32 = lane & 31, hi = lane >> 5;
    f32x16 S[2]; float bs0 = 0.f, bs1 = 0.f;
#pragma unroll
    for (int j = 0; j < 2; ++j) { const float* up = us_ptr(P, sc, h, w, j, lane);
#pragma unroll
        for (int r = 0; r < 16; ++r) S[j][r] = up[(size_t)crow(r, hi) * HD]; }
    const int tb = w >> 2, eb = w & 3, db = w >> 1;
    for (int c = 0; c < 4; ++c) {
        const int tc = sc * 256 + c * 64;
        chunk_prep<true>(P, h, tc, lds, bs0, bs1);
        { const __attribute__((address_space(3))) float* BM = (const __attribute__((address_space(3))) float*)(lds + OFF_BM);
#pragma unroll
          for (int g4 = 0; g4 < 4; ++g4) { const int d0 = 32 * db + 8 * g4 + 4 * hi; const f32x4 bm = *(const __attribute__((address_space(3))) f32x4*)(BM + d0);
              const float f0 = __expf(bm[0]), f1 = __expf(bm[1]), f2 = __expf(bm[2]), f3 = __expf(bm[3]);
#pragma unroll
              for (int j = 0; j < 2; ++j) { const int e = 32 * (2 * (w & 1) + j) + r32;
                  *(__attribute__((address_space(3))) u32x2*)(lds + OFF_ST + e * RS_Q + d0 * 2) = (u32x2){pk2(S[j][4 * g4] * f0, S[j][4 * g4 + 1] * f1), pk2(S[j][4 * g4 + 2] * f2, S[j][4 * g4 + 3] * f3)}; } } }
        if (w < 3) {
            const int sb = (w == 2) ? 1 : 0, tb2 = (w >= 1) ? 1 : 0; f32x16 acc = {};
#pragma unroll
            for (int ks = 0; ks < 8; ++ks) { const bf16x8 a = ld128(lds + OFF_KT + (32 * sb + r32) * RS_Q + (16 * ks + 8 * hi) * 2), b = ld128(lds + OFF_QT + (32 * tb2 + r32) * RS_Q + (16 * ks + 8 * hi) * 2);
                acc = MFMA32(a, b, acc); }
            const int t = 32 * tb2 + r32;
#pragma unroll
            for (int g4 = 0; g4 < 4; ++g4) { const int s0 = 32 * sb + 8 * g4 + 4 * hi; float v[4];
#pragma unroll
                for (int q = 0; q < 4; ++q) v[q] = (s0 + q <= t) ? acc[4 * g4 + q] : 0.f;
                *(__attribute__((address_space(3))) u32x2*)(lds + OFF_PP + t * RS_P + s0 * 2) = (u32x2){pk2(v[0], v[1]), pk2(v[2], v[3])}; }
        }
        __syncthreads();
        f32x16 o = {};
#pragma unroll
        for (int ks = 0; ks < 8; ++ks) { const bf16x8 a = ld128(lds + OFF_QT + (32 * tb + r32) * RS_Q + (16 * ks + 8 * hi) * 2), b = ld128(lds + OFF_ST + (32 * eb + r32) * RS_Q + (16 * ks + 8 * hi) * 2);
            o = MFMA32(a, b, o); }
#pragma unroll
        for (int ks = 0; ks < 4; ++ks) if (ks < 2 * (tb + 1)) { const bf16x8 a = ld128(lds + OFF_PP + (32 * tb + r32) * RS_P + (16 * ks + 8 * hi) * 2), b = tr_frag(lds + OFF_VV, RS_T, 16 * ks, 32 * eb, lane);
            o = MFMA32(a, b, o); }
        state_update(lds, S, w, lane);
        __syncthreads();
        { __attribute__((address_space(3))) float* OO = (__attribute__((address_space(3))) float*)(lds + OFF_OO);
#pragma unroll
          for (int r = 0; r < 16; ++r) OO[(32 * tb + crow(r, hi)) * (RS_O / 4) + 32 * eb + r32] = o[r]; }
        __syncthreads();
        { const int t = tid >> 3, e0 = (tid & 7) * 16; const __attribute__((address_space(3))) f32x4* orow = (const __attribute__((address_space(3))) f32x4*)(lds + OFF_OO + t * RS_O + e0 * 4);
          f32x4 v[4]; float ss = 0.f;
#pragma unroll
          for (int k = 0; k < 4; ++k) { v[k] = orow[k]; ss += (v[k].x * v[k].x + v[k].y * v[k].y) + (v[k].z * v[k].z + v[k].w * v[k].w); }
          ss += __shfl_xor(ss, 1); ss += __shfl_xor(ss, 2); ss += __shfl_xor(ss, 4);
          const float rs = 1.0f / sqrtf(ss * (1.0f / HD) + NORM_EPS);
          const bf16_t* hgp = (const bf16_t*)(P.ws + WS_HG) + (size_t)(tc + t) * DH + h * HD + e0; const u32x4 ga = *(const u32x4*)hgp, gb = *(const u32x4*)(hgp + 8);
          const f32x4* nw = (const f32x4*)(P.hgrn_norm_w + e0); float y[16];
#pragma unroll
          for (int k = 0; k < 4; ++k) { const f32x4 n4 = nw[k]; const unsigned g01 = (k < 2) ? ga[2 * k] : gb[2 * (k - 2)], g23 = (k < 2) ? ga[2 * k + 1] : gb[2 * (k - 2) + 1];
              y[4 * k] = v[k].x * rs * n4.x * __uint_as_float(g01 << 16); y[4 * k + 1] = v[k].y * rs * n4.y * __uint_as_float(g01 & 0xffff0000u);
              y[4 * k + 2] = v[k].z * rs * n4.z * __uint_as_float(g23 << 16); y[4 * k + 3] = v[k].w * rs * n4.w * __uint_as_float(g23 & 0xffff0000u); }
          bf16_t* mp = (bf16_t*)(P.ws + WS_MIX) + (size_t)(tc + t) * DM + h * HD + e0;
          *(u32x4*)mp = (u32x4){pk2(y[0], y[1]), pk2(y[2], y[3]), pk2(y[4], y[5]), pk2(y[6], y[7])};
          *(u32x4*)(mp + 8) = (u32x4){pk2(y[8], y[9]), pk2(y[10], y[11]), pk2(y[12], y[13]), pk2(y[14], y[15])}; }
        __syncthreads();
    }
}
__device__ __forceinline__ void out_phase(const Params& P, int vcu, int nblk, lds_u8* lds) { for (int it = vcu; it < 256; it += nblk) out_item(P, it >> 2, it & 3, lds); }
#undef MFMA32
}


#define LAS __attribute__((address_space(3)))
#define XB_TMO      128
#define XB_XCNT(j)  (256  + 64 * (j))
#define XB_XSUB(j)  (1280 + 64 * (j))
#define XB_XGEN(j)  (2304 + 64 * (j))
#define XB_TOP      3328
#define XB_TOPGEN   3392
#define XCD_BAR_WORDS 3456
#define XB_SPIN_CAP (1u << 18)
__device__ __forceinline__ unsigned xb_ld(unsigned* p)              { return __hip_atomic_load(p, __ATOMIC_RELAXED, __HIP_MEMORY_SCOPE_AGENT); }
__device__ __forceinline__ unsigned xb_add(unsigned* p, unsigned v) { return __hip_atomic_fetch_add(p, v, __ATOMIC_RELAXED, __HIP_MEMORY_SCOPE_AGENT); }
__device__ __forceinline__ unsigned xb_xcc_id() { return (unsigned)__builtin_amdgcn_s_getreg((3 << 11) | 20) & 0xFu; }
#define XB_SPIN(cond, bar) do { unsigned _sp = 0; while (cond) { __builtin_amdgcn_s_sleep(1); \
    if ((++_sp & 255u) == 0u) { if (xb_ld(&(bar)[XB_TMO])) break; if (_sp > XB_SPIN_CAP) { atomicAdd(&(bar)[XB_TMO], 1u); break; } } } } while (0)
struct XcdBarrier { unsigned* bar; unsigned x; volatile LAS unsigned* st; };
__device__ __forceinline__ XcdBarrier xcd_barrier_post(unsigned* bar, volatile LAS unsigned* st) {
    XcdBarrier b; b.bar = bar; b.x = xb_xcc_id(); b.st = st;
    if (threadIdx.x == 0) (void)xb_add(&bar[XB_XCNT(b.x)], 1u);
    return b;
}
__device__ __forceinline__ void xcd_barrier_complete(unsigned* bar, unsigned x, unsigned& nloc, unsigned& nx) {
    const unsigned G = gridDim.x * gridDim.y * gridDim.z;
    unsigned sum, cnt, mine, sp = 0u;
    for (;;) {
        sum = 0u; cnt = 0u; mine = 0u;
#pragma unroll
        for (unsigned j = 0; j < 16; ++j) { const unsigned c = xb_ld(&bar[XB_XCNT(j)]); sum += c; cnt += (c > 0u) ? 1u : 0u; mine = (j == x) ? c : mine; }
        if (sum == G) break;
        __builtin_amdgcn_s_sleep(1);
        if ((++sp & 255u) == 0u) { if (xb_ld(&bar[XB_TMO])) break; if (sp > XB_SPIN_CAP) { atomicAdd(&bar[XB_TMO], 1u); break; } }
    }
    nloc = mine > 0u ? mine : 1u; nx = cnt > 0u ? cnt : 1u;
}
__device__ __forceinline__ void xcd_barrier(const XcdBarrier& b) {
    asm volatile("s_waitcnt vmcnt(0)" ::: "memory");
    __syncthreads();
    if (threadIdx.x == 0) {
        unsigned* bar = b.bar;
        __builtin_amdgcn_s_waitcnt(0);
        unsigned nloc = b.st[0], nx = b.st[1];
        if (nloc == 0u) { xcd_barrier_complete(bar, b.x, nloc, nx); b.st[0] = nloc; b.st[1] = nx; }
        const unsigned old = xb_add(&bar[XB_XSUB(b.x)], 1u);
        const unsigned gen = old / nloc;
        if (old + 1u == (gen + 1u) * nloc) {
            __builtin_amdgcn_fence(__ATOMIC_RELEASE, "agent");
            asm volatile("s_waitcnt vmcnt(0)" ::: "memory");
            const unsigned og = xb_add(&bar[XB_TOP], 1u);
            const unsigned tg = og / nx;
            if (og + 1u == (tg + 1u) * nx) xb_add(&bar[XB_TOPGEN], 1u);
            else XB_SPIN(xb_ld(&bar[XB_TOPGEN]) == tg, bar);
            __builtin_amdgcn_fence(__ATOMIC_ACQUIRE, "agent");
            xb_add(&bar[XB_XGEN(b.x)], 1u);
            asm volatile("s_waitcnt vmcnt(0)" ::: "memory");
        } else {
            XB_SPIN(xb_ld(&bar[XB_XGEN(b.x)]) == gen, bar);
            __builtin_amdgcn_fence(__ATOMIC_ACQUIRE, "agent");
            asm volatile("s_waitcnt vmcnt(0)" ::: "memory");
        }
    }
    __syncthreads();
}
constexpr int CW_BAR = 131072;
constexpr int MISC_OFF = 147456 - 64;
constexpr int NWAVES = 8;
constexpr int LDS_BYTES = 147456;
constexpr int N_PHASES = 7;
struct Args { Params P; int ph_lo, ph_hi, flags, pad; };

__device__ __forceinline__ void final_norm_phase(const Params& P, int bid, int nblk) {
    const int lane = threadIdx.x & 63, wave = threadIdx.x >> 6, gw = bid * NWAVES + wave, ngw = nblk * NWAVES;
    const float* rowsq = (const float*)(P.ws + WS_CTL) + CT_ROWSQ;
    for (int m = gw; m < T; m += ngw) {
        f32x4* yr = (f32x4*)(P.out + (size_t)m * DM) + lane; const f32x4* wr = (const f32x4*)P.final_norm_w + lane;
        const float rstd = 1.0f / sqrtf(rowsq[m] * (1.0f / DM) + NORM_EPS);
#pragma unroll
        for (int j = 0; j < 4; ++j) { const f32x4 v = yr[64 * j], w = wr[64 * j]; yr[64 * j] = (f32x4){v.x * rstd * w.x, v.y * rstd * w.y, v.z * rstd * w.z, v.w * rstd * w.w}; }
    }
}

__global__ void __launch_bounds__(NWAVES * 64, 2) mk_fwd(Args a) {
    extern __shared__ __attribute__((aligned(16))) unsigned char lds[];
    const Params& P = a.P;
    const int G = gridDim.x, bx = blockIdx.x;
    const int vcu = (G % 8 == 0) ? (bx % 8) * (G / 8) + bx / 8 : bx;
    const int lo = a.ph_lo, hi = a.ph_hi;
#define IN(k) (lo <= (k) && (k) < hi)
#define SEAM(k) do { if (IN(k) && IN((k) + 1)) xcd_barrier(bar); } while (0)
    if (threadIdx.x < 16) ((LAS unsigned*)((LAS unsigned char*)lds + MISC_OFF))[threadIdx.x] = 0u;
    __syncthreads();
    const XcdBarrier bar = xcd_barrier_post((unsigned*)(P.ws + WS_CTL) + CW_BAR, (volatile LAS unsigned*)((LAS unsigned char*)lds + MISC_OFF));
    if (IN(0)) {
        prologue_phase(P, bx, G, (float*)lds);
        float* rowsq = (float*)(P.ws + WS_CTL) + CT_ROWSQ;
        for (int i = bx * (NWAVES * 64) + threadIdx.x; i < T; i += G * NWAVES * 64) rowsq[i] = 0.f;
    }
    SEAM(0);
    if (IN(1)) {
        pg8::Gemm g{(const bf16_t*)(P.ws + WS_XN), (const bf16_t*)(P.ws + WS_WIN), T, DIN, DM}; pg8::StaticOrder S; S.init(T, DIN, G, bx);
        EpiIn E{P};
        pg8::gemm_phase<EpiIn, pg8::StaticOrder, true, true>((PG8_LAS unsigned char*)lds, g, S, E);
    }
    SEAM(1);
    if (IN(2)) hg::local_phase(P, vcu, G, (hg::lds_u8*)lds);
    SEAM(2);
    if (IN(3)) hg::scan_phase(P, bx, G);
    SEAM(3);
    if (IN(4)) { att::attn_phase(P, vcu, G, (char*)lds); hg::out_phase(P, vcu, G, (hg::lds_u8*)lds); }
    SEAM(4);
    if (IN(5)) {
        pg8::Gemm g{(const bf16_t*)(P.ws + WS_MIX), (const bf16_t*)(P.ws + WS_WOUT), T, DM, DM}; pg8::StaticOrder S; S.init(T, DM, G, bx);
        EpiOut E{P};
        pg8::gemm_phase<EpiOut, pg8::StaticOrder, false, true>((PG8_LAS unsigned char*)lds, g, S, E);
    }
    SEAM(5);
    if (IN(6)) final_norm_phase(P, bx, G);
#undef IN
#undef SEAM
}

static int g_grid = 0;
static void launch_phases(const Params& P, int lo, int hi, hipStream_t stream) {
    Args a{}; a.P = P; a.ph_lo = lo; a.ph_hi = hi; a.flags = 0; a.pad = 0;
    if (hipMemsetAsync(P.ws + WS_CTL + (size_t)CW_BAR * 4, 0, XCD_BAR_WORDS * 4, stream) != hipSuccess) { fprintf(stderr, "kernel_launch: memset of the barrier words failed\n"); return; }
    hipLaunchKernelGGL(mk_fwd, dim3(g_grid), dim3(NWAVES * 64), LDS_BYTES, stream, a);
    const hipError_t e = hipPeekAtLastError();
    if (e != hipSuccess) fprintf(stderr, "kernel_launch: launch [%d,%d) failed: %s (grid %d)\n", lo, hi, hipGetErrorString(e), g_grid);
}

extern "C" void kernel_launch(void* const* d_in, const int* in_sizes, int n_in, void* d_out, int out_size, void* d_ws, size_t ws_size, hipStream_t stream) {
    if (n_in != 12 || in_sizes[0] != T * DM || out_size != T * DM || ws_size < 256 * MiB) { fprintf(stderr, "kernel_launch: unexpected shapes (n_in %d in0 %d out %d ws %zu)\n", n_in, n_in > 0 ? in_sizes[0] : -1, out_size, ws_size); return; }
    if (g_grid == 0) {
        int dev = 0, cus = 0, per_cu = 0;
        if (hipGetDevice(&dev) != hipSuccess || hipDeviceGetAttribute(&cus, hipDeviceAttributeMultiprocessorCount, dev) != hipSuccess) { fprintf(stderr, "kernel_launch: device query failed\n"); g_grid = -1; return; }
        if (hipFuncSetAttribute((const void*)mk_fwd, hipFuncAttributeMaxDynamicSharedMemorySize, LDS_BYTES) != hipSuccess) { fprintf(stderr, "kernel_launch: hipFuncSetAttribute failed\n"); g_grid = -1; return; }
        if (hipOccupancyMaxActiveBlocksPerMultiprocessor(&per_cu, (const void*)mk_fwd, NWAVES * 64, LDS_BYTES) != hipSuccess || per_cu < 1) { fprintf(stderr, "kernel_launch: occupancy query says %d blocks per CU\n", per_cu); per_cu = 1; }
        (void)hipGetLastError();
        g_grid = cus * (per_cu < 1 ? 1 : 1);
    }
    if (g_grid < 0) return;
    Params P{};
    P.x = (const float*)d_in[0]; P.norm_w = (const float*)d_in[1]; P.w_in = (const float*)d_in[2]; P.lb_logits = (const float*)d_in[3]; P.hgrn_norm_w = (const float*)d_in[4];
    P.lq1 = (const float*)d_in[5]; P.lk1 = (const float*)d_in[6]; P.lq2 = (const float*)d_in[7]; P.lk2 = (const float*)d_in[8]; P.diff_norm_w = (const float*)d_in[9];
    P.w_out = (const float*)d_in[10]; P.final_norm_w = (const float*)d_in[11]; P.out = (float*)d_out; P.ws = (unsigned char*)d_ws;
    launch_phases(P, 0, N_PHASES, stream);
}
```

```cpp
#include <hip/hip_runtime.h>
#include <cstdio>
#include <cstdint>

typedef unsigned short bf16_t;
typedef float f32x4 __attribute__((ext_vector_type(4)));
typedef float f32x2 __attribute__((ext_vector_type(2)));
typedef unsigned u32x4 __attribute__((ext_vector_type(4)));
typedef unsigned u32x2 __attribute__((ext_vector_type(2)));
typedef __bf16 bf16x2_t __attribute__((ext_vector_type(2)));

constexpr int T = 16384, DM = 1024, DIN = 4096, DH = 512;
constexpr int NH = 4, HD = 128;
constexpr float NORM_EPS = 1e-6f, SUBLN_EPS = 1e-5f;
constexpr float LAMBDA_INIT = 0.2f;
constexpr float QSCALE = 0.125f * 1.4426950408889634f;

constexpr size_t MiB = 1u << 20;
constexpr size_t WS_CTL = 0;
constexpr size_t WS_COS = 1 * MiB, WS_SIN = 3 * MiB;
constexpr size_t WS_WOUT = 5 * MiB;
constexpr size_t WS_WIN = 8 * MiB;
constexpr size_t WS_XN = 16 * MiB;
constexpr size_t WS_MIX = 16 * MiB;
constexpr size_t WS_HQ = 48 * MiB;
constexpr size_t WS_G = 64 * MiB;
constexpr size_t WS_HI = 96 * MiB;
constexpr size_t WS_HG = 112 * MiB;
constexpr size_t WS_DQ = 128 * MiB;
constexpr size_t WS_DK = 144 * MiB;
constexpr size_t WS_DV = 160 * MiB;
constexpr size_t WS_DG = 176 * MiB;
constexpr size_t WS_US = 192 * MiB;
constexpr size_t WS_BS = 208 * MiB;
constexpr size_t WS_OTMP = 210 * MiB;
constexpr int CT_LAM = 16;
constexpr int CT_LB = 1024;
constexpr int CT_ROWSQ = 16384;

struct Params {
    const float* x; const float* norm_w; const float* w_in; const float* lb_logits; const float* hgrn_norm_w;
    const float* lq1; const float* lk1; const float* lq2; const float* lk2; const float* diff_norm_w; const float* w_out; const float* final_norm_w;
    float* out; unsigned char* ws;
};

__device__ __forceinline__ float bf2f(bf16_t h) { return __uint_as_float((unsigned)h << 16); }
__device__ __forceinline__ unsigned pk2(float lo, float hi) { f32x2 v = {lo, hi}; bf16x2_t b = __builtin_convertvector(v, bf16x2_t); return __builtin_bit_cast(unsigned, b); }
__device__ __forceinline__ bf16_t f2bf(float f) { return (bf16_t)(pk2(f, 0.f) & 0xffffu); }
__device__ __forceinline__ float wave_sum(float v) {
#pragma unroll
    for (int o = 1; o < 64; o <<= 1) v += __shfl_xor(v, o);
    return v;
}
__device__ __forceinline__ int opaque_tid() { int t = threadIdx.x; asm volatile("" : "+v"(t)); return t; }
__device__ __forceinline__ float sigmoidf_(float v) { return 1.0f / (1.0f + __expf(-v)); }
__device__ __forceinline__ float siluf_(float v) { return v / (1.0f + __expf(-v)); }

__host__ __device__ __forceinline__ int win_orig_col(int np) {
    if (np < 2048 || np >= 3072) return np;
    const int base = np & ~63, p = np & 63;
    return base + (p >> 1) + 32 * (p & 1);
}

__device__ __forceinline__ void epi8(const Params& P, int type, int t, int c, const float* v) {
    unsigned char* ws = P.ws;
    const size_t off = (size_t)t * DH + c;
    if (type == 1) {
        const float* lb = (const float*)(ws + WS_CTL) + CT_LB + c;
        float g[8];
#pragma unroll
        for (int j = 0; j < 8; ++j) { const float l = lb[j]; const float f = l + (1.0f - l) * sigmoidf_(v[j]); g[j] = __logf(f); }
        float* G = (float*)(ws + WS_G) + off;
        *(f32x4*)G = (f32x4){g[0], g[1], g[2], g[3]}; *(f32x4*)(G + 4) = (f32x4){g[4], g[5], g[6], g[7]};
        return;
    }
    float o[8];
    size_t base;
    if (type == 3 || type == 7) {
#pragma unroll
        for (int j = 0; j < 8; ++j) o[j] = siluf_(v[j]);
        base = (type == 3) ? WS_HG : WS_DG;
    } else if (type == 4 || type == 5) {
        const int i0 = (c & 63) >> 1;
        const f32x4 cs = *(const f32x4*)((const float*)(ws + WS_COS) + (size_t)t * 32 + i0);
        const f32x4 sn = *(const f32x4*)((const float*)(ws + WS_SIN) + (size_t)t * 32 + i0);
        const float sc = (type == 4) ? QSCALE : 1.0f;
#pragma unroll
        for (int j = 0; j < 4; ++j) { const float x1 = v[2 * j], x2 = v[2 * j + 1];
            o[2 * j] = (x1 * cs[j] - x2 * sn[j]) * sc; o[2 * j + 1] = (x2 * cs[j] + x1 * sn[j]) * sc; }
        base = (type == 4) ? WS_DQ : WS_DK;
    } else {
#pragma unroll
        for (int j = 0; j < 8; ++j) o[j] = v[j];
        base = (type == 0) ? WS_HQ : (type == 2) ? WS_HI : WS_DV;
    }
    u32x4 w = {pk2(o[0], o[1]), pk2(o[2], o[3]), pk2(o[4], o[5]), pk2(o[6], o[7])};
    *(u32x4*)((bf16_t*)(ws + base) + off) = w;
}

__device__ __forceinline__ void prologue_phase(const Params& P, int bid, int nblk, float* scr  ) {
    const int tid = threadIdx.x, lane = tid & 63, wave = tid >> 6, nwv = blockDim.x >> 6;
    const int gw = bid * nwv + wave, NGW = nblk * nwv;
    unsigned char* ws = P.ws;
    if (bid == 0 && wave == 0) {
        float a = P.lq1[lane] * P.lk1[lane], b = P.lq2[lane] * P.lk2[lane];
        a = wave_sum(a); b = wave_sum(b);
        if (lane == 0) ((float*)(ws + WS_CTL))[CT_LAM] = __expf(a) - __expf(b) + LAMBDA_INIT;
    }
    if (bid == 0) {
        for (int c = tid; c < DH; c += blockDim.x) { const float l0 = P.lb_logits[c], l1 = P.lb_logits[DH + c]; ((float*)(ws + WS_CTL))[CT_LB + c] = 1.0f / (1.0f + __expf(l1 - l0)); }
    }
    for (int idx = bid * blockDim.x + tid; idx < T * 32; idx += nblk * blockDim.x) {
        const int t = idx >> 5, i = idx & 31;
        const float invf = 1.0f / exp2f((float)i * (13.287712379549449f / 32.0f));
        const float ang = (float)t * invf;
        const double rev = (double)ang * 0.15915494309189535;
        const float fr = (float)(rev - __builtin_rint(rev));
        ((float*)(ws + WS_COS))[idx] = __builtin_amdgcn_cosf(fr);
        ((float*)(ws + WS_SIN))[idx] = __builtin_amdgcn_sinf(fr);
    }
    float* s = scr + wave * (64 * 33);
    constexpr int I_IN = (DM / 64) * (DIN / 32), I_OUT = (DM / 64) * (DM / 32);
    for (int it = gw; it < I_IN + I_OUT; it += NGW) {
        const bool isin = it < I_IN; const int r = isin ? it : it - I_IN;
        const float* W = isin ? P.w_in : P.w_out; const int N = isin ? DIN : DM;
        bf16_t* WT = (bf16_t*)(ws + (isin ? WS_WIN : WS_WOUT));
        const int nblkn = N / 32, kb = r / nblkn, nb = r % nblkn, k0 = 64 * kb, n0 = 32 * nb;
        const int ncol = isin ? win_orig_col(n0 + (lane & 31)) : n0 + (lane & 31);
#pragma unroll 8
        for (int i = 0; i < 32; ++i) { const int kk = 2 * i + (lane >> 5); s[kk * 33 + (lane & 31)] = W[(size_t)(k0 + kk) * N + ncol]; }
        __builtin_amdgcn_wave_barrier(); asm volatile("s_waitcnt lgkmcnt(0)" ::: "memory");
        const int c = lane & 7;
#pragma unroll
        for (int j = 0; j < 4; ++j) { const int n = (lane >> 3) + 8 * j; const float* q = s + (8 * c) * 33 + n;
            u32x4 o; o.x = pk2(q[0 * 33], q[1 * 33]); o.y = pk2(q[2 * 33], q[3 * 33]); o.z = pk2(q[4 * 33], q[5 * 33]); o.w = pk2(q[6 * 33], q[7 * 33]);
            *(u32x4*)(WT + (size_t)(n0 + n) * DM + k0 + 8 * c) = o; }
        __builtin_amdgcn_wave_barrier(); asm volatile("s_waitcnt lgkmcnt(0)" ::: "memory");
    }
    for (int m = gw; m < T; m += NGW) {
        const f32x4* xr = (const f32x4*)(P.x + (size_t)m * DM) + lane; const f32x4* wr = (const f32x4*)P.norm_w + lane;
        f32x4 v[4]; float ss = 0.f;
#pragma unroll
        for (int j = 0; j < 4; ++j) { v[j] = xr[64 * j]; ss += (v[j].x * v[j].x + v[j].y * v[j].y) + (v[j].z * v[j].z + v[j].w * v[j].w); }
        const float rstd = 1.0f / sqrtf(wave_sum(ss) * (1.0f / DM) + NORM_EPS);
        u32x2* o8 = (u32x2*)((bf16_t*)(ws + WS_XN) + (size_t)m * DM) + lane;
#pragma unroll
        for (int j = 0; j < 4; ++j) { const f32x4 w = wr[64 * j]; u32x2 o; o.x = pk2(v[j].x * rstd * w.x, v[j].y * rstd * w.y); o.y = pk2(v[j].z * rstd * w.z, v[j].w * rstd * w.w); o8[64 * j] = o; }
    }
}

__global__ void __launch_bounds__(512) k_prologue(Params P) {
    __shared__ float scr[8 * 64 * 33];
    prologue_phase(P, blockIdx.x, gridDim.x, scr);
}

__global__ void __launch_bounds__(256) k_naive_gemm_in(Params P) {
    __shared__ float As[64][33], Bs[64][33];
    const bf16_t* A = (const bf16_t*)(P.ws + WS_XN); const bf16_t* B = (const bf16_t*)(P.ws + WS_WIN);
    const int tid = threadIdx.x, ty = tid >> 3, tx = tid & 7, m0 = blockIdx.y * 64, n0 = blockIdx.x * 64;
    float acc[2][8] = {};
    const int lr = tid >> 2, lk = (tid & 3) * 8;
    for (int k0 = 0; k0 < DM; k0 += 32) {
        const u32x4 a = *(const u32x4*)(A + (size_t)(m0 + lr) * DM + k0 + lk), b = *(const u32x4*)(B + (size_t)(n0 + lr) * DM + k0 + lk);
#pragma unroll
        for (int j = 0; j < 4; ++j) { As[lr][lk + 2 * j] = __uint_as_float(a[j] << 16); As[lr][lk + 2 * j + 1] = __uint_as_float(a[j] & 0xffff0000u);
            Bs[lr][lk + 2 * j] = __uint_as_float(b[j] << 16); Bs[lr][lk + 2 * j + 1] = __uint_as_float(b[j] & 0xffff0000u); }
        __syncthreads();
#pragma unroll 8
        for (int k = 0; k < 32; ++k) { const float a0 = As[2 * ty][k], a1 = As[2 * ty + 1][k];
#pragma unroll
            for (int j = 0; j < 8; ++j) { const float bv = Bs[8 * tx + j][k]; acc[0][j] += a0 * bv; acc[1][j] += a1 * bv; } }
        __syncthreads();
    }
    const int nc = n0 + 8 * tx, type = nc >> 9, c = nc & 511;
    epi8(P, type, m0 + 2 * ty, c, acc[0]); epi8(P, type, m0 + 2 * ty + 1, c, acc[1]);
}

__global__ void __launch_bounds__(128) k_naive_hgrn(Params P) {
    __shared__ float qs[32][128], fs[32][128];
    const int h = blockIdx.x, e = threadIdx.x;
    const bf16_t* HQ = (const bf16_t*)(P.ws + WS_HQ); const float* G = (const float*)(P.ws + WS_G); const bf16_t* HI = (const bf16_t*)(P.ws + WS_HI);
    float* OT = (float*)(P.ws + WS_OTMP);
    float S[128];
#pragma unroll
    for (int d = 0; d < 128; ++d) S[d] = 0.f;
    for (int t0 = 0; t0 < T; t0 += 32) {
        for (int i = 0; i < 32; ++i) { qs[i][e] = bf2f(HQ[(size_t)(t0 + i) * DH + h * HD + e]); fs[i][e] = __expf(G[(size_t)(t0 + i) * DH + h * HD + e]); }
        __syncthreads();
        for (int i = 0; i < 32; ++i) {
            const float v = bf2f(HI[(size_t)(t0 + i) * DH + h * HD + e]); float o = 0.f;
#pragma unroll
            for (int d = 0; d < 128; ++d) { const float f = fs[i][d]; S[d] = f * S[d] + (1.0f - f) * v; o += qs[i][d] * S[d]; }
            OT[(size_t)(t0 + i) * DH + h * HD + e] = o;
        }
        __syncthreads();
    }
}
__global__ void __launch_bounds__(256) k_naive_hgrn_norm(Params P) {
    const int lane = threadIdx.x & 63, gw = (blockIdx.x * blockDim.x + threadIdx.x) >> 6, ngw = (gridDim.x * blockDim.x) >> 6;
    const float* OT = (const float*)(P.ws + WS_OTMP); const bf16_t* HG = (const bf16_t*)(P.ws + WS_HG); bf16_t* MIX = (bf16_t*)(P.ws + WS_MIX);
    for (int r = gw; r < T * NH; r += ngw) {
        const int t = r >> 2, h = r & 3; const size_t off = (size_t)t * DH + h * HD + 2 * lane;
        const float a = OT[off], b = OT[off + 1];
        const float rs = 1.0f / sqrtf(wave_sum(a * a + b * b) * (1.0f / HD) + NORM_EPS);
        const float y0 = a * rs * P.hgrn_norm_w[2 * lane] * bf2f(HG[off]), y1 = b * rs * P.hgrn_norm_w[2 * lane + 1] * bf2f(HG[off + 1]);
        *(unsigned*)(MIX + (size_t)t * DM + h * HD + 2 * lane) = pk2(y0, y1);
    }
}

__global__ void __launch_bounds__(256) k_naive_attn(Params P) {
    __shared__ float Kt[32][128], Vt[32][128];
    const int tid = threadIdx.x, tl = tid >> 2, vq = tid & 3, h = blockIdx.y, t0 = (gridDim.x - 1 - blockIdx.x) * 64, t = t0 + tl;
    const bf16_t* DQ = (const bf16_t*)(P.ws + WS_DQ); const bf16_t* DK = (const bf16_t*)(P.ws + WS_DK); const bf16_t* DV = (const bf16_t*)(P.ws + WS_DV);
    const bf16_t* DG = (const bf16_t*)(P.ws + WS_DG); bf16_t* MIX = (bf16_t*)(P.ws + WS_MIX);
    const float lam = ((const float*)(P.ws + WS_CTL))[CT_LAM];
    float q1[64], q2[64], o1[32], o2[32];
#pragma unroll
    for (int d = 0; d < 64; ++d) { q1[d] = bf2f(DQ[(size_t)t * DH + h * HD + d]); q2[d] = bf2f(DQ[(size_t)t * DH + h * HD + 64 + d]); }
#pragma unroll
    for (int j = 0; j < 32; ++j) { o1[j] = 0.f; o2[j] = 0.f; }
    float m1 = -1e30f, m2 = -1e30f, l1 = 0.f, l2 = 0.f;
    const int nt = (t0 + 64) / 32;
    for (int kt = 0; kt < nt; ++kt) {
        const int s0 = kt * 32;
        for (int i = tid; i < 32 * 128; i += 256) { const int r = i >> 7, c = i & 127; Kt[r][c] = bf2f(DK[(size_t)(s0 + r) * DH + h * HD + c]); Vt[r][c] = bf2f(DV[(size_t)(s0 + r) * DH + h * HD + c]); }
        __syncthreads();
        for (int s = 0; s < 32; ++s) {
            if (s0 + s <= t) {
                float a = 0.f, b = 0.f;
#pragma unroll
                for (int d = 0; d < 64; ++d) { a += q1[d] * Kt[s][d]; b += q2[d] * Kt[s][64 + d]; }
                { const float mn = fmaxf(m1, a), al = exp2f(m1 - mn), p = exp2f(a - mn); l1 = l1 * al + p; m1 = mn;
#pragma unroll
                  for (int j = 0; j < 32; ++j) o1[j] = o1[j] * al + p * Vt[s][vq * 32 + j]; }
                { const float mn = fmaxf(m2, b), al = exp2f(m2 - mn), p = exp2f(b - mn); l2 = l2 * al + p; m2 = mn;
#pragma unroll
                  for (int j = 0; j < 32; ++j) o2[j] = o2[j] * al + p * Vt[s][vq * 32 + j]; }
            }
        }
        __syncthreads();
    }
    const float i1 = 1.0f / l1, i2 = lam / l2; float ss = 0.f;
#pragma unroll
    for (int j = 0; j < 32; ++j) { o1[j] = o1[j] * i1 - o2[j] * i2; ss += o1[j] * o1[j]; }
    ss += __shfl_xor(ss, 1); ss += __shfl_xor(ss, 2);
    const float rs = (1.0f - LAMBDA_INIT) / sqrtf(ss * (1.0f / HD) + SUBLN_EPS);
#pragma unroll
    for (int j = 0; j < 32; j += 2) {
        const int c = vq * 32 + j;
        const float y0 = o1[j] * rs * P.diff_norm_w[c] * bf2f(DG[(size_t)t * DH + h * HD + c]), y1 = o1[j + 1] * rs * P.diff_norm_w[c + 1] * bf2f(DG[(size_t)t * DH + h * HD + c + 1]);
        *(unsigned*)(MIX + (size_t)t * DM + DH + h * HD + c) = pk2(y0, y1);
    }
}

__global__ void __launch_bounds__(256) k_naive_gemm_out(Params P) {
    __shared__ float As[64][33], Bs[32][65];
    const bf16_t* A = (const bf16_t*)(P.ws + WS_MIX);
    const int tid = threadIdx.x, ty = tid >> 3, tx = tid & 7, m0 = blockIdx.y * 64, n0 = blockIdx.x * 64;
    float acc[2][8] = {};
    const int lr = tid >> 2, lk = (tid & 3) * 8;
    for (int k0 = 0; k0 < DM; k0 += 32) {
        const u32x4 a = *(const u32x4*)(A + (size_t)(m0 + lr) * DM + k0 + lk);
#pragma unroll
        for (int j = 0; j < 4; ++j) { As[lr][lk + 2 * j] = __uint_as_float(a[j] << 16); As[lr][lk + 2 * j + 1] = __uint_as_float(a[j] & 0xffff0000u); }
        for (int i = tid; i < 32 * 64; i += 256) { const int kk = i >> 6, nn = i & 63; Bs[kk][nn] = P.w_out[(size_t)(k0 + kk) * DM + n0 + nn]; }
        __syncthreads();
#pragma unroll 8
        for (int k = 0; k < 32; ++k) { const float a0 = As[2 * ty][k], a1 = As[2 * ty + 1][k];
#pragma unroll
            for (int j = 0; j < 8; ++j) { const float bv = Bs[k][8 * tx + j]; acc[0][j] += a0 * bv; acc[1][j] += a1 * bv; } }
        __syncthreads();
    }
#pragma unroll
    for (int r = 0; r < 2; ++r) { const size_t off = (size_t)(m0 + 2 * ty + r) * DM + n0 + 8 * tx;
#pragma unroll
        for (int j = 0; j < 8; ++j) P.out[off + j] = P.x[off + j] + acc[r][j]; }
}
__global__ void __launch_bounds__(256) k_final_norm(Params P) {
    const int lane = threadIdx.x & 63, gw = (blockIdx.x * blockDim.x + threadIdx.x) >> 6, ngw = (gridDim.x * blockDim.x) >> 6;
    for (int m = gw; m < T; m += ngw) {
        f32x4* yr = (f32x4*)(P.out + (size_t)m * DM) + lane; const f32x4* wr = (const f32x4*)P.final_norm_w + lane;
        f32x4 v[4]; float ss = 0.f;
#pragma unroll
        for (int j = 0; j < 4; ++j) { v[j] = yr[64 * j]; ss += (v[j].x * v[j].x + v[j].y * v[j].y) + (v[j].z * v[j].z + v[j].w * v[j].w); }
        const float rstd = 1.0f / sqrtf(wave_sum(ss) * (1.0f / DM) + NORM_EPS);
#pragma unroll
        for (int j = 0; j < 4; ++j) { const f32x4 w = wr[64 * j]; yr[64 * j] = (f32x4){v[j].x * rstd * w.x, v[j].y * rstd * w.y, v[j].z * rstd * w.z, v[j].w * rstd * w.w}; }
    }
}


namespace pg8 {
#define PG8_LAS __attribute__((address_space(3)))
typedef short bf16x8 __attribute__((ext_vector_type(8)));
constexpr int BM = 256, BK = 64, HALF = 128, HTB = HALF * BK * 2  , STAGE_BYTES = 8 * HTB, NXCD = 8, WGM = 8;
__host__ __device__ __forceinline__ int lds_byte(int r, int c) { const int st = (r >> 4) * 2 + (c >> 5), rr = r & 15, cc = c & 31, ob = rr * 64 + cc * 2; return st * 1024 + (ob ^ (((ob >> 9) & 1) << 5)); }
__host__ __device__ __forceinline__ void stage_rc(int b, int& R, int& C) { const int st = b / 1024, sb = b % 1024, swz = sb ^ (((sb >> 9) & 1) << 5); R = (st >> 1) * 16 + swz / 64; C = (st & 1) * 32 + (swz % 64) / 2; }
__host__ __device__ __forceinline__ int perm32(int rho) { const int n = rho >> 4, i = rho & 15; return 8 * (i >> 2) + 4 * n + (i & 3); }
struct Unit { int pm, pn; };
struct Gemm { const bf16_t* A; const bf16_t* Bt; int M, N, K; };
struct StaticOrder {
    int nM, nN, nwg, G, c;
    __host__ __device__ void init(int M, int N, int G_, int c_) { nM = M / BM; nN = N / BM; nwg = nM * nN; G = G_; c = c_; }
    __host__ __device__ bool next(int i, Unit& u) const {
        const long L = (long)i * G + c; if (L >= nwg) return false;
        int wgid = (int)L; { const int q = nwg / NXCD, r = nwg % NXCD, xcd = wgid % NXCD, off = wgid / NXCD; wgid = (xcd < r ? xcd * (q + 1) : r * (q + 1) + (xcd - r) * q) + off; }
        const int nig = WGM * nN, gid = wgid / nig, fm = gid * WGM, gsz = (nM - fm) < WGM ? (nM - fm) : WGM;
        u.pm = fm + ((wgid % nig) % gsz); u.pn = (wgid % nig) / gsz; return true;
    }
    __device__ __forceinline__ void a_ready(const Unit&) const {}
    __device__ __forceinline__ void done(const Unit&) const {}
};
template <class Epi, class Sched, bool ALIGN_EPI = false, bool SP2 = false>
__device__ __forceinline__ void gemm_phase(PG8_LAS unsigned char* lds, const Gemm g, const Sched& S, const Epi& E) {
    const int tid = opaque_tid(), wid = __builtin_amdgcn_readfirstlane(tid >> 6), lane = tid & 63, wr = wid >> 2, wc = wid & 3, fr = lane & 15, fq = lane >> 4;
    const int K = g.K, nt = K / BK;
    unsigned voffA[2], voffB[2];
#pragma unroll
    for (int i = 0; i < 2; ++i) { int R, C; stage_rc(tid * 16 + i * 8192, R, C); const int Rb = Epi::PERM ? ((R & ~31) + perm32(R & 31)) : R;
        voffA[i] = (unsigned)(R * K + C) * 2u; voffB[i] = (unsigned)(Rb * K + C) * 2u; }
    const size_t kstep = (size_t)(BK * 2);
    const size_t hstep = (size_t)HALF * K * 2;
    const size_t tstep = 2 * hstep;
    const unsigned ldsw = (unsigned)wid * 1024u;
    const int aoff = lds_byte(wr * 64 + fr, fq * 8), boff = lds_byte(wc * 32 + fr, fq * 8);
#define PG8_SA(b, h) (((b) * 2 + (h)) * HTB)
#define PG8_SB(b, h) ((4 + (b) * 2 + (h)) * HTB)
#define PG8_STAGE(bufoff, gbase, voff) do { _Pragma("unroll") for (int _i = 0; _i < 2; ++_i) \
        __builtin_amdgcn_global_load_lds((const unsigned*)((const char*)(gbase) + (voff)[_i]), (PG8_LAS unsigned*)(lds + (bufoff) + ldsw + _i * 8192), 16, 0, 0); } while (0)
#define PG8_LDA(dst, b, h) do { _Pragma("unroll") for (int m = 0; m < 4; ++m) _Pragma("unroll") for (int k = 0; k < 2; ++k) dst[m][k] = *(const PG8_LAS bf16x8*)(lds + PG8_SA(b, h) + aoff + m * 2048 + k * 1024); } while (0)
#define PG8_LDB(dst, b, h) do { _Pragma("unroll") for (int n = 0; n < 2; ++n) _Pragma("unroll") for (int k = 0; k < 2; ++k) dst[n][k] = *(const PG8_LAS bf16x8*)(lds + PG8_SB(b, h) + boff + n * 2048 + k * 1024); } while (0)
#define PG8_MMA(ai, bj, At, Bt) do { __builtin_amdgcn_s_setprio(1); _Pragma("unroll") for (int m = 0; m < 4; ++m) _Pragma("unroll") for (int n = 0; n < 2; ++n) _Pragma("unroll") for (int k = 0; k < 2; ++k) \
        acc[ai][bj][m][n] = __builtin_amdgcn_mfma_f32_16x16x32_bf16(Bt[n][k], At[m][k], acc[ai][bj][m][n], 0, 0, 0); __builtin_amdgcn_s_setprio(0); } while (0)
#define PG8_WAIT_V(n) asm volatile("s_waitcnt vmcnt(" #n ")" ::: "memory")
#define PG8_WAIT_L(n) asm volatile("s_waitcnt lgkmcnt(" #n ")" ::: "memory")
#define PG8_BAR __builtin_amdgcn_s_barrier()
#define PG8_SCHED __builtin_amdgcn_sched_barrier(0)
    Unit cur, nxt; int ui = 0;
    if (!S.next(0, cur)) return;
    f32x4 acc[2][2][4][2];
#pragma unroll
    for (int a = 0; a < 2; ++a)
#pragma unroll
        for (int b = 0; b < 2; ++b)
#pragma unroll
            for (int m = 0; m < 4; ++m)
#pragma unroll
                for (int n = 0; n < 2; ++n) acc[a][b][m][n] = (f32x4){0.f, 0.f, 0.f, 0.f};
    bf16x8 At[4][2], B0[2][2], B1[2][2];
    const char* cA = (const char*)g.A + (size_t)cur.pm * tstep; const char* cB = (const char*)g.Bt + (size_t)cur.pn * tstep;
    S.a_ready(cur);
    if constexpr (SP2) {
        PG8_STAGE(PG8_SB(0, 0), cB, voffB); PG8_STAGE(PG8_SB(0, 1), cB + hstep, voffB); PG8_STAGE(PG8_SA(0, 0), cA, voffA); PG8_STAGE(PG8_SA(0, 1), cA + hstep, voffA);
        if (wr == 1) PG8_BAR;
        PG8_WAIT_V(2); PG8_BAR;
        PG8_STAGE(PG8_SB(1, 0), cB + kstep, voffB); PG8_STAGE(PG8_SA(1, 0), cA + kstep, voffA); PG8_STAGE(PG8_SB(1, 1), cB + hstep + kstep, voffB);
        PG8_WAIT_V(6); PG8_BAR;
    } else {
        PG8_STAGE(PG8_SB(0, 0), cB, voffB); PG8_STAGE(PG8_SA(0, 0), cA, voffA); PG8_STAGE(PG8_SB(0, 1), cB + hstep, voffB); PG8_STAGE(PG8_SA(0, 1), cA + hstep, voffA);
        if (wr == 1) PG8_BAR;
        PG8_WAIT_V(4); PG8_BAR;
        PG8_STAGE(PG8_SB(1, 0), cB + kstep, voffB); PG8_STAGE(PG8_SA(1, 0), cA + kstep, voffA); PG8_STAGE(PG8_SB(1, 1), cB + hstep + kstep, voffB);
        PG8_WAIT_V(6); PG8_BAR;
    }
    for (;;) {
        const bool has_next = S.next(ui + 1, nxt);
        const char* nA = has_next ? (const char*)g.A + (size_t)nxt.pm * tstep : cA; const char* nB = has_next ? (const char*)g.Bt + (size_t)nxt.pn * tstep : cB;
        for (int t = 0; t < nt; t += 2) {
            const bool last = (t == nt - 2);
            const char* a1 = cA + (size_t)(t + 1) * kstep;
            const char* a2 = last ? nA : cA + (size_t)(t + 2) * kstep; const char* b2 = last ? nB : cB + (size_t)(t + 2) * kstep;
            const char* a3 = a2 + kstep; const char* b3 = b2 + kstep;
            if (last && has_next) S.a_ready(nxt);
            if constexpr (SP2) {
            PG8_LDB(B0, 0, 0); PG8_LDB(B1, 0, 1); PG8_SCHED; PG8_LDA(At, 0, 0); PG8_STAGE(PG8_SA(1, 1), a1 + hstep, voffA);
            PG8_WAIT_V(8); PG8_WAIT_L(0); PG8_BAR; PG8_MMA(0, 0, At, B0); PG8_MMA(0, 1, At, B1); PG8_BAR; PG8_SCHED;
            PG8_LDA(At, 0, 1); PG8_STAGE(PG8_SB(0, 0), b2, voffB); PG8_STAGE(PG8_SB(0, 1), b2 + hstep, voffB); PG8_STAGE(PG8_SA(0, 0), a2, voffA);
            PG8_WAIT_V(8); PG8_WAIT_L(0); PG8_BAR; PG8_MMA(1, 0, At, B0); PG8_MMA(1, 1, At, B1); PG8_BAR; PG8_SCHED;
            PG8_LDB(B0, 1, 0); PG8_LDB(B1, 1, 1); PG8_SCHED; PG8_LDA(At, 1, 0); PG8_STAGE(PG8_SA(0, 1), a2 + hstep, voffA);
            PG8_WAIT_V(8); PG8_WAIT_L(0); PG8_BAR; PG8_MMA(0, 0, At, B0); PG8_MMA(0, 1, At, B1); PG8_BAR; PG8_SCHED;
            PG8_LDA(At, 1, 1); PG8_STAGE(PG8_SB(1, 0), b3, voffB); PG8_STAGE(PG8_SB(1, 1), b3 + hstep, voffB); PG8_STAGE(PG8_SA(1, 0), a3, voffA);
            PG8_WAIT_V(8); PG8_WAIT_L(0); PG8_BAR; PG8_MMA(1, 0, At, B0); PG8_MMA(1, 1, At, B1); PG8_BAR; PG8_SCHED;
            } else {
            PG8_LDB(B0, 0, 0); PG8_SCHED; PG8_LDA(At, 0, 0); PG8_STAGE(PG8_SA(1, 1), a1 + hstep, voffA);
            PG8_WAIT_L(8); PG8_BAR; PG8_WAIT_L(0); PG8_MMA(0, 0, At, B0); PG8_BAR; PG8_SCHED;
            PG8_LDB(B1, 0, 1); PG8_STAGE(PG8_SB(0, 0), b2, voffB);
            PG8_BAR; PG8_WAIT_L(0); PG8_MMA(0, 1, At, B1); PG8_BAR;
            PG8_LDA(At, 0, 1); PG8_STAGE(PG8_SA(0, 0), a2, voffA);
            PG8_BAR; PG8_WAIT_L(0); PG8_MMA(1, 0, At, B0); PG8_BAR; PG8_SCHED;
            PG8_STAGE(PG8_SB(0, 1), b2 + hstep, voffB);
            PG8_WAIT_V(6); PG8_BAR; PG8_MMA(1, 1, At, B1); PG8_BAR;
            PG8_LDB(B0, 1, 0); PG8_SCHED; PG8_LDA(At, 1, 0); PG8_STAGE(PG8_SA(0, 1), a2 + hstep, voffA);
            PG8_WAIT_L(8); PG8_BAR; PG8_WAIT_L(0); PG8_MMA(0, 0, At, B0); PG8_BAR; PG8_SCHED;
            PG8_LDB(B1, 1, 1); PG8_STAGE(PG8_SB(1, 0), b3, voffB);
            PG8_BAR; PG8_WAIT_L(0); PG8_MMA(0, 1, At, B1); PG8_BAR;
            PG8_LDA(At, 1, 1); PG8_STAGE(PG8_SA(1, 0), a3, voffA);
            PG8_BAR; PG8_WAIT_L(0); PG8_MMA(1, 0, At, B0); PG8_BAR; PG8_SCHED;
            PG8_STAGE(PG8_SB(1, 1), b3 + hstep, voffB);
            PG8_WAIT_V(6); PG8_BAR; PG8_MMA(1, 1, At, B1); PG8_BAR;
            }
        }
        if constexpr (ALIGN_EPI) { if (wr == 0) PG8_BAR; }
        if constexpr (!Epi::AFTER_DRAIN) { E(acc, cur, wr, wc, fr, fq); S.done(cur); }
        if (!has_next) break;
#pragma unroll
        for (int a = 0; a < 2; ++a)
#pragma unroll
            for (int b = 0; b < 2; ++b)
#pragma unroll
                for (int m = 0; m < 4; ++m)
#pragma unroll
                    for (int n = 0; n < 2; ++n) acc[a][b][m][n] = (f32x4){0.f, 0.f, 0.f, 0.f};
        cur = nxt; cA = nA; cB = nB; ++ui;
        if constexpr (ALIGN_EPI) { if (wr == 1) PG8_BAR; }
    }
    PG8_WAIT_V(0);
    if constexpr (!ALIGN_EPI) { if (wr == 0) PG8_BAR; }
    PG8_BAR;
    if constexpr (Epi::AFTER_DRAIN) { E.fused(acc, cur, wr, wc, fr, fq, lds, wid, lane); S.done(cur); }
#undef PG8_SA
#undef PG8_SB
#undef PG8_STAGE
#undef PG8_LDA
#undef PG8_LDB
#undef PG8_MMA
#undef PG8_WAIT_V
#undef PG8_WAIT_L
#undef PG8_BAR
#undef PG8_SCHED
}
}

struct EpiIn {
    static constexpr bool PERM = true, AFTER_DRAIN = false;
    Params P;
    template <int TYPE> __device__ __forceinline__ void run(const f32x4 (&acc)[2][2][4][2], const pg8::Unit& u, int wr, int wc, int fr, int fq) const {
        const int row0 = u.pm * pg8::BM + wr * 64 + fr, c0 = (u.pn & 1) * 256 + wc * 32 + 8 * fq;
#pragma unroll
        for (int ai = 0; ai < 2; ++ai)
#pragma unroll
            for (int m = 0; m < 4; ++m)
#pragma unroll
                for (int bj = 0; bj < 2; ++bj) {
                    const f32x4 v0 = acc[ai][bj][m][0], v1 = acc[ai][bj][m][1];
                    const float v[8] = {v0[0], v0[1], v0[2], v0[3], v1[0], v1[1], v1[2], v1[3]};
                    epi8(P, TYPE, row0 + ai * pg8::HALF + m * 16, c0 + bj * pg8::HALF, v);
                }
    }
    __device__ __forceinline__ void operator()(const f32x4 (&acc)[2][2][4][2], const pg8::Unit& u, int wr, int wc, int fr, int fq) const {
        switch (u.pn >> 1) {
            case 0: run<0>(acc, u, wr, wc, fr, fq); break; case 1: run<1>(acc, u, wr, wc, fr, fq); break;
            case 2: run<2>(acc, u, wr, wc, fr, fq); break; case 3: run<3>(acc, u, wr, wc, fr, fq); break;
            case 4: run<4>(acc, u, wr, wc, fr, fq); break; case 5: run<5>(acc, u, wr, wc, fr, fq); break;
            case 6: run<6>(acc, u, wr, wc, fr, fq); break; default: run<7>(acc, u, wr, wc, fr, fq); break;
        }
    }
};
struct EpiOut {
    static constexpr bool PERM = false, AFTER_DRAIN = false;
    Params P;
    __device__ __forceinline__ void operator()(const f32x4 (&acc)[2][2][4][2], const pg8::Unit& u, int wr, int wc, int fr, int fq) const {
        float* rowsq = (float*)(P.ws + WS_CTL) + CT_ROWSQ;
        const int col0 = u.pn * pg8::BM + wc * 32 + 4 * fq;
#pragma unroll
        for (int ai = 0; ai < 2; ++ai)
#pragma unroll
            for (int m = 0; m < 4; ++m) {
                const int r = u.pm * pg8::BM + ai * pg8::HALF + wr * 64 + m * 16 + fr; const size_t off = (size_t)r * DM + col0; float ss = 0.f;
#pragma unroll
                for (int bj = 0; bj < 2; ++bj)
#pragma unroll
                    for (int n = 0; n < 2; ++n) { const f32x4 xv = *(const f32x4*)(P.x + off + bj * pg8::HALF + n * 16); const f32x4 y = xv + acc[ai][bj][m][n];
                        ss += (y[0] * y[0] + y[1] * y[1]) + (y[2] * y[2] + y[3] * y[3]); *(f32x4*)(P.out + off + bj * pg8::HALF + n * 16) = y; }
                ss += __shfl_xor(ss, 16); ss += __shfl_xor(ss, 32);
                if (fq == 0) atomicAdd(rowsq + r, ss);
            }
    }
};

namespace att {
typedef short bf16x8 __attribute__((ext_vector_type(8)));
typedef short s16x4 __attribute__((ext_vector_type(4)));
typedef float f32x16 __attribute__((ext_vector_type(16)));
constexpr int QBLK = 32, KVBLK = 64, QB = 128;
constexpr int SHM_V = KVBLK * 128 * 2, SHM_K = KVBLK * 128 * 2;
constexpr int OFF_V = 0, OFF_K = 2 * SHM_V, OFF_WS = 2 * SHM_V + 2 * SHM_K, OFF_X = OFF_WS + 8 * 64 * 4, XW = 4224  , LDS_BYTES = OFF_X + 4 * XW * 4;
constexpr float THR = 8.f;
#define KSWZ(row, colB) ((row) * 256 + ((colB) ^ (((row) & 7) << 4)))
#define SBAR() __builtin_amdgcn_sched_barrier(0)
__device__ __forceinline__ int v_st(int k, int c) { const int kk = (k & ~0xC) | ((k & 4) << 1) | ((k & 8) >> 1); return ((kk >> 3) * 4 + (c >> 5)) * 512 + ((kk & 7) * 32 + (c & 31)) * 2; }
__device__ __forceinline__ int v_rd_base(int lane) { return ((lane & 3) << 3) | (((lane >> 2) & 3) << 6) | (((lane >> 4) & 1) << 5) | (((lane >> 5) & 1) << 8); }
constexpr int v_rd_off(int d0, int ks, int half) { return d0 * 512 + ks * 4096 + half * 2048; }
__device__ __forceinline__ int crow(int r, int hi) { return (r & 3) + 8 * (r >> 2) + 4 * hi; }
__device__ __forceinline__ unsigned cvtpk(float lo, float hi) { unsigned r; asm volatile("v_cvt_pk_bf16_f32 %0, %1, %2" : "=v"(r) : "v"(lo), "v"(hi)); return r; }
__device__ __forceinline__ void mask_tile(f32x16& p0, f32x16& p1, int dq) {
    const float NEG = -__builtin_inff();
#pragma unroll
    for (int r = 0; r < 16; ++r) { const int c = (r & 3) + 8 * (r >> 2); if (dq - c < 0) p0[r] = NEG; if (dq - c - 32 < 0) p1[r] = NEG; }
}
__device__ __forceinline__ float rowmax32(const f32x16& p0, const f32x16& p1) {
    float a = fmaxf(fmaxf(p0[0], p0[1]), p1[0]), b = fmaxf(fmaxf(p0[2], p0[3]), p1[1]); a = fmaxf(fmaxf(a, p1[2]), p1[3]);
#pragma unroll
    for (int r = 4; r < 16; r += 4) { a = fmaxf(fmaxf(a, p0[r]), p0[r + 1]); b = fmaxf(fmaxf(b, p0[r + 2]), p0[r + 3]); a = fmaxf(fmaxf(a, p1[r]), p1[r + 1]); b = fmaxf(fmaxf(b, p1[r + 2]), p1[r + 3]); }
    float m = fmaxf(a, b);
    auto rr = __builtin_amdgcn_permlane32_swap(__float_as_uint(m), __float_as_uint(m), false, false);
    return fmaxf(__uint_as_float(rr[0]), __uint_as_float(rr[1]));
}
template <bool FIRST>
__device__ __forceinline__ float decide(f32x16& p0, f32x16& p1, float& l_reg, f32x16& negm) {
    const float rm = rowmax32(p0, p1); float alpha = 1.f;
    if (FIRST || __builtin_expect(__any(rm > THR), 0)) {
        const float dl = FIRST ? rm : fmaxf(rm, 0.f); const float nm = negm[0] - dl;
#pragma unroll
        for (int r = 0; r < 16; ++r) { p0[r] -= dl; p1[r] -= dl; }
#pragma unroll
        for (int r = 0; r < 16; ++r) negm[r] = nm;
        asm volatile("" : "+v"(negm));
        if (!FIRST) { alpha = __builtin_amdgcn_exp2f(-dl); l_reg *= alpha; }
    }
    return alpha;
}
__device__ __forceinline__ void finishP(const f32x16& p0, const f32x16& p1, bf16x8& pa0, bf16x8& pa1, bf16x8& pa2, bf16x8& pa3) {
#define PK4(P, B_, OUT) do { unsigned a0 = cvtpk(P[B_+0], P[B_+1]), a1 = cvtpk(P[B_+2], P[B_+3]);                          \
        unsigned b0 = cvtpk(P[B_+4], P[B_+5]), b1 = cvtpk(P[B_+6], P[B_+7]);                                             \
        auto r0 = __builtin_amdgcn_permlane32_swap(a0, b0, false, false); auto r1 = __builtin_amdgcn_permlane32_swap(a1, b1, false, false); \
        u32x4 w = {r0[0], r1[0], r0[1], r1[1]}; OUT = *reinterpret_cast<bf16x8*>(&w); } while (0)
    PK4(p0, 0, pa0); PK4(p0, 8, pa1); PK4(p1, 0, pa2); PK4(p1, 8, pa3);
#undef PK4
}
template <int KB>
__device__ __forceinline__ void qkt(f32x16& p0, f32x16& p1, const char* K_lds, int kx, const char* qf, const f32x16& negm) {
    p0 = negm; p1 = negm;
#pragma unroll
    for (int d0 = 0; d0 < 4; ++d0) { const char* a = K_lds + KB * SHM_K + (kx ^ (d0 * 32));
        bf16x8 b0 = *reinterpret_cast<const bf16x8*>(a);
        bf16x8 b1 = *reinterpret_cast<const bf16x8*>(a + 32 * 256);
        const bf16x8 q = *reinterpret_cast<const bf16x8*>(qf + d0 * 1024);
        p0 = __builtin_amdgcn_mfma_f32_32x32x16_bf16(b0, q, p0, 0, 0, 0);
        p1 = __builtin_amdgcn_mfma_f32_32x32x16_bf16(b1, q, p1, 0, 0, 0); }
}
typedef short v4i16_t __attribute__((ext_vector_type(4)));
typedef __attribute__((address_space(3))) const char* lds_cptr;
__device__ __forceinline__ s16x4 vtr(lds_cptr p) { return __builtin_bit_cast(s16x4, __builtin_amdgcn_ds_read_tr16_b64_v4i16((__attribute__((address_space(3))) v4i16_t*)p)); }
template <int VB, bool EXPS>
__device__ __forceinline__ void pv_tile(f32x16* o, lds_cptr vp0, bf16x8 pa0, bf16x8 pa1, bf16x8 pa2, bf16x8 pa3, f32x16& X0, f32x16& X1, float& l_reg) {
#define VFR(d0, ks) ({ const s16x4 l_ = vtr(vp0 + VB * SHM_V + v_rd_off(d0, ks, 0)), h_ = vtr(vp0 + VB * SHM_V + v_rd_off(d0, ks, 1)); (bf16x8){l_[0], l_[1], l_[2], l_[3], h_[0], h_[1], h_[2], h_[3]}; })
#define GAPB(MF, X, B_) do { MF; if (EXPS) { X[B_] = __builtin_amdgcn_exp2f(X[B_]); X[B_ + 1] = __builtin_amdgcn_exp2f(X[B_ + 1]); sa += X[B_]; sb += X[B_ + 1]; asm volatile("" : "+v"(X), "+v"(sa), "+v"(sb)); } SBAR(); } while (0)
    float sa = 0.f, sb = 0.f;
    bf16x8 fa0, fa1, fa2, fa3;
#define PVD(d0, XA, BA, XB, BB) do { fa0 = VFR(d0, 0); fa1 = VFR(d0, 1); fa2 = VFR(d0, 2); fa3 = VFR(d0, 3); SBAR();  \
    GAPB(o[d0] = __builtin_amdgcn_mfma_f32_32x32x16_bf16(pa0, fa0, o[d0], 0, 0, 0), XA, BA);          \
    GAPB(o[d0] = __builtin_amdgcn_mfma_f32_32x32x16_bf16(pa1, fa1, o[d0], 0, 0, 0), XA, BA + 2);      \
    GAPB(o[d0] = __builtin_amdgcn_mfma_f32_32x32x16_bf16(pa2, fa2, o[d0], 0, 0, 0), XB, BB);          \
    GAPB(o[d0] = __builtin_amdgcn_mfma_f32_32x32x16_bf16(pa3, fa3, o[d0], 0, 0, 0), XB, BB + 2); } while (0)
    PVD(0, X0, 0, X0, 4); PVD(1, X0, 8, X0, 12); PVD(2, X1, 0, X1, 4); PVD(3, X1, 8, X1, 12);
    if (EXPS) l_reg += sa + sb;
#undef PVD
#undef GAPB
#undef VFR
}

__device__ __forceinline__ void attn_unit(const Params& P, int h, int qb, char* lds) {
    const int tid = opaque_tid(), wid = __builtin_amdgcn_readfirstlane(tid >> 6), lane = tid & 63, r32 = lane & 31, hi = lane >> 5;
    const int comp = wid >> 2, wq = wid & 3;
    const int q0 = qb * QB, NT = 2 * qb + 2;
    const int qlo = q0 + wq * QBLK, qm = qlo + r32 - 4 * hi;
    const bf16_t* DQ = (const bf16_t*)(P.ws + WS_DQ);
    char* V_lds = lds + OFF_V; char* K_lds = lds + OFF_K;
    float* ws = (float*)(lds + OFF_WS) + wid * 64; float* li_l = ws; float* al_l = ws + 32;
    float l_reg = 0.f; f32x16 o[4]; f32x16 negm;
    { float zf = 0.f; asm volatile("" : "+v"(zf));
#pragma unroll
      for (int r = 0; r < 16; ++r) { negm[r] = zf; o[0][r] = zf; o[1][r] = zf; o[2][r] = zf; o[3][r] = zf; } }
    const int kx = r32 * 256 + comp * 128 + ((hi * 16) ^ ((r32 & 7) << 4));
    const lds_cptr vp0 = (lds_cptr)V_lds + v_rd_base(lane);
    char* qf = lds + OFF_X + wid * 4096 + lane * 16;
#pragma unroll
    for (int d0 = 0; d0 < 4; ++d0) *(bf16x8*)(qf + d0 * 1024) = *(const bf16x8*)(DQ + (size_t)(qlo + r32) * DH + h * HD + comp * 64 + d0 * 16 + hi * 8);
    const __amdgpu_buffer_rsrc_t rsK = __builtin_amdgcn_make_buffer_rsrc((void*)(P.ws + WS_DK), 0, (unsigned)((size_t)T * DH * 2), 0x00020000);
    const __amdgpu_buffer_rsrc_t rsV = __builtin_amdgcn_make_buffer_rsrc((void*)(P.ws + WS_DV), 0, (unsigned)((size_t)T * DH * 2), 0x00020000);
    int voK0, voK1, voV0, voV1;
    { const int c0 = (2 * wid) * 64 + lane, c1 = c0 + 64;
      auto ksrc = [&](int ci) { const int row = ci >> 4, cc = (ci & 15) ^ (row & 7); return (row * DH + h * HD + cc * 8) * 2; };
      auto vsrc = [&](int ci) { const int st = ci >> 5, kk = (st >> 2) * 8 + ((ci & 31) >> 2), c = (st & 3) * 32 + (ci & 3) * 8;
                                const int k = (kk & ~0xC) | ((kk & 4) << 1) | ((kk & 8) >> 1); return (k * DH + h * HD + c) * 2; };
      voK0 = ksrc(c0); voK1 = ksrc(c1); voV0 = vsrc(c0); voV1 = vsrc(c1); }
    const unsigned ldsK = (unsigned)(uintptr_t)K_lds + (unsigned)wid * 2048u, ldsV = (unsigned)(uintptr_t)V_lds + (unsigned)wid * 2048u;
#define DMA1(rs, vo, m0v, so) asm volatile("s_nop 4\n\ts_mov_b32 m0, %0\n\ts_nop 0\n\tbuffer_load_dwordx4 %1, %2, %3 offen lds" :: "s"(m0v), "v"(vo), "s"(rs), "s"(so) : "m0", "memory")
#define DMA_K(t, bf) do { const unsigned so_ = (unsigned)__builtin_amdgcn_readfirstlane((t) * KVBLK * DH * 2), m_ = (unsigned)__builtin_amdgcn_readfirstlane(ldsK + (bf) * SHM_K); DMA1(rsK, voK0, m_, so_); DMA1(rsK, voK1, m_ + 1024u, so_); } while (0)
#define DMA_V(t, bf) do { const unsigned so_ = (unsigned)__builtin_amdgcn_readfirstlane((t) * KVBLK * DH * 2), m_ = (unsigned)__builtin_amdgcn_readfirstlane(ldsV + (bf) * SHM_V); DMA1(rsV, voV0, m_, so_); DMA1(rsV, voV1, m_ + 1024u, so_); } while (0)
#define WAIT_BAR(N) asm volatile("s_waitcnt vmcnt(" #N ") lgkmcnt(0)\n\ts_barrier" ::: "memory")
#define RESC(a) do { if (__any((a) < 1.f)) { if (hi == 0) al_l[r32] = (a); asm volatile("s_waitcnt lgkmcnt(0)" ::: "memory");              \
                     _Pragma("unroll") for (int d_ = 0; d_ < 4; ++d_) _Pragma("unroll") for (int r = 0; r < 16; ++r) o[d_][r] *= al_l[4 * hi + (r & 3) + 8 * (r >> 2)]; } } while (0)
#define KBASE(t) ((t) * KVBLK)
#define MASKT(P0_, P1_, t) do { const int kb_ = KBASE(t); if (kb_ + KVBLK - 1 > qlo) mask_tile(P0_, P1_, qm - kb_); } while (0)
    f32x16 pA0, pA1, pB0, pB1; float alX; bf16x8 pa0, pa1, pa2, pa3;
    DMA_K(0, 0); DMA_V(0, 0); DMA_K(1, 1);
    WAIT_BAR(2);
    SBAR(); qkt<0>(pA0, pA1, K_lds, kx, qf, negm);
    MASKT(pA0, pA1, 0); (void)decide<true>(pA0, pA1, l_reg, negm);
#pragma unroll
    for (int r = 0; r < 16; ++r) { pA0[r] = __builtin_amdgcn_exp2f(pA0[r]); pA1[r] = __builtin_amdgcn_exp2f(pA1[r]); l_reg += pA0[r] + pA1[r]; }
    DMA_V(1, 1);
    WAIT_BAR(2);
#define HALF_STEP(PX0, PX1, PY0, PY1, t, KB, VB, SB) do {                                                                    \
        DMA_K((t) + 1, SB);                                                                                                   \
        SBAR(); qkt<KB>(PX0, PX1, K_lds, kx, qf, negm);                                                                       \
        finishP(PY0, PY1, pa0, pa1, pa2, pa3); SBAR();                                                                 \
        MASKT(PX0, PX1, (t)); alX = decide<false>(PX0, PX1, l_reg, negm); SBAR();                                             \
        pv_tile<VB, true>(o, vp0, pa0, pa1, pa2, pa3, PX0, PX1, l_reg);                                                              \
        WAIT_BAR(2);                                                                                                          \
        DMA_V((t) + 1, SB);                                                                                                   \
        RESC(alX);                                                                                                            \
        WAIT_BAR(2); } while (0)
    for (int t = 1; t + 1 < NT; t += 2) {
        HALF_STEP(pB0, pB1, pA0, pA1, t, 1, 0, 0);
        HALF_STEP(pA0, pA1, pB0, pB1, t + 1, 0, 1, 1);
    }
    SBAR(); qkt<1>(pB0, pB1, K_lds, kx, qf, negm);
    finishP(pA0, pA1, pa0, pa1, pa2, pa3); SBAR();
    MASKT(pB0, pB1, NT - 1); alX = decide<false>(pB0, pB1, l_reg, negm); SBAR();
    pv_tile<0, true>(o, vp0, pa0, pa1, pa2, pa3, pB0, pB1, l_reg);
    RESC(alX);
    WAIT_BAR(0);
    finishP(pB0, pB1, pa0, pa1, pa2, pa3); SBAR();
    pv_tile<1, false>(o, vp0, pa0, pa1, pa2, pa3, pB0, pB1, l_reg);
    { auto rr = __builtin_amdgcn_permlane32_swap(__float_as_uint(l_reg), __float_as_uint(l_reg), false, false); l_reg = __uint_as_float(rr[0]) + __uint_as_float(rr[1]); }
    SBAR(); asm volatile("" ::: "memory");
    int le = lane; asm volatile("" : "+v"(le));
    const int r32e = le & 31, hie = le >> 5;
    float* wse = (float*)(lds + OFF_WS) + wid * 64;
    if (hie == 0) wse[r32e] = l_reg; asm volatile("s_waitcnt lgkmcnt(0)" ::: "memory");
    {
        float rli[16]; const float* lb_ = wse + 4 * hie;
#pragma unroll
        for (int r = 0; r < 16; ++r) rli[r] = __builtin_amdgcn_rcpf(lb_[(r & 3) + 8 * (r >> 2)]);
        if (comp == 1) { const float lam = ((const float*)(P.ws + WS_CTL))[CT_LAM];
#pragma unroll
            for (int r = 0; r < 16; ++r) rli[r] *= lam; }
#pragma unroll
        for (int d0 = 0; d0 < 4; ++d0)
#pragma unroll
            for (int r = 0; r < 16; ++r) o[d0][r] *= rli[r];
    }
    __syncthreads();
    float* X = (float*)(lds + OFF_X) + wq * XW;
    float* Xl = X + le;
    if (comp == 1) {
#pragma unroll
        for (int d0 = 0; d0 < 4; ++d0)
#pragma unroll
            for (int r = 0; r < 16; ++r) Xl[(d0 * 16 + r) * 64] = o[d0][r];
    }
    __syncthreads();
    if (comp == 0) {
#pragma unroll
        for (int r = 0; r < 16; ++r) { float s = 0.f;
#pragma unroll
            for (int d0 = 0; d0 < 4; ++d0) { const float v = o[d0][r] - Xl[(d0 * 16 + r) * 64]; o[d0][r] = v; s += v * v; }
            s += __shfl_xor(s, 1); s += __shfl_xor(s, 2); s += __shfl_xor(s, 4); s += __shfl_xor(s, 8); s += __shfl_xor(s, 16);
            const float rs = (1.0f - LAMBDA_INIT) / sqrtf(s * (1.0f / HD) + SUBLN_EPS);
#pragma unroll
            for (int d0 = 0; d0 < 4; ++d0) o[d0][r] *= rs; }
        asm volatile("s_waitcnt lgkmcnt(0)" ::: "memory"); SBAR();
        float* Xb = X + 4 * hie * 132 + r32e;
#pragma unroll
        for (int r = 0; r < 16; ++r)
#pragma unroll
            for (int d0 = 0; d0 < 4; ++d0) Xb[((r & 3) + 8 * (r >> 2)) * 132 + d0 * 32] = o[d0][r];
        asm volatile("s_waitcnt lgkmcnt(0)" ::: "memory"); SBAR();
        const int row = le >> 1, hf = le & 1, t = qlo + row;
        const bf16_t* DGp = (const bf16_t*)(P.ws + WS_DG) + (size_t)t * DH + h * HD + hf * 64; bf16_t* MXp = (bf16_t*)(P.ws + WS_MIX) + (size_t)t * DM + DH + h * HD + hf * 64;
        const float* nwp = P.diff_norm_w + hf * 64; const float* xr = X + row * 132 + hf * 64;
#pragma unroll
        for (int ps = 0; ps < 2; ++ps) {
            u32x4 g[4]; f32x4 y[8], nw[8];
#pragma unroll
            for (int k = 0; k < 4; ++k) g[k] = *(const u32x4*)(DGp + ps * 32 + k * 8);
#pragma unroll
            for (int k = 0; k < 8; ++k) { y[k] = *(const f32x4*)(xr + ps * 32 + k * 4); nw[k] = *(const f32x4*)(nwp + ps * 32 + k * 4); }
#pragma unroll
            for (int k = 0; k < 4; ++k) { u32x4 w;
#pragma unroll
                for (int j = 0; j < 2; ++j) { const f32x4 yy = y[2 * k + j] * nw[2 * k + j]; const unsigned g01 = g[k][2 * j], g23 = g[k][2 * j + 1];
                    w[2 * j] = pk2(yy.x * __uint_as_float(g01 << 16), yy.y * __uint_as_float(g01 & 0xffff0000u)); w[2 * j + 1] = pk2(yy.z * __uint_as_float(g23 << 16), yy.w * __uint_as_float(g23 & 0xffff0000u)); }
                *(u32x4*)(MXp + ps * 32 + k * 8) = w; }
            asm volatile("" ::: "memory");
        }
    }
    __syncthreads();
#undef DMA1
#undef DMA_K
#undef DMA_V
#undef WAIT_BAR
#undef RESC
#undef KBASE
#undef MASKT
#undef HALF_STEP
}
__device__ __forceinline__ void attn_phase(const Params& P, int vcu, int nblk, char* lds) {
    for (int it = vcu; it < 256; it += nblk) { const int h = it >> 6, j = it & 63; for (int u = 0; u < 2; ++u) attn_unit(P, h, u ? j : 127 - j, lds); }
}
#undef KSWZ
#undef SBAR
}

namespace hg {
typedef short bf16x8 __attribute__((ext_vector_type(8)));
typedef short s16x4 __attribute__((ext_vector_type(4)));
typedef float f32x16 __attribute__((ext_vector_type(16)));
typedef __attribute__((address_space(3))) unsigned char lds_u8;
constexpr int RS_Q = 272, RS_T = 320, RS_P = 144, RS_O = 528;
constexpr int OFF_QT = 0, OFF_KT = 17408, OFF_OO = 0, OFF_KH = 34816, OFF_VV = 55296, OFF_ST = 75776, OFF_PP = 110592, OFF_GT = 119808, OFF_BM = 123904, OFF_BL = 124416, LDS_BYTES = 124928;
__device__ __forceinline__ int crow(int r, int hi) { return (r & 3) + 8 * (r >> 2) + 4 * hi; }
__device__ __forceinline__ bf16x8 ld128(const lds_u8* p) { return *(const __attribute__((address_space(3))) bf16x8*)p; }
typedef short v4i16_t __attribute__((ext_vector_type(4)));
__device__ __forceinline__ s16x4 vtr(const lds_u8* p) { return __builtin_bit_cast(s16x4, __builtin_amdgcn_ds_read_tr16_b64_v4i16((__attribute__((address_space(3))) v4i16_t*)p)); }
__device__ __forceinline__ bf16x8 tr_frag(const lds_u8* base, int RS, int kbase, int nbase, int lane) {
    const lds_u8* p = base + (kbase + 8 * (lane >> 5) + ((lane & 15) >> 2)) * RS + (nbase + 16 * ((lane >> 4) & 1) + 4 * (lane & 3)) * 2;
    const s16x4 lo = vtr(p), hi = vtr(p + 4 * RS);
    return (bf16x8){lo[0], lo[1], lo[2], lo[3], hi[0], hi[1], hi[2], hi[3]};
}
#define MFMA32(a, b, c) __builtin_amdgcn_mfma_f32_32x32x16_bf16((a), (b), (c), 0, 0, 0)

template <bool FULL>
__device__ __forceinline__ void chunk_prep(const Params& P, int h, int tc, lds_u8* lds, float& bs0, float& bs1) {
    const int tid = opaque_tid(), d2 = tid & 63, rg = tid >> 6;
    const float* Gp = (const float*)(P.ws + WS_G) + (size_t)(tc + 8 * rg) * DH + h * HD + 2 * d2;
    const bf16_t* Qp = (const bf16_t*)(P.ws + WS_HQ) + (size_t)(tc + 8 * rg) * DH + h * HD + 2 * d2;
    const bf16_t* Vp = (const bf16_t*)(P.ws + WS_HI) + (size_t)(tc + (tid >> 4)) * DH + h * HD + (tid & 15) * 8;
    f32x2 g[8]; unsigned qraw[8];
#pragma unroll
    for (int i = 0; i < 8; ++i) { g[i] = *(const f32x2*)(Gp + (size_t)i * DH); if (FULL) qraw[i] = *(const unsigned*)(Qp + (size_t)i * DH); }
    const u32x4 va = *(const u32x4*)Vp, vb = *(const u32x4*)(Vp + (size_t)32 * DH);
    f32x2 cs[8]; float c0 = 0.f, c1 = 0.f;
#pragma unroll
    for (int i = 0; i < 8; ++i) { c0 += g[i].x; c1 += g[i].y; cs[i] = (f32x2){c0, c1}; }
    __attribute__((address_space(3))) float* GT = (__attribute__((address_space(3))) float*)(lds + OFF_GT);
    *(__attribute__((address_space(3))) f32x2*)(GT + rg * 128 + 2 * d2) = (f32x2){c0, c1};
    *(__attribute__((address_space(3))) u32x4*)(lds + OFF_VV + (tid >> 4) * RS_T + (tid & 15) * 16) = va;
    *(__attribute__((address_space(3))) u32x4*)(lds + OFF_VV + ((tid >> 4) + 32) * RS_T + (tid & 15) * 16) = vb;
    __syncthreads();
    float p0 = 0.f, p1 = 0.f, m0 = 0.f, m1 = 0.f, t0 = 0.f, t1 = 0.f;
#pragma unroll
    for (int j = 0; j < 8; ++j) { const f32x2 t = *(__attribute__((address_space(3))) f32x2*)(GT + j * 128 + 2 * d2);
        if (j < rg) { p0 += t.x; p1 += t.y; } if (j < 4) { m0 += t.x; m1 += t.y; } t0 += t.x; t1 += t.y; }
    if (rg == 0) { *(__attribute__((address_space(3))) f32x2*)(lds + OFF_BM + d2 * 8) = (f32x2){m0, m1}; *(__attribute__((address_space(3))) f32x2*)(lds + OFF_BL + d2 * 8) = (f32x2){t0, t1}; }
    bs0 += t0; bs1 += t1;
#pragma unroll
    for (int i = 0; i < 8; ++i) {
        const int row = 8 * rg + i; const float b0 = p0 + cs[i].x, b1 = p1 + cs[i].y;
        const float k0 = 1.0f - __expf(g[i].x), k1 = 1.0f - __expf(g[i].y);
        *(__attribute__((address_space(3))) unsigned*)(lds + OFF_KH + row * RS_T + d2 * 4) = pk2(k0 * __expf(t0 - b0), k1 * __expf(t1 - b1));
        if (FULL) {
            const float q0 = __uint_as_float(qraw[i] << 16), q1 = __uint_as_float(qraw[i] & 0xffff0000u);
            *(__attribute__((address_space(3))) unsigned*)(lds + OFF_QT + row * RS_Q + d2 * 4) = pk2(q0 * __expf(b0 - m0), q1 * __expf(b1 - m1));
            *(__attribute__((address_space(3))) unsigned*)(lds + OFF_KT + row * RS_Q + d2 * 4) = pk2(k0 * __expf(m0 - b0), k1 * __expf(m1 - b1));
        }
    }
    __syncthreads();
}
__device__ __forceinline__ void state_update(lds_u8* lds, f32x16 (&S)[2], int w, int lane) {
    const int db = w >> 1, hi = lane >> 5;
    const __attribute__((address_space(3))) float* BL = (const __attribute__((address_space(3))) float*)(lds + OFF_BL);
#pragma unroll
    for (int g4 = 0; g4 < 4; ++g4) { const f32x4 bl = *(const __attribute__((address_space(3))) f32x4*)(BL + 32 * db + 8 * g4 + 4 * hi);
#pragma unroll
        for (int q = 0; q < 4; ++q) { const float f = __expf(bl[q]); S[0][4 * g4 + q] *= f; S[1][4 * g4 + q] *= f; } }
#pragma unroll
    for (int ks = 0; ks < 4; ++ks) {
        const bf16x8 a = tr_frag(lds + OFF_KH, RS_T, 16 * ks, 32 * db, lane);
        const bf16x8 b0 = tr_frag(lds + OFF_VV, RS_T, 16 * ks, 32 * (2 * (w & 1)), lane), b1 = tr_frag(lds + OFF_VV, RS_T, 16 * ks, 32 * (2 * (w & 1) + 1), lane);
        S[0] = MFMA32(a, b0, S[0]); S[1] = MFMA32(a, b1, S[1]);
    }
}
__device__ __forceinline__ float* us_ptr(const Params& P, int sc, int h, int w, int j, int lane) {
    return (float*)(P.ws + WS_US) + ((size_t)(sc * NH + h) * HD + 32 * (w >> 1)) * HD + 32 * (2 * (w & 1) + j) + (lane & 31);
}
__device__ __forceinline__ void local_item(const Params& P, int sc, int h, lds_u8* lds) {
    const int tid = opaque_tid(), w = __builtin_amdgcn_readfirstlane(tid >> 6), lane = tid & 63, hi = lane >> 5;
    f32x16 S[2] = {}; float bs0 = 0.f, bs1 = 0.f;
    for (int c = 0; c < 4; ++c) {
        chunk_prep<false>(P, h, sc * 256 + c * 64, lds, bs0, bs1);
        state_update(lds, S, w, lane);
        __syncthreads();
    }
#pragma unroll
    for (int j = 0; j < 2; ++j) { float* up = us_ptr(P, sc, h, w, j, lane);
#pragma unroll
        for (int r = 0; r < 16; ++r) up[(size_t)crow(r, hi) * HD] = S[j][r]; }
    if (tid < 64) *(f32x2*)((float*)(P.ws + WS_BS) + (size_t)(sc * NH + h) * HD + 2 * tid) = (f32x2){bs0, bs1};
}
__device__ __forceinline__ void local_phase(const Params& P, int vcu, int nblk, lds_u8* lds) { for (int it = vcu; it < 256; it += nblk) local_item(P, it >> 2, it & 3, lds); }
__device__ __forceinline__ void scan_phase(const Params& P, int bid, int nblk) {
    const int tid = opaque_tid(); if (tid >= 256) return;
    float* US = (float*)(P.ws + WS_US); const float* BS = (const float*)(P.ws + WS_BS);
    for (int i = bid * 256 + tid; i < NH * HD * HD; i += nblk * 256) {
        const int hd = i >> 7; float s = 0.f;
        for (int sc0 = 0; sc0 < 64; sc0 += 8) {
            float u[8], a[8];
#pragma unroll
            for (int k = 0; k < 8; ++k) { u[k] = US[(size_t)(sc0 + k) * (NH * HD * HD) + i]; a[k] = BS[(size_t)(sc0 + k) * (NH * HD) + hd]; }
#pragma unroll
            for (int k = 0; k < 8; ++k) { US[(size_t)(sc0 + k) * (NH * HD * HD) + i] = s; s = __expf(a[k]) * s + u[k]; }
        }
    }
}
__device__ __forceinline__ void out_item(const Params& P, int sc, int h, lds_u8* lds) {
    const int tid = opaque_tid(), w = __builtin_amdgcn_readfirstlane(tid >> 6), lane = tid & 63, r32 = lane & 31, hi = lane >> 5;
    f32x16 S[2]; float bs0 = 0.f, bs1 = 0.f;
#pragma unroll
    for (int j = 0; j < 2; ++j) { const float* up = us_ptr(P, sc, h, w, j, lane);
#pragma unroll
        for (int r = 0; r < 16; ++r) S[j][r] = up[(size_t)crow(r, hi) * HD]; }
    const int tb = w >> 2, eb = w & 3, db = w >> 1;
    for (int c = 0; c < 4; ++c) {
        const int tc = sc * 256 + c * 64;
        chunk_prep<true>(P, h, tc, lds, bs0, bs1);
        { const __attribute__((address_space(3))) float* BM = (const __attribute__((address_space(3))) float*)(lds + OFF_BM);
#pragma unroll
          for (int g4 = 0; g4 < 4; ++g4) { const int d0 = 32 * db + 8 * g4 + 4 * hi; const f32x4 bm = *(const __attribute__((address_space(3))) f32x4*)(BM + d0);
              const float f0 = __expf(bm[0]), f1 = __expf(bm[1]), f2 = __expf(bm[2]), f3 = __expf(bm[3]);
#pragma unroll
              for (int j = 0; j < 2; ++j) { const int e = 32 * (2 * (w & 1) + j) + r32;
                  *(__attribute__((address_space(3))) u32x2*)(lds + OFF_ST + e * RS_Q + d0 * 2) = (u32x2){pk2(S[j][4 * g4] * f0, S[j][4 * g4 + 1] * f1), pk2(S[j][4 * g4 + 2] * f2, S[j][4 * g4 + 3] * f3)}; } } }
        if (w < 3) {
            const int sb = (w == 2) ? 1 : 0, tb2 = (w >= 1) ? 1 : 0; f32x16 acc = {};
#pragma unroll
            for (int ks = 0; ks < 8; ++ks) { const bf16x8 a = ld128(lds + OFF_KT + (32 * sb + r32) * RS_Q + (16 * ks + 8 * hi) * 2), b = ld128(lds + OFF_QT + (32 * tb2 + r32) * RS_Q + (16 * ks + 8 * hi) * 2);
                acc = MFMA32(a, b, acc); }
            const int t = 32 * tb2 + r32;
#pragma unroll
            for (int g4 = 0; g4 < 4; ++g4) { const int s0 = 32 * sb + 8 * g4 + 4 * hi; float v[4];
#pragma unroll
                for (int q = 0; q < 4; ++q) v[q] = (s0 + q <= t) ? acc[4 * g4 + q] : 0.f;
                *(__attribute__((address_space(3))) u32x2*)(lds + OFF_PP + t * RS_P + s0 * 2) = (u32x2){pk2(v[0], v[1]), pk2(v[2], v[3])}; }
        }
        __syncthreads();
        f32x16 o = {};
#pragma unroll
        for (int ks = 0; ks < 8; ++ks) { const bf16x8 a = ld128(lds + OFF_QT + (32 * tb + r32) * RS_Q + (16 * ks + 8 * hi) * 2), b = ld128(lds + OFF_ST + (32 * eb + r32) * RS_Q + (16 * ks + 8 * hi) * 2);
            o = MFMA32(a, b, o); }
#pragma unroll
        for (int ks = 0; ks < 4; ++ks) if (ks < 2 * (tb + 1)) { const bf16x8 a = ld128(lds + OFF_PP + (32 * tb + r32) * RS_P + (16 * ks + 8 * hi) * 2), b = tr_frag(lds + OFF_VV, RS_T, 16 * ks, 32 * eb, lane);
            o = MFMA32(a, b, o); }
        state_update(lds, S, w, lane);
        __syncthreads();
        { __attribute__((address_space(3))) float* OO = (__attribute__((address_space(3))) float*)(lds + OFF_OO);
#pragma unroll
          for (int r = 0; r < 16; ++r) OO[(32 * tb + crow(r, hi)) * (RS_O / 4) + 32 * eb + r32] = o[r]; }
        __syncthreads();
        { const int t = tid >> 3, e0 = (tid & 7) * 16; const __attribute__((address_space(3))) f32x4* orow = (const __attribute__((address_space(3))) f32x4*)(lds + OFF_OO + t * RS_O + e0 * 4);
          f32x4 v[4]; float ss = 0.f;
#pragma unroll
          for (int k = 0; k < 4; ++k) { v[k] = orow[k]; ss += (v[k].x * v[k].x + v[k].y * v[k].y) + (v[k].z * v[k].z + v[k].w * v[k].w); }
          ss += __shfl_xor(ss, 1); ss += __shfl_xor(ss, 2); ss += __shfl_xor(ss, 4);
          const float rs = 1.0f / sqrtf(ss * (1.0f / HD) + NORM_EPS);
          const bf16_t* hgp = (const bf16_t*)(P.ws + WS_HG) + (size_t)(tc + t) * DH + h * HD + e0; const u32x4 ga = *(const u32x4*)hgp, gb = *(const u32x4*)(hgp + 8);
          const f32x4* nw = (const f32x4*)(P.hgrn_norm_w + e0); float y[16];
#pragma unroll
          for (int k = 0; k < 4; ++k) { const f32x4 n4 = nw[k]; const unsigned g01 = (k < 2) ? ga[2 * k] : gb[2 * (k - 2)], g23 = (k < 2) ? ga[2 * k + 1] : gb[2 * (k - 2) + 1];
              y[4 * k] = v[k].x * rs * n4.x * __uint_as_float(g01 << 16); y[4 * k + 1] = v[k].y * rs * n4.y * __uint_as_float(g01 & 0xffff0000u);
              y[4 * k + 2] = v[k].z * rs * n4.z * __uint_as_float(g23 << 16); y[4 * k + 3] = v[k].w * rs * n4.w * __uint_as_float(g23 & 0xffff0000u); }
          bf16_t* mp = (bf16_t*)(P.ws + WS_MIX) + (size_t)(tc + t) * DM + h * HD + e0;
          *(u32x4*)mp = (u32x4){pk2(y[0], y[1]), pk2(y[2], y[3]), pk2(y[4], y[5]), pk2(y[6], y[7])};
          *(u32x4*)(mp + 8) = (u32x4){pk2(y[8], y[9]), pk2(y[10], y[11]), pk2(y[12], y[13]), pk2(y[14], y[15])}; }
        __syncthreads();
    }
}
__device__ __forceinline__ void out_phase(const Params& P, int vcu, int nblk, lds_u8* lds) { for (int it = vcu; it < 256; it += nblk) out_item(P, it >> 2, it & 3, lds); }
#undef MFMA32
}


#define LAS __attribute__((address_space(3)))
#define XB_TMO      128
#define XB_XCNT(j)  (256  + 64 * (j))
#define XB_XSUB(j)  (1280 + 64 * (j))
#define XB_XGEN(j)  (2304 + 64 * (j))
#define XB_TOP      3328
#define XB_TOPGEN   3392
#define XCD_BAR_WORDS 3456
#define XB_SPIN_CAP (1u << 18)
__device__ __forceinline__ unsigned xb_ld(unsigned* p)              { return __hip_atomic_load(p, __ATOMIC_RELAXED, __HIP_MEMORY_SCOPE_AGENT); }
__device__ __forceinline__ unsigned xb_add(unsigned* p, unsigned v) { return __hip_atomic_fetch_add(p, v, __ATOMIC_RELAXED, __HIP_MEMORY_SCOPE_AGENT); }
__device__ __forceinline__ unsigned xb_xcc_id() { return (unsigned)__builtin_amdgcn_s_getreg((3 << 11) | 20) & 0xFu; }
#define XB_SPIN(cond, bar) do { unsigned _sp = 0; while (cond) { __builtin_amdgcn_s_sleep(1); \
    if ((++_sp & 255u) == 0u) { if (xb_ld(&(bar)[XB_TMO])) break; if (_sp > XB_SPIN_CAP) { atomicAdd(&(bar)[XB_TMO], 1u); break; } } } } while (0)
struct XcdBarrier { unsigned* bar; unsigned x; volatile LAS unsigned* st; };
__device__ __forceinline__ XcdBarrier xcd_barrier_post(unsigned* bar, volatile LAS unsigned* st) {
    XcdBarrier b; b.bar = bar; b.x = xb_xcc_id(); b.st = st;
    if (threadIdx.x == 0) (void)xb_add(&bar[XB_XCNT(b.x)], 1u);
    return b;
}
__device__ __forceinline__ void xcd_barrier_complete(unsigned* bar, unsigned x, unsigned& nloc, unsigned& nx) {
    const unsigned G = gridDim.x * gridDim.y * gridDim.z;
    unsigned sum, cnt, mine, sp = 0u;
    for (;;) {
        sum = 0u; cnt = 0u; mine = 0u;
#pragma unroll
        for (unsigned j = 0; j < 16; ++j) { const unsigned c = xb_ld(&bar[XB_XCNT(j)]); sum += c; cnt += (c > 0u) ? 1u : 0u; mine = (j == x) ? c : mine; }
        if (sum == G) break;
        __builtin_amdgcn_s_sleep(1);
        if ((++sp & 255u) == 0u) { if (xb_ld(&bar[XB_TMO])) break; if (sp > XB_SPIN_CAP) { atomicAdd(&bar[XB_TMO], 1u); break; } }
    }
    nloc = mine > 0u ? mine : 1u; nx = cnt > 0u ? cnt : 1u;
}
__device__ __forceinline__ void xcd_barrier(const XcdBarrier& b) {
    asm volatile("s_waitcnt vmcnt(0)" ::: "memory");
    __syncthreads();
    if (threadIdx.x == 0) {
        unsigned* bar = b.bar;
        __builtin_amdgcn_s_waitcnt(0);
        unsigned nloc = b.st[0], nx = b.st[1];
        if (nloc == 0u) { xcd_barrier_complete(bar, b.x, nloc, nx); b.st[0] = nloc; b.st[1] = nx; }
        const unsigned old = xb_add(&bar[XB_XSUB(b.x)], 1u);
        const unsigned gen = old / nloc;
        if (old + 1u == (gen + 1u) * nloc) {
            __builtin_amdgcn_fence(__ATOMIC_RELEASE, "agent");
            asm volatile("s_waitcnt vmcnt(0)" ::: "memory");
            const unsigned og = xb_add(&bar[XB_TOP], 1u);
            const unsigned tg = og / nx;
            if (og + 1u == (tg + 1u) * nx) xb_add(&bar[XB_TOPGEN], 1u);
            else XB_SPIN(xb_ld(&bar[XB_TOPGEN]) == tg, bar);
            __builtin_amdgcn_fence(__ATOMIC_ACQUIRE, "agent");
            xb_add(&bar[XB_XGEN(b.x)], 1u);
            asm volatile("s_waitcnt vmcnt(0)" ::: "memory");
        } else {
            XB_SPIN(xb_ld(&bar[XB_XGEN(b.x)]) == gen, bar);
            __builtin_amdgcn_fence(__ATOMIC_ACQUIRE, "agent");
            asm volatile("s_waitcnt vmcnt(0)" ::: "memory");
        }
    }
    __syncthreads();
}
constexpr int CW_BAR = 131072;
constexpr int MISC_OFF = 147456 - 64;
constexpr int NWAVES = 8;
constexpr int LDS_BYTES = 147456;
constexpr int N_PHASES = 7;
struct Args { Params P; int ph_lo, ph_hi, flags, pad; };

__device__ __forceinline__ void final_norm_phase(const Params& P, int bid, int nblk) {
    const int lane = threadIdx.x & 63, wave = threadIdx.x >> 6, gw = bid * NWAVES + wave, ngw = nblk * NWAVES;
    const float* rowsq = (const float*)(P.ws + WS_CTL) + CT_ROWSQ;
    for (int m = gw; m < T; m += ngw) {
        f32x4* yr = (f32x4*)(P.out + (size_t)m * DM) + lane; const f32x4* wr = (const f32x4*)P.final_norm_w + lane;
        const float rstd = 1.0f / sqrtf(rowsq[m] * (1.0f / DM) + NORM_EPS);
#pragma unroll
        for (int j = 0; j < 4; ++j) { const f32x4 v = yr[64 * j], w = wr[64 * j]; yr[64 * j] = (f32x4){v.x * rstd * w.x, v.y * rstd * w.y, v.z * rstd * w.z, v.w * rstd * w.w}; }
    }
}

__global__ void __launch_bounds__(NWAVES * 64, 2) mk_fwd(Args a) {
    extern __shared__ __attribute__((aligned(16))) unsigned char lds[];
    const Params& P = a.P;
    const int G = gridDim.x, bx = blockIdx.x;
    const int vcu = (G % 8 == 0) ? (bx % 8) * (G / 8) + bx / 8 : bx;
    const int lo = a.ph_lo, hi = a.ph_hi;
#define IN(k) (lo <= (k) && (k) < hi)
#define SEAM(k) do { if (IN(k) && IN((k) + 1)) xcd_barrier(bar); } while (0)
    if (threadIdx.x < 16) ((LAS unsigned*)((LAS unsigned char*)lds + MISC_OFF))[threadIdx.x] = 0u;
    __syncthreads();
    const XcdBarrier bar = xcd_barrier_post((unsigned*)(P.ws + WS_CTL) + CW_BAR, (volatile LAS unsigned*)((LAS unsigned char*)lds + MISC_OFF));
    if (IN(0)) {
        prologue_phase(P, bx, G, (float*)lds);
        float* rowsq = (float*)(P.ws + WS_CTL) + CT_ROWSQ;
        for (int i = bx * (NWAVES * 64) + threadIdx.x; i < T; i += G * NWAVES * 64) rowsq[i] = 0.f;
    }
    SEAM(0);
    if (IN(1)) {
        pg8::Gemm g{(const bf16_t*)(P.ws + WS_XN), (const bf16_t*)(P.ws + WS_WIN), T, DIN, DM}; pg8::StaticOrder S; S.init(T, DIN, G, bx);
        EpiIn E{P};
        pg8::gemm_phase<EpiIn, pg8::StaticOrder, true, true>((PG8_LAS unsigned char*)lds, g, S, E);
    }
    SEAM(1);
    if (IN(2)) hg::local_phase(P, vcu, G, (hg::lds_u8*)lds);
    SEAM(2);
    if (IN(3)) hg::scan_phase(P, bx, G);
    SEAM(3);
    if (IN(4)) { att::attn_phase(P, vcu, G, (char*)lds); hg::out_phase(P, vcu, G, (hg::lds_u8*)lds); }
    SEAM(4);
    if (IN(5)) {
        pg8::Gemm g{(const bf16_t*)(P.ws + WS_MIX), (const bf16_t*)(P.ws + WS_WOUT), T, DM, DM}; pg8::StaticOrder S; S.init(T, DM, G, bx);
        EpiOut E{P};
        pg8::gemm_phase<EpiOut, pg8::StaticOrder, false, true>((PG8_LAS unsigned char*)lds, g, S, E);
    }
    SEAM(5);
    if (IN(6)) final_norm_phase(P, bx, G);
#undef IN
#undef SEAM
}

static int g_grid = 0;
static void launch_phases(const Params& P, int lo, int hi, hipStream_t stream) {
    Args a{}; a.P = P; a.ph_lo = lo; a.ph_hi = hi; a.flags = 0; a.pad = 0;
    if (hipMemsetAsync(P.ws + WS_CTL + (size_t)CW_BAR * 4, 0, XCD_BAR_WORDS * 4, stream) != hipSuccess) { fprintf(stderr, "kernel_launch: memset of the barrier words failed\n"); return; }
    hipLaunchKernelGGL(mk_fwd, dim3(g_grid), dim3(NWAVES * 64), LDS_BYTES, stream, a);
    const hipError_t e = hipPeekAtLastError();
    if (e != hipSuccess) fprintf(stderr, "kernel_launch: launch [%d,%d) failed: %s (grid %d)\n", lo, hi, hipGetErrorString(e), g_grid);
}

extern "C" void kernel_launch(void* const* d_in, const int* in_sizes, int n_in, void* d_out, int out_size, void* d_ws, size_t ws_size, hipStream_t stream) {
    if (n_in != 12 || in_sizes[0] != T * DM || out_size != T * DM || ws_size < 256 * MiB) { fprintf(stderr, "kernel_launch: unexpected shapes (n_in %d in0 %d out %d ws %zu)\n", n_in, n_in > 0 ? in_sizes[0] : -1, out_size, ws_size); return; }
    if (g_grid == 0) {
        int dev = 0, cus = 0, per_cu = 0;
        if (hipGetDevice(&dev) != hipSuccess || hipDeviceGetAttribute(&cus, hipDeviceAttributeMultiprocessorCount, dev) != hipSuccess) { fprintf(stderr, "kernel_launch: device query failed\n"); g_grid = -1; return; }
        if (hipFuncSetAttribute((const void*)mk_fwd, hipFuncAttributeMaxDynamicSharedMemorySize, LDS_BYTES) != hipSuccess) { fprintf(stderr, "kernel_launch: hipFuncSetAttribute failed\n"); g_grid = -1; return; }
        if (hipOccupancyMaxActiveBlocksPerMultiprocessor(&per_cu, (const void*)mk_fwd, NWAVES * 64, LDS_BYTES) != hipSuccess || per_cu < 1) { fprintf(stderr, "kernel_launch: occupancy query says %d blocks per CU\n", per_cu); per_cu = 1; }
        (void)hipGetLastError();
        g_grid = cus * (per_cu < 1 ? 1 : 1);
    }
    if (g_grid < 0) return;
    Params P{};
    P.x = (const float*)d_in[0]; P.norm_w = (const float*)d_in[1]; P.w_in = (const float*)d_in[2]; P.lb_logits = (const float*)d_in[3]; P.hgrn_norm_w = (const float*)d_in[4];
    P.lq1 = (const float*)d_in[5]; P.lk1 = (const float*)d_in[6]; P.lq2 = (const float*)d_in[7]; P.lk2 = (const float*)d_in[8]; P.diff_norm_w = (const float*)d_in[9];
    P.w_out = (const float*)d_in[10]; P.final_norm_w = (const float*)d_in[11]; P.out = (float*)d_out; P.ws = (unsigned char*)d_ws;
    launch_phases(P, 0, N_PHASES, stream);
}
```

```cpp
#include <hip/hip_runtime.h>
#include <cstdio>
#include <cstdint>

typedef unsigned short bf16_t;
typedef float f32x4 __attribute__((ext_vector_type(4)));
typedef float f32x2 __attribute__((ext_vector_type(2)));
typedef unsigned u32x4 __attribute__((ext_vector_type(4)));
typedef unsigned u32x2 __attribute__((ext_vector_type(2)));
typedef __bf16 bf16x2_t __attribute__((ext_vector_type(2)));

constexpr int T = 16384, DM = 1024, DIN = 4096, DH = 512;
constexpr int NH = 4, HD = 128;
constexpr float NORM_EPS = 1e-6f, SUBLN_EPS = 1e-5f;
constexpr float LAMBDA_INIT = 0.2f;
constexpr float QSCALE = 0.125f * 1.4426950408889634f;

constexpr size_t MiB = 1u << 20;
constexpr size_t WS_CTL = 0;
constexpr size_t WS_COS = 1 * MiB, WS_SIN = 3 * MiB;
constexpr size_t WS_WOUT = 5 * MiB;
constexpr size_t WS_WIN = 8 * MiB;
constexpr size_t WS_XN = 16 * MiB;
constexpr size_t WS_MIX = 16 * MiB;
constexpr size_t WS_HQ = 48 * MiB;
constexpr size_t WS_G = 64 * MiB;
constexpr size_t WS_HI = 96 * MiB;
constexpr size_t WS_HG = 112 * MiB;
constexpr size_t WS_DQ = 128 * MiB;
constexpr size_t WS_DK = 144 * MiB;
constexpr size_t WS_DV = 160 * MiB;
constexpr size_t WS_DG = 176 * MiB;
constexpr size_t WS_US = 192 * MiB;
constexpr size_t WS_BS = 208 * MiB;
constexpr size_t WS_OTMP = 210 * MiB;
constexpr int CT_LAM = 16;
constexpr int CT_LB = 1024;
constexpr int CT_ROWSQ = 16384;

struct Params {
    const float* x; const float* norm_w; const float* w_in; const float* lb_logits; const float* hgrn_norm_w;
    const float* lq1; const float* lk1; const float* lq2; const float* lk2; const float* diff_norm_w; const float* w_out; const float* final_norm_w;
    float* out; unsigned char* ws;
};

__device__ __forceinline__ float bf2f(bf16_t h) { return __uint_as_float((unsigned)h << 16); }
__device__ __forceinline__ unsigned pk2(float lo, float hi) { f32x2 v = {lo, hi}; bf16x2_t b = __builtin_convertvector(v, bf16x2_t); return __builtin_bit_cast(unsigned, b); }
__device__ __forceinline__ bf16_t f2bf(float f) { return (bf16_t)(pk2(f, 0.f) & 0xffffu); }
__device__ __forceinline__ float wave_sum(float v) {
#pragma unroll
    for (int o = 1; o < 64; o <<= 1) v += __shfl_xor(v, o);
    return v;
}
__device__ __forceinline__ int opaque_tid() { int t = threadIdx.x; asm volatile("" : "+v"(t)); return t; }
__device__ __forceinline__ float sigmoidf_(float v) { return 1.0f / (1.0f + __expf(-v)); }
__device__ __forceinline__ float siluf_(float v) { return v / (1.0f + __expf(-v)); }

__host__ __device__ __forceinline__ int win_orig_col(int np) {
    if (np < 2048 || np >= 3072) return np;
    const int base = np & ~63, p = np & 63;
    return base + (p >> 1) + 32 * (p & 1);
}

__device__ __forceinline__ void epi8(const Params& P, int type, int t, int c, const float* v) {
    unsigned char* ws = P.ws;
    const size_t off = (size_t)t * DH + c;
    if (type == 1) {
        const float* lb = (const float*)(ws + WS_CTL) + CT_LB + c;
        float g[8];
#pragma unroll
        for (int j = 0; j < 8; ++j) { const float l = lb[j]; const float f = l + (1.0f - l) * sigmoidf_(v[j]); g[j] = __logf(f); }
        float* G = (float*)(ws + WS_G) + off;
        *(f32x4*)G = (f32x4){g[0], g[1], g[2], g[3]}; *(f32x4*)(G + 4) = (f32x4){g[4], g[5], g[6], g[7]};
        return;
    }
    float o[8];
    size_t base;
    if (type == 3 || type == 7) {
#pragma unroll
        for (int j = 0; j < 8; ++j) o[j] = siluf_(v[j]);
        base = (type == 3) ? WS_HG : WS_DG;
    } else if (type == 4 || type == 5) {
        const int i0 = (c & 63) >> 1;
        const f32x4 cs = *(const f32x4*)((const float*)(ws + WS_COS) + (size_t)t * 32 + i0);
        const f32x4 sn = *(const f32x4*)((const float*)(ws + WS_SIN) + (size_t)t * 32 + i0);
        const float sc = (type == 4) ? QSCALE : 1.0f;
#pragma unroll
        for (int j = 0; j < 4; ++j) { const float x1 = v[2 * j], x2 = v[2 * j + 1];
            o[2 * j] = (x1 * cs[j] - x2 * sn[j]) * sc; o[2 * j + 1] = (x2 * cs[j] + x1 * sn[j]) * sc; }
        base = (type == 4) ? WS_DQ : WS_DK;
    } else {
#pragma unroll
        for (int j = 0; j < 8; ++j) o[j] = v[j];
        base = (type == 0) ? WS_HQ : (type == 2) ? WS_HI : WS_DV;
    }
    u32x4 w = {pk2(o[0], o[1]), pk2(o[2], o[3]), pk2(o[4], o[5]), pk2(o[6], o[7])};
    *(u32x4*)((bf16_t*)(ws + base) + off) = w;
}

__device__ __forceinline__ void prologue_phase(const Params& P, int bid, int nblk, float* scr  ) {
    const int tid = threadIdx.x, lane = tid & 63, wave = tid >> 6, nwv = blockDim.x >> 6;
    const int gw = bid * nwv + wave, NGW = nblk * nwv;
    unsigned char* ws = P.ws;
    if (bid == 0 && wave == 0) {
        float a = P.lq1[lane] * P.lk1[lane], b = P.lq2[lane] * P.lk2[lane];
        a = wave_sum(a); b = wave_sum(b);
        if (lane == 0) ((float*)(ws + WS_CTL))[CT_LAM] = __expf(a) - __expf(b) + LAMBDA_INIT;
    }
    if (bid == 0) {
        for (int c = tid; c < DH; c += blockDim.x) { const float l0 = P.lb_logits[c], l1 = P.lb_logits[DH + c]; ((float*)(ws + WS_CTL))[CT_LB + c] = 1.0f / (1.0f + __expf(l1 - l0)); }
    }
    for (int idx = bid * blockDim.x + tid; idx < T * 32; idx += nblk * blockDim.x) {
        const int t = idx >> 5, i = idx & 31;
        const float invf = 1.0f / exp2f((float)i * (13.287712379549449f / 32.0f));
        const float ang = (float)t * invf;
        const double rev = (double)ang * 0.15915494309189535;
        const float fr = (float)(rev - __builtin_rint(rev));
        ((float*)(ws + WS_COS))[idx] = __builtin_amdgcn_cosf(fr);
        ((float*)(ws + WS_SIN))[idx] = __builtin_amdgcn_sinf(fr);
    }
    float* s = scr + wave * (64 * 33);
    constexpr int I_IN = (DM / 64) * (DIN / 32), I_OUT = (DM / 64) * (DM / 32);
    for (int it = gw; it < I_IN + I_OUT; it += NGW) {
        const bool isin = it < I_IN; const int r = isin ? it : it - I_IN;
        const float* W = isin ? P.w_in : P.w_out; const int N = isin ? DIN : DM;
        bf16_t* WT = (bf16_t*)(ws + (isin ? WS_WIN : WS_WOUT));
        const int nblkn = N / 32, kb = r / nblkn, nb = r % nblkn, k0 = 64 * kb, n0 = 32 * nb;
        const int ncol = isin ? win_orig_col(n0 + (lane & 31)) : n0 + (lane & 31);
#pragma unroll 8
        for (int i = 0; i < 32; ++i) { const int kk = 2 * i + (lane >> 5); s[kk * 33 + (lane & 31)] = W[(size_t)(k0 + kk) * N + ncol]; }
        __builtin_amdgcn_wave_barrier(); asm volatile("s_waitcnt lgkmcnt(0)" ::: "memory");
        const int c = lane & 7;
#pragma unroll
        for (int j = 0; j < 4; ++j) { const int n = (lane >> 3) + 8 * j; const float* q = s + (8 * c) * 33 + n;
            u32x4 o; o.x = pk2(q[0 * 33], q[1 * 33]); o.y = pk2(q[2 * 33], q[3 * 33]); o.z = pk2(q[4 * 33], q[5 * 33]); o.w = pk2(q[6 * 33], q[7 * 33]);
            *(u32x4*)(WT + (size_t)(n0 + n) * DM + k0 + 8 * c) = o; }
        __builtin_amdgcn_wave_barrier(); asm volatile("s_waitcnt lgkmcnt(0)" ::: "memory");
    }
    for (int m = gw; m < T; m += NGW) {
        const f32x4* xr = (const f32x4*)(P.x + (size_t)m * DM) + lane; const f32x4* wr = (const f32x4*)P.norm_w + lane;
        f32x4 v[4]; float ss = 0.f;
#pragma unroll
        for (int j = 0; j < 4; ++j) { v[j] = xr[64 * j]; ss += (v[j].x * v[j].x + v[j].y * v[j].y) + (v[j].z * v[j].z + v[j].w * v[j].w); }
        const float rstd = 1.0f / sqrtf(wave_sum(ss) * (1.0f / DM) + NORM_EPS);
        u32x2* o8 = (u32x2*)((bf16_t*)(ws + WS_XN) + (size_t)m * DM) + lane;
#pragma unroll
        for (int j = 0; j < 4; ++j) { const f32x4 w = wr[64 * j]; u32x2 o; o.x = pk2(v[j].x * rstd * w.x, v[j].y * rstd * w.y); o.y = pk2(v[j].z * rstd * w.z, v[j].w * rstd * w.w); o8[64 * j] = o; }
    }
}

__global__ void __launch_bounds__(512) k_prologue(Params P) {
    __shared__ float scr[8 * 64 * 33];
    prologue_phase(P, blockIdx.x, gridDim.x, scr);
}

__global__ void __launch_bounds__(256) k_naive_gemm_in(Params P) {
    __shared__ float As[64][33], Bs[64][33];
    const bf16_t* A = (const bf16_t*)(P.ws + WS_XN); const bf16_t* B = (const bf16_t*)(P.ws + WS_WIN);
    const int tid = threadIdx.x, ty = tid >> 3, tx = tid & 7, m0 = blockIdx.y * 64, n0 = blockIdx.x * 64;
    float acc[2][8] = {};
    const int lr = tid >> 2, lk = (tid & 3) * 8;
    for (int k0 = 0; k0 < DM; k0 += 32) {
        const u32x4 a = *(const u32x4*)(A + (size_t)(m0 + lr) * DM + k0 + lk), b = *(const u32x4*)(B + (size_t)(n0 + lr) * DM + k0 + lk);
#pragma unroll
        for (int j = 0; j < 4; ++j) { As[lr][lk + 2 * j] = __uint_as_float(a[j] << 16); As[lr][lk + 2 * j + 1] = __uint_as_float(a[j] & 0xffff0000u);
            Bs[lr][lk + 2 * j] = __uint_as_float(b[j] << 16); Bs[lr][lk + 2 * j + 1] = __uint_as_float(b[j] & 0xffff0000u); }
        __syncthreads();
#pragma unroll 8
        for (int k = 0; k < 32; ++k) { const float a0 = As[2 * ty][k], a1 = As[2 * ty + 1][k];
#pragma unroll
            for (int j = 0; j < 8; ++j) { const float bv = Bs[8 * tx + j][k]; acc[0][j] += a0 * bv; acc[1][j] += a1 * bv; } }
        __syncthreads();
    }
    const int nc = n0 + 8 * tx, type = nc >> 9, c = nc & 511;
    epi8(P, type, m0 + 2 * ty, c, acc[0]); epi8(P, type, m0 + 2 * ty + 1, c, acc[1]);
}

__global__ void __launch_bounds__(128) k_naive_hgrn(Params P) {
    __shared__ float qs[32][128], fs[32][128];
    const int h = blockIdx.x, e = threadIdx.x;
    const bf16_t* HQ = (const bf16_t*)(P.ws + WS_HQ); const float* G = (const float*)(P.ws + WS_G); const bf16_t* HI = (const bf16_t*)(P.ws + WS_HI);
    float* OT = (float*)(P.ws + WS_OTMP);
    float S[128];
#pragma unroll
    for (int d = 0; d < 128; ++d) S[d] = 0.f;
    for (int t0 = 0; t0 < T; t0 += 32) {
        for (int i = 0; i < 32; ++i) { qs[i][e] = bf2f(HQ[(size_t)(t0 + i) * DH + h * HD + e]); fs[i][e] = __expf(G[(size_t)(t0 + i) * DH + h * HD + e]); }
        __syncthreads();
        for (int i = 0; i < 32; ++i) {
            const float v = bf2f(HI[(size_t)(t0 + i) * DH + h * HD + e]); float o = 0.f;
#pragma unroll
            for (int d = 0; d < 128; ++d) { const float f = fs[i][d]; S[d] = f * S[d] + (1.0f - f) * v; o += qs[i][d] * S[d]; }
            OT[(size_t)(t0 + i) * DH + h * HD + e] = o;
        }
        __syncthreads();
    }
}
__global__ void __launch_bounds__(256) k_naive_hgrn_norm(Params P) {
    const int lane = threadIdx.x & 63, gw = (blockIdx.x * blockDim.x + threadIdx.x) >> 6, ngw = (gridDim.x * blockDim.x) >> 6;
    const float* OT = (const float*)(P.ws + WS_OTMP); const bf16_t* HG = (const bf16_t*)(P.ws + WS_HG); bf16_t* MIX = (bf16_t*)(P.ws + WS_MIX);
    for (int r = gw; r < T * NH; r += ngw) {
        const int t = r >> 2, h = r & 3; const size_t off = (size_t)t * DH + h * HD + 2 * lane;
        const float a = OT[off], b = OT[off + 1];
        const float rs = 1.0f / sqrtf(wave_sum(a * a + b * b) * (1.0f / HD) + NORM_EPS);
        const float y0 = a * rs * P.hgrn_norm_w[2 * lane] * bf2f(HG[off]), y1 = b * rs * P.hgrn_norm_w[2 * lane + 1] * bf2f(HG[off + 1]);
        *(unsigned*)(MIX + (size_t)t * DM + h * HD + 2 * lane) = pk2(y0, y1);
    }
}

__global__ void __launch_bounds__(256) k_naive_attn(Params P) {
    __shared__ float Kt[32][128], Vt[32][128];
    const int tid = threadIdx.x, tl = tid >> 2, vq = tid & 3, h = blockIdx.y, t0 = (gridDim.x - 1 - blockIdx.x) * 64, t = t0 + tl;
    const bf16_t* DQ = (const bf16_t*)(P.ws + WS_DQ); const bf16_t* DK = (const bf16_t*)(P.ws + WS_DK); const bf16_t* DV = (const bf16_t*)(P.ws + WS_DV);
    const bf16_t* DG = (const bf16_t*)(P.ws + WS_DG); bf16_t* MIX = (bf16_t*)(P.ws + WS_MIX);
    const float lam = ((const float*)(P.ws + WS_CTL))[CT_LAM];
    float q1[64], q2[64], o1[32], o2[32];
#pragma unroll
    for (int d = 0; d < 64; ++d) { q1[d] = bf2f(DQ[(size_t)t * DH + h * HD + d]); q2[d] = bf2f(DQ[(size_t)t * DH + h * HD + 64 + d]); }
#pragma unroll
    for (int j = 0; j < 32; ++j) { o1[j] = 0.f; o2[j] = 0.f; }
    float m1 = -1e30f, m2 = -1e30f, l1 = 0.f, l2 = 0.f;
    const int nt = (t0 + 64) / 32;
    for (int kt = 0; kt < nt; ++kt) {
        const int s0 = kt * 32;
        for (int i = tid; i < 32 * 128; i += 256) { const int r = i >> 7, c = i & 127; Kt[r][c] = bf2f(DK[(size_t)(s0 + r) * DH + h * HD + c]); Vt[r][c] = bf2f(DV[(size_t)(s0 + r) * DH + h * HD + c]); }
        __syncthreads();
        for (int s = 0; s < 32; ++s) {
            if (s0 + s <= t) {
                float a = 0.f, b = 0.f;
#pragma unroll
                for (int d = 0; d < 64; ++d) { a += q1[d] * Kt[s][d]; b += q2[d] * Kt[s][64 + d]; }
                { const float mn = fmaxf(m1, a), al = exp2f(m1 - mn), p = exp2f(a - mn); l1 = l1 * al + p; m1 = mn;
#pragma unroll
                  for (int j = 0; j < 32; ++j) o1[j] = o1[j] * al + p * Vt[s][vq * 32 + j]; }
                { const float mn = fmaxf(m2, b), al = exp2f(m2 - mn), p = exp2f(b - mn); l2 = l2 * al + p; m2 = mn;
#pragma unroll
                  for (int j = 0; j < 32; ++j) o2[j] = o2[j] * al + p * Vt[s][vq * 32 + j]; }
            }
        }
        __syncthreads();
    }
    const float i1 = 1.0f / l1, i2 = lam / l2; float ss = 0.f;
#pragma unroll
    for (int j = 0; j < 32; ++j) { o1[j] = o1[j] * i1 - o2[j] * i2; ss += o1[j] * o1[j]; }
    ss += __shfl_xor(ss, 1); ss += __shfl_xor(ss, 2);
    const float rs = (1.0f - LAMBDA_INIT) / sqrtf(ss * (1.0f / HD) + SUBLN_EPS);
#pragma unroll
    for (int j = 0; j < 32; j += 2) {
        const int c = vq * 32 + j;
        const float y0 = o1[j] * rs * P.diff_norm_w[c] * bf2f(DG[(size_t)t * DH + h * HD + c]), y1 = o1[j + 1] * rs * P.diff_norm_w[c + 1] * bf2f(DG[(size_t)t * DH + h * HD + c + 1]);
        *(unsigned*)(MIX + (size_t)t * DM + DH + h * HD + c) = pk2(y0, y1);
    }
}

__global__ void __launch_bounds__(256) k_naive_gemm_out(Params P) {
    __shared__ float As[64][33], Bs[32][65];
    const bf16_t* A = (const bf16_t*)(P.ws + WS_MIX);
    const int tid = threadIdx.x, ty = tid >> 3, tx = tid & 7, m0 = blockIdx.y * 64, n0 = blockIdx.x * 64;
    float acc[2][8] = {};
    const int lr = tid >> 2, lk = (tid & 3) * 8;
    for (int k0 = 0; k0 < DM; k0 += 32) {
        const u32x4 a = *(const u32x4*)(A + (size_t)(m0 + lr) * DM + k0 + lk);
#pragma unroll
        for (int j = 0; j < 4; ++j) { As[lr][lk + 2 * j] = __uint_as_float(a[j] << 16); As[lr][lk + 2 * j + 1] = __uint_as_float(a[j] & 0xffff0000u); }
        for (int i = tid; i < 32 * 64; i += 256) { const int kk = i >> 6, nn = i & 63; Bs[kk][nn] = P.w_out[(size_t)(k0 + kk) * DM + n0 + nn]; }
        __syncthreads();
#pragma unroll 8
        for (int k = 0; k < 32; ++k) { const float a0 = As[2 * ty][k], a1 = As[2 * ty + 1][k];
#pragma unroll
            for (int j = 0; j < 8; ++j) { const float bv = Bs[k][8 * tx + j]; acc[0][j] += a0 * bv; acc[1][j] += a1 * bv; } }
        __syncthreads();
    }
#pragma unroll
    for (int r = 0; r < 2; ++r) { const size_t off = (size_t)(m0 + 2 * ty + r) * DM + n0 + 8 * tx;
#pragma unroll
        for (int j = 0; j < 8; ++j) P.out[off + j] = P.x[off + j] + acc[r][j]; }
}
__global__ void __launch_bounds__(256) k_final_norm(Params P) {
    const int lane = threadIdx.x & 63, gw = (blockIdx.x * blockDim.x + threadIdx.x) >> 6, ngw = (gridDim.x * blockDim.x) >> 6;
    for (int m = gw; m < T; m += ngw) {
        f32x4* yr = (f32x4*)(P.out + (size_t)m * DM) + lane; const f32x4* wr = (const f32x4*)P.final_norm_w + lane;
        f32x4 v[4]; float ss = 0.f;
#pragma unroll
        for (int j = 0; j < 4; ++j) { v[j] = yr[64 * j]; ss += (v[j].x * v[j].x + v[j].y * v[j].y) + (v[j].z * v[j].z + v[j].w * v[j].w); }
        const float rstd = 1.0f / sqrtf(wave_sum(ss) * (1.0f / DM) + NORM_EPS);
#pragma unroll
        for (int j = 0; j < 4; ++j) { const f32x4 w = wr[64 * j]; yr[64 * j] = (f32x4){v[j].x * rstd * w.x, v[j].y * rstd * w.y, v[j].z * rstd * w.z, v[j].w * rstd * w.w}; }
    }
}


namespace pg8 {
#define PG8_LAS __attribute__((address_space(3)))
typedef short bf16x8 __attribute__((ext_vector_type(8)));
constexpr int BM = 256, BK = 64, HALF = 128, HTB = HALF * BK * 2  , STAGE_BYTES = 8 * HTB, NXCD = 8, WGM = 8;
__host__ __device__ __forceinline__ int lds_byte(int r, int c) { const int st = (r >> 4) * 2 + (c >> 5), rr = r & 15, cc = c & 31, ob = rr * 64 + cc * 2; return st * 1024 + (ob ^ (((ob >> 9) & 1) << 5)); }
__host__ __device__ __forceinline__ void stage_rc(int b, int& R, int& C) { const int st = b / 1024, sb = b % 1024, swz = sb ^ (((sb >> 9) & 1) << 5); R = (st >> 1) * 16 + swz / 64; C = (st & 1) * 32 + (swz % 64) / 2; }
__host__ __device__ __forceinline__ int perm32(int rho) { const int n = rho >> 4, i = rho & 15; return 8 * (i >> 2) + 4 * n + (i & 3); }
struct Unit { int pm, pn; };
struct Gemm { const bf16_t* A; const bf16_t* Bt; int M, N, K; };
struct StaticOrder {
    int nM, nN, nwg, G, c;
    __host__ __device__ void init(int M, int N, int G_, int c_) { nM = M / BM; nN = N / BM; nwg = nM * nN; G = G_; c = c_; }
    __host__ __device__ bool next(int i, Unit& u) const {
        const long L = (long)i * G + c; if (L >= nwg) return false;
        int wgid = (int)L; { const int q = nwg / NXCD, r = nwg % NXCD, xcd = wgid % NXCD, off = wgid / NXCD; wgid = (xcd < r ? xcd * (q + 1) : r * (q + 1) + (xcd - r) * q) + off; }
        const int nig = WGM * nN, gid = wgid / nig, fm = gid * WGM, gsz = (nM - fm) < WGM ? (nM - fm) : WGM;
        u.pm = fm + ((wgid % nig) % gsz); u.pn = (wgid % nig) / gsz; return true;
    }
    __device__ __forceinline__ void a_ready(const Unit&) const {}
    __device__ __forceinline__ void done(const Unit&) const {}
};
template <class Epi, class Sched, bool ALIGN_EPI = false, bool SP2 = false>
__device__ __forceinline__ void gemm_phase(PG8_LAS unsigned char* lds, const Gemm g, const Sched& S, const Epi& E) {
    const int tid = opaque_tid(), wid = __builtin_amdgcn_readfirstlane(tid >> 6), lane = tid & 63, wr = wid >> 2, wc = wid & 3, fr = lane & 15, fq = lane >> 4;
    const int K = g.K, nt = K / BK;
    unsigned voffA[2], voffB[2];
#pragma unroll
    for (int i = 0; i < 2; ++i) { int R, C; stage_rc(tid * 16 + i * 8192, R, C); const int Rb = Epi::PERM ? ((R & ~31) + perm32(R & 31)) : R;
        voffA[i] = (unsigned)(R * K + C) * 2u; voffB[i] = (unsigned)(Rb * K + C) * 2u; }
    const size_t kstep = (size_t)(BK * 2);
    const size_t hstep = (size_t)HALF * K * 2;
    const size_t tstep = 2 * hstep;
    const unsigned ldsw = (unsigned)wid * 1024u;
    const int aoff = lds_byte(wr * 64 + fr, fq * 8), boff = lds_byte(wc * 32 + fr, fq * 8);
#define PG8_SA(b, h) (((b) * 2 + (h)) * HTB)
#define PG8_SB(b, h) ((4 + (b) * 2 + (h)) * HTB)
#define PG8_STAGE(bufoff, gbase, voff) do { _Pragma("unroll") for (int _i = 0; _i < 2; ++_i) \
        __builtin_amdgcn_global_load_lds((const unsigned*)((const char*)(gbase) + (voff)[_i]), (PG8_LAS unsigned*)(lds + (bufoff) + ldsw + _i * 8192), 16, 0, 0); } while (0)
#define PG8_LDA(dst, b, h) do { _Pragma("unroll") for (int m = 0; m < 4; ++m) _Pragma("unroll") for (int k = 0; k < 2; ++k) dst[m][k] = *(const PG8_LAS bf16x8*)(lds + PG8_SA(b, h) + aoff + m * 2048 + k * 1024); } while (0)
#define PG8_LDB(dst, b, h) do { _Pragma("unroll") for (int n = 0; n < 2; ++n) _Pragma("unroll") for (int k = 0; k < 2; ++k) dst[n][k] = *(const PG8_LAS bf16x8*)(lds + PG8_SB(b, h) + boff + n * 2048 + k * 1024); } while (0)
#define PG8_MMA(ai, bj, At, Bt) do { __builtin_amdgcn_s_setprio(1); _Pragma("unroll") for (int m = 0; m < 4; ++m) _Pragma("unroll") for (int n = 0; n < 2; ++n) _Pragma("unroll") for (int k = 0; k < 2; ++k) \
        acc[ai][bj][m][n] = __builtin_amdgcn_mfma_f32_16x16x32_bf16(Bt[n][k], At[m][k], acc[ai][bj][m][n], 0, 0, 0); __builtin_amdgcn_s_setprio(0); } while (0)
#define PG8_WAIT_V(n) asm volatile("s_waitcnt vmcnt(" #n ")" ::: "memory")
#define PG8_WAIT_L(n) asm volatile("s_waitcnt lgkmcnt(" #n ")" ::: "memory")
#define PG8_BAR __builtin_amdgcn_s_barrier()
#define PG8_SCHED __builtin_amdgcn_sched_barrier(0)
    Unit cur, nxt; int ui = 0;
    if (!S.next(0, cur)) return;
    f32x4 acc[2][2][4][2];
#pragma unroll
    for (int a = 0; a < 2; ++a)
#pragma unroll
        for (int b = 0; b < 2; ++b)
#pragma unroll
            for (int m = 0; m < 4; ++m)
#pragma unroll
                for (int n = 0; n < 2; ++n) acc[a][b][m][n] = (f32x4){0.f, 0.f, 0.f, 0.f};
    bf16x8 At[4][2], B0[2][2], B1[2][2];
    const char* cA = (const char*)g.A + (size_t)cur.pm * tstep; const char* cB = (const char*)g.Bt + (size_t)cur.pn * tstep;
    S.a_ready(cur);
    if constexpr (SP2) {
        PG8_STAGE(PG8_SB(0, 0), cB, voffB); PG8_STAGE(PG8_SB(0, 1), cB + hstep, voffB); PG8_STAGE(PG8_SA(0, 0), cA, voffA); PG8_STAGE(PG8_SA(0, 1), cA + hstep, voffA);
        if (wr == 1) PG8_BAR;
        PG8_WAIT_V(2); PG8_BAR;
        PG8_STAGE(PG8_SB(1, 0), cB + kstep, voffB); PG8_STAGE(PG8_SA(1, 0), cA + kstep, voffA); PG8_STAGE(PG8_SB(1, 1), cB + hstep + kstep, voffB);
        PG8_WAIT_V(6); PG8_BAR;
    } else {
        PG8_STAGE(PG8_SB(0, 0), cB, voffB); PG8_STAGE(PG8_SA(0, 0), cA, voffA); PG8_STAGE(PG8_SB(0, 1), cB + hstep, voffB); PG8_STAGE(PG8_SA(0, 1), cA + hstep, voffA);
        if (wr == 1) PG8_BAR;
        PG8_WAIT_V(4); PG8_BAR;
        PG8_STAGE(PG8_SB(1, 0), cB + kstep, voffB); PG8_STAGE(PG8_SA(1, 0), cA + kstep, voffA); PG8_STAGE(PG8_SB(1, 1), cB + hstep + kstep, voffB);
        PG8_WAIT_V(6); PG8_BAR;
    }
    for (;;) {
        const bool has_next = S.next(ui + 1, nxt);
        const char* nA = has_next ? (const char*)g.A + (size_t)nxt.pm * tstep : cA; const char* nB = has_next ? (const char*)g.Bt + (size_t)nxt.pn * tstep : cB;
        for (int t = 0; t < nt; t += 2) {
            const bool last = (t == nt - 2);
            const char* a1 = cA + (size_t)(t + 1) * kstep;
            const char* a2 = last ? nA : cA + (size_t)(t + 2) * kstep; const char* b2 = last ? nB : cB + (size_t)(t + 2) * kstep;
            const char* a3 = a2 + kstep; const char* b3 = b2 + kstep;
            if (last && has_next) S.a_ready(nxt);
            if constexpr (SP2) {
            PG8_LDB(B0, 0, 0); PG8_LDB(B1, 0, 1); PG8_SCHED; PG8_LDA(At, 0, 0); PG8_STAGE(PG8_SA(1, 1), a1 + hstep, voffA);
            PG8_WAIT_V(8); PG8_WAIT_L(0); PG8_BAR; PG8_MMA(0, 0, At, B0); PG8_MMA(0, 1, At, B1); PG8_BAR; PG8_SCHED;
            PG8_LDA(At, 0, 1); PG8_STAGE(PG8_SB(0, 0), b2, voffB); PG8_STAGE(PG8_SB(0, 1), b2 + hstep, voffB); PG8_STAGE(PG8_SA(0, 0), a2, voffA);
            PG8_WAIT_V(8); PG8_WAIT_L(0); PG8_BAR; PG8_MMA(1, 0, At, B0); PG8_MMA(1, 1, At, B1); PG8_BAR; PG8_SCHED;
            PG8_LDB(B0, 1, 0); PG8_LDB(B1, 1, 1); PG8_SCHED; PG8_LDA(At, 1, 0); PG8_STAGE(PG8_SA(0, 1), a2 + hstep, voffA);
            PG8_WAIT_V(8); PG8_WAIT_L(0); PG8_BAR; PG8_MMA(0, 0, At, B0); PG8_MMA(0, 1, At, B1); PG8_BAR; PG8_SCHED;
            PG8_LDA(At, 1, 1); PG8_STAGE(PG8_SB(1, 0), b3, voffB); PG8_STAGE(PG8_SB(1, 1), b3 + hstep, voffB); PG8_STAGE(PG8_SA(1, 0), a3, voffA);
            PG8_WAIT_V(8); PG8_WAIT_L(0); PG8_BAR; PG8_MMA(1, 0, At, B0); PG8_MMA(1, 1, At, B1); PG8_BAR; PG8_SCHED;
            } else {
            PG8_LDB(B0, 0, 0); PG8_SCHED; PG8_LDA(At, 0, 0); PG8_STAGE(PG8_SA(1, 1), a1 + hstep, voffA);
            PG8_WAIT_L(8); PG8_BAR; PG8_WAIT_L(0); PG8_MMA(0, 0, At, B0); PG8_BAR; PG8_SCHED;
            PG8_LDB(B1, 0, 1); PG8_STAGE(PG8_SB(0, 0), b2, voffB);
            PG8_BAR; PG8_WAIT_L(0); PG8_MMA(0, 1, At, B1); PG8_BAR;
            PG8_LDA(At, 0, 1); PG8_STAGE(PG8_SA(0, 0), a2, voffA);
            PG8_BAR; PG8_WAIT_L(0); PG8_MMA(1, 0, At, B0); PG8_BAR; PG8_SCHED;
            PG8_STAGE(PG8_SB(0, 1), b2 + hstep, voffB);
            PG8_WAIT_V(6); PG8_BAR; PG8_MMA(1, 1, At, B1); PG8_BAR;
            PG8_LDB(B0, 1, 0); PG8_SCHED; PG8_LDA(At, 1, 0); PG8_STAGE(PG8_SA(0, 1), a2 + hstep, voffA);
            PG8_WAIT_L(8); PG8_BAR; PG8_WAIT_L(0); PG8_MMA(0, 0, At, B0); PG8_BAR; PG8_SCHED;
            PG8_LDB(B1, 1, 1); PG8_STAGE(PG8_SB(1, 0), b3, voffB);
            PG8_BAR; PG8_WAIT_L(0); PG8_MMA(0, 1, At, B1); PG8_BAR;
            PG8_LDA(At, 1, 1); PG8_STAGE(PG8_SA(1, 0), a3, voffA);
            PG8_BAR; PG8_WAIT_L(0); PG8_MMA(1, 0, At, B0); PG8_BAR; PG8_SCHED;
            PG8_STAGE(PG8_SB(1, 1), b3 + hstep, voffB);
            PG8_WAIT_V(6); PG8_BAR; PG8_MMA(1, 1, At, B1); PG8_BAR;
            }
        }
        if constexpr (ALIGN_EPI) { if (wr == 0) PG8_BAR; }
        if constexpr (!Epi::AFTER_DRAIN) { E(acc, cur, wr, wc, fr, fq); S.done(cur); }
        if (!has_next) break;
#pragma unroll
        for (int a = 0; a < 2; ++a)
#pragma unroll
            for (int b = 0; b < 2; ++b)
#pragma unroll
                for (int m = 0; m < 4; ++m)
#pragma unroll
                    for (int n = 0; n < 2; ++n) acc[a][b][m][n] = (f32x4){0.f, 0.f, 0.f, 0.f};
        cur = nxt; cA = nA; cB = nB; ++ui;
        if constexpr (ALIGN_EPI) { if (wr == 1) PG8_BAR; }
    }
    PG8_WAIT_V(0);
    if constexpr (!ALIGN_EPI) { if (wr == 0) PG8_BAR; }
    PG8_BAR;
    if constexpr (Epi::AFTER_DRAIN) { E.fused(acc, cur, wr, wc, fr, fq, lds, wid, lane); S.done(cur); }
#undef PG8_SA
#undef PG8_SB
#undef PG8_STAGE
#undef PG8_LDA
#undef PG8_LDB
#undef PG8_MMA
#undef PG8_WAIT_V
#undef PG8_WAIT_L
#undef PG8_BAR
#undef PG8_SCHED
}
}

struct EpiIn {
    static constexpr bool PERM = true, AFTER_DRAIN = false;
    Params P;
    template <int TYPE> __device__ __forceinline__ void run(const f32x4 (&acc)[2][2][4][2], const pg8::Unit& u, int wr, int wc, int fr, int fq) const {
        const int row0 = u.pm * pg8::BM + wr * 64 + fr, c0 = (u.pn & 1) * 256 + wc * 32 + 8 * fq;
#pragma unroll
        for (int ai = 0; ai < 2; ++ai)
#pragma unroll
            for (int m = 0; m < 4; ++m)
#pragma unroll
                for (int bj = 0; bj < 2; ++bj) {
                    const f32x4 v0 = acc[ai][bj][m][0], v1 = acc[ai][bj][m][1];
                    const float v[8] = {v0[0], v0[1], v0[2], v0[3], v1[0], v1[1], v1[2], v1[3]};
                    epi8(P, TYPE, row0 + ai * pg8::HALF + m * 16, c0 + bj * pg8::HALF, v);
                }
    }
    __device__ __forceinline__ void operator()(const f32x4 (&acc)[2][2][4][2], const pg8::Unit& u, int wr, int wc, int fr, int fq) const {
        switch (u.pn >> 1) {
            case 0: run<0>(acc, u, wr, wc, fr, fq); break; case 1: run<1>(acc, u, wr, wc, fr, fq); break;
            case 2: run<2>(acc, u, wr, wc, fr, fq); break; case 3: run<3>(acc, u, wr, wc, fr, fq); break;
            case 4: run<4>(acc, u, wr, wc, fr, fq); break; case 5: run<5>(acc, u, wr, wc, fr, fq); break;
            case 6: run<6>(acc, u, wr, wc, fr, fq); break; default: run<7>(acc, u, wr, wc, fr, fq); break;
        }
    }
};
struct EpiOut {
    static constexpr bool PERM = false, AFTER_DRAIN = false;
    Params P;
    __device__ __forceinline__ void operator()(const f32x4 (&acc)[2][2][4][2], const pg8::Unit& u, int wr, int wc, int fr, int fq) const {
        float* rowsq = (float*)(P.ws + WS_CTL) + CT_ROWSQ;
        const int col0 = u.pn * pg8::BM + wc * 32 + 4 * fq;
#pragma unroll
        for (int ai = 0; ai < 2; ++ai)
#pragma unroll
            for (int m = 0; m < 4; ++m) {
                const int r = u.pm * pg8::BM + ai * pg8::HALF + wr * 64 + m * 16 + fr; const size_t off = (size_t)r * DM + col0; float ss = 0.f;
#pragma unroll
                for (int bj = 0; bj < 2; ++bj)
#pragma unroll
                    for (int n = 0; n < 2; ++n) { const f32x4 xv = *(const f32x4*)(P.x + off + bj * pg8::HALF + n * 16); const f32x4 y = xv + acc[ai][bj][m][n];
                        ss += (y[0] * y[0] + y[1] * y[1]) + (y[2] * y[2] + y[3] * y[3]); *(f32x4*)(P.out + off + bj * pg8::HALF + n * 16) = y; }
                ss += __shfl_xor(ss, 16); ss += __shfl_xor(ss, 32);
                if (fq == 0) atomicAdd(rowsq + r, ss);
            }
    }
};

namespace att {
typedef short bf16x8 __attribute__((ext_vector_type(8)));
typedef short s16x4 __attribute__((ext_vector_type(4)));
typedef float f32x16 __attribute__((ext_vector_type(16)));
constexpr int QBLK = 32, KVBLK = 64, QB = 128;
constexpr int SHM_V = KVBLK * 128 * 2, SHM_K = KVBLK * 128 * 2;
constexpr int OFF_V = 0, OFF_K = 2 * SHM_V, OFF_WS = 2 * SHM_V + 2 * SHM_K, OFF_X = OFF_WS + 8 * 64 * 4, XW = 4224  , LDS_BYTES = OFF_X + 4 * XW * 4;
constexpr float THR = 8.f;
#define KSWZ(row, colB) ((row) * 256 + ((colB) ^ (((row) & 7) << 4)))
#define SBAR() __builtin_amdgcn_sched_barrier(0)
__device__ __forceinline__ int v_st(int k, int c) { const int kk = (k & ~0xC) | ((k & 4) << 1) | ((k & 8) >> 1); return ((kk >> 3) * 4 + (c >> 5)) * 512 + ((kk & 7) * 32 + (c & 31)) * 2; }
__device__ __forceinline__ int v_rd_base(int lane) { return ((lane & 3) << 3) | (((lane >> 2) & 3) << 6) | (((lane >> 4) & 1) << 5) | (((lane >> 5) & 1) << 8); }
constexpr int v_rd_off(int d0, int ks, int half) { return d0 * 512 + ks * 4096 + half * 2048; }
__device__ __forceinline__ int crow(int r, int hi) { return (r & 3) + 8 * (r >> 2) + 4 * hi; }
__device__ __forceinline__ unsigned cvtpk(float lo, float hi) { unsigned r; asm volatile("v_cvt_pk_bf16_f32 %0, %1, %2" : "=v"(r) : "v"(lo), "v"(hi)); return r; }
__device__ __forceinline__ void mask_tile(f32x16& p0, f32x16& p1, int dq) {
    const float NEG = -__builtin_inff();
#pragma unroll
    for (int r = 0; r < 16; ++r) { const int c = (r & 3) + 8 * (r >> 2); if (dq - c < 0) p0[r] = NEG; if (dq - c - 32 < 0) p1[r] = NEG; }
}
__device__ __forceinline__ float rowmax32(const f32x16& p0, const f32x16& p1) {
    float a = fmaxf(fmaxf(p0[0], p0[1]), p1[0]), b = fmaxf(fmaxf(p0[2], p0[3]), p1[1]); a = fmaxf(fmaxf(a, p1[2]), p1[3]);
#pragma unroll
    for (int r = 4; r < 16; r += 4) { a = fmaxf(fmaxf(a, p0[r]), p0[r + 1]); b = fmaxf(fmaxf(b, p0[r + 2]), p0[r + 3]); a = fmaxf(fmaxf(a, p1[r]), p1[r + 1]); b = fmaxf(fmaxf(b, p1[r + 2]), p1[r + 3]); }
    float m = fmaxf(a, b);
    auto rr = __builtin_amdgcn_permlane32_swap(__float_as_uint(m), __float_as_uint(m), false, false);
    return fmaxf(__uint_as_float(rr[0]), __uint_as_float(rr[1]));
}
template <bool FIRST>
__device__ __forceinline__ float decide(f32x16& p0, f32x16& p1, float& l_reg, f32x16& negm) {
    const float rm = rowmax32(p0, p1); float alpha = 1.f;
    if (FIRST || __builtin_expect(__any(rm > THR), 0)) {
        const float dl = FIRST ? rm : fmaxf(rm, 0.f); const float nm = negm[0] - dl;
#pragma unroll
        for (int r = 0; r < 16; ++r) { p0[r] -= dl; p1[r] -= dl; }
#pragma unroll
        for (int r = 0; r < 16; ++r) negm[r] = nm;
        asm volatile("" : "+v"(negm));
        if (!FIRST) { alpha = __builtin_amdgcn_exp2f(-dl); l_reg *= alpha; }
    }
    return alpha;
}
__device__ __forceinline__ void finishP(const f32x16& p0, const f32x16& p1, bf16x8& pa0, bf16x8& pa1, bf16x8& pa2, bf16x8& pa3) {
#define PK4(P, B_, OUT) do { unsigned a0 = cvtpk(P[B_+0], P[B_+1]), a1 = cvtpk(P[B_+2], P[B_+3]);                          \
        unsigned b0 = cvtpk(P[B_+4], P[B_+5]), b1 = cvtpk(P[B_+6], P[B_+7]);                                             \
        auto r0 = __builtin_amdgcn_permlane32_swap(a0, b0, false, false); auto r1 = __builtin_amdgcn_permlane32_swap(a1, b1, false, false); \
        u32x4 w = {r0[0], r1[0], r0[1], r1[1]}; OUT = *reinterpret_cast<bf16x8*>(&w); } while (0)
    PK4(p0, 0, pa0); PK4(p0, 8, pa1); PK4(p1, 0, pa2); PK4(p1, 8, pa3);
#undef PK4
}
template <int KB>
__device__ __forceinline__ void qkt(f32x16& p0, f32x16& p1, const char* K_lds, int kx, const char* qf, const f32x16& negm) {
    p0 = negm; p1 = negm;
#pragma unroll
    for (int d0 = 0; d0 < 4; ++d0) { const char* a = K_lds + KB * SHM_K + (kx ^ (d0 * 32));
        bf16x8 b0 = *reinterpret_cast<const bf16x8*>(a);
        bf16x8 b1 = *reinterpret_cast<const bf16x8*>(a + 32 * 256);
        const bf16x8 q = *reinterpret_cast<const bf16x8*>(qf + d0 * 1024);
        p0 = __builtin_amdgcn_mfma_f32_32x32x16_bf16(b0, q, p0, 0, 0, 0);
        p1 = __builtin_amdgcn_mfma_f32_32x32x16_bf16(b1, q, p1, 0, 0, 0); }
}
typedef short v4i16_t __attribute__((ext_vector_type(4)));
typedef __attribute__((address_space(3))) const char* lds_cptr;
__device__ __forceinline__ s16x4 vtr(lds_cptr p) { return __builtin_bit_cast(s16x4, __builtin_amdgcn_ds_read_tr16_b64_v4i16((__attribute__((address_space(3))) v4i16_t*)p)); }
template <int VB, bool EXPS>
__device__ __forceinline__ void pv_tile(f32x16* o, lds_cptr vp0, bf16x8 pa0, bf16x8 pa1, bf16x8 pa2, bf16x8 pa3, f32x16& X0, f32x16& X1, float& l_reg) {
#define VFR(d0, ks) ({ const s16x4 l_ = vtr(vp0 + VB * SHM_V + v_rd_off(d0, ks, 0)), h_ = vtr(vp0 + VB * SHM_V + v_rd_off(d0, ks, 1)); (bf16x8){l_[0], l_[1], l_[2], l_[3], h_[0], h_[1], h_[2], h_[3]}; })
#define GAPB(MF, X, B_) do { MF; if (EXPS) { X[B_] = __builtin_amdgcn_exp2f(X[B_]); X[B_ + 1] = __builtin_amdgcn_exp2f(X[B_ + 1]); sa += X[B_]; sb += X[B_ + 1]; asm volatile("" : "+v"(X), "+v"(sa), "+v"(sb)); } SBAR(); } while (0)
    float sa = 0.f, sb = 0.f;
    bf16x8 fa0, fa1, fa2, fa3, fb0, fb1, fb2, fb3;
#define RDA(d0) do { fa0 = VFR(d0, 0); fa1 = VFR(d0, 1); fa2 = VFR(d0, 2); fa3 = VFR(d0, 3); } while (0)
#define RDB(d0) do { fb0 = VFR(d0, 0); fb1 = VFR(d0, 1); fb2 = VFR(d0, 2); fb3 = VFR(d0, 3); } while (0)
#define MMA(d0, F0, F1, F2, F3, XA, BA, XB, BB) do { \
    GAPB(o[d0] = __builtin_amdgcn_mfma_f32_32x32x16_bf16(pa0, F0, o[d0], 0, 0, 0), XA, BA);          \
    GAPB(o[d0] = __builtin_amdgcn_mfma_f32_32x32x16_bf16(pa1, F1, o[d0], 0, 0, 0), XA, BA + 2);      \
    GAPB(o[d0] = __builtin_amdgcn_mfma_f32_32x32x16_bf16(pa2, F2, o[d0], 0, 0, 0), XB, BB);          \
    GAPB(o[d0] = __builtin_amdgcn_mfma_f32_32x32x16_bf16(pa3, F3, o[d0], 0, 0, 0), XB, BB + 2); } while (0)
    RDA(0); RDB(1); SBAR();
    MMA(0, fa0, fa1, fa2, fa3, X0, 0, X0, 4);
    RDA(2); SBAR();
    MMA(1, fb0, fb1, fb2, fb3, X0, 8, X0, 12);
    RDB(3); SBAR();
    MMA(2, fa0, fa1, fa2, fa3, X1, 0, X1, 4);
    MMA(3, fb0, fb1, fb2, fb3, X1, 8, X1, 12);
#undef RDA
#undef RDB
#undef MMA
    if (EXPS) l_reg += sa + sb;
#undef GAPB
#undef VFR
}

__device__ __forceinline__ void attn_unit(const Params& P, int h, int qb, char* lds) {
    const int tid = opaque_tid(), wid = __builtin_amdgcn_readfirstlane(tid >> 6), lane = tid & 63, r32 = lane & 31, hi = lane >> 5;
    const int comp = wid >> 2, wq = wid & 3;
    const int q0 = qb * QB, NT = 2 * qb + 2;
    const int qlo = q0 + wq * QBLK, qm = qlo + r32 - 4 * hi;
    const bf16_t* DQ = (const bf16_t*)(P.ws + WS_DQ);
    char* V_lds = lds + OFF_V; char* K_lds = lds + OFF_K;
    float* ws = (float*)(lds + OFF_WS) + wid * 64; float* li_l = ws; float* al_l = ws + 32;
    float l_reg = 0.f; f32x16 o[4]; f32x16 negm;
    { float zf = 0.f; asm volatile("" : "+v"(zf));
#pragma unroll
      for (int r = 0; r < 16; ++r) { negm[r] = zf; o[0][r] = zf; o[1][r] = zf; o[2][r] = zf; o[3][r] = zf; } }
    const int kx = r32 * 256 + comp * 128 + ((hi * 16) ^ ((r32 & 7) << 4));
    const lds_cptr vp0 = (lds_cptr)V_lds + v_rd_base(lane);
    char* qf = lds + OFF_X + wid * 4096 + lane * 16;
#pragma unroll
    for (int d0 = 0; d0 < 4; ++d0) *(bf16x8*)(qf + d0 * 1024) = *(const bf16x8*)(DQ + (size_t)(qlo + r32) * DH + h * HD + comp * 64 + d0 * 16 + hi * 8);
    const __amdgpu_buffer_rsrc_t rsK = __builtin_amdgcn_make_buffer_rsrc((void*)(P.ws + WS_DK), 0, (unsigned)((size_t)T * DH * 2), 0x00020000);
    const __amdgpu_buffer_rsrc_t rsV = __builtin_amdgcn_make_buffer_rsrc((void*)(P.ws + WS_DV), 0, (unsigned)((size_t)T * DH * 2), 0x00020000);
    int voK0, voK1, voV0, voV1;
    { const int c0 = (2 * wid) * 64 + lane, c1 = c0 + 64;
      auto ksrc = [&](int ci) { const int row = ci >> 4, cc = (ci & 15) ^ (row & 7); return (row * DH + h * HD + cc * 8) * 2; };
      auto vsrc = [&](int ci) { const int st = ci >> 5, kk = (st >> 2) * 8 + ((ci & 31) >> 2), c = (st & 3) * 32 + (ci & 3) * 8;
                                const int k = (kk & ~0xC) | ((kk & 4) << 1) | ((kk & 8) >> 1); return (k * DH + h * HD + c) * 2; };
      voK0 = ksrc(c0); voK1 = ksrc(c1); voV0 = vsrc(c0); voV1 = vsrc(c1); }
    const unsigned ldsK = (unsigned)(uintptr_t)K_lds + (unsigned)wid * 2048u, ldsV = (unsigned)(uintptr_t)V_lds + (unsigned)wid * 2048u;
#define DMA1(rs, vo, m0v, so) asm volatile("s_nop 4\n\ts_mov_b32 m0, %0\n\ts_nop 0\n\tbuffer_load_dwordx4 %1, %2, %3 offen lds" :: "s"(m0v), "v"(vo), "s"(rs), "s"(so) : "m0", "memory")
#define DMA_K(t, bf) do { const unsigned so_ = (unsigned)__builtin_amdgcn_readfirstlane((t) * KVBLK * DH * 2), m_ = (unsigned)__builtin_amdgcn_readfirstlane(ldsK + (bf) * SHM_K); DMA1(rsK, voK0, m_, so_); DMA1(rsK, voK1, m_ + 1024u, so_); } while (0)
#define DMA_V(t, bf) do { const unsigned so_ = (unsigned)__builtin_amdgcn_readfirstlane((t) * KVBLK * DH * 2), m_ = (unsigned)__builtin_amdgcn_readfirstlane(ldsV + (bf) * SHM_V); DMA1(rsV, voV0, m_, so_); DMA1(rsV, voV1, m_ + 1024u, so_); } while (0)
#define WAIT_BAR(N) asm volatile("s_waitcnt vmcnt(" #N ") lgkmcnt(0)\n\ts_barrier" ::: "memory")
#define RESC(a) do { if (__any((a) < 1.f)) { if (hi == 0) al_l[r32] = (a); asm volatile("s_waitcnt lgkmcnt(0)" ::: "memory");              \
                     _Pragma("unroll") for (int d_ = 0; d_ < 4; ++d_) _Pragma("unroll") for (int r = 0; r < 16; ++r) o[d_][r] *= al_l[4 * hi + (r & 3) + 8 * (r >> 2)]; } } while (0)
#define KBASE(t) ((t) * KVBLK)
#define MASKT(P0_, P1_, t) do { const int kb_ = KBASE(t); if (kb_ + KVBLK - 1 > qlo) mask_tile(P0_, P1_, qm - kb_); } while (0)
    f32x16 pA0, pA1, pB0, pB1; float alX; bf16x8 pa0, pa1, pa2, pa3;
    DMA_K(0, 0); DMA_V(0, 0); DMA_K(1, 1);
    WAIT_BAR(2);
    SBAR(); qkt<0>(pA0, pA1, K_lds, kx, qf, negm);
    MASKT(pA0, pA1, 0); (void)decide<true>(pA0, pA1, l_reg, negm);
#pragma unroll
    for (int r = 0; r < 16; ++r) { pA0[r] = __builtin_amdgcn_exp2f(pA0[r]); pA1[r] = __builtin_amdgcn_exp2f(pA1[r]); l_reg += pA0[r] + pA1[r]; }
    DMA_V(1, 1);
    WAIT_BAR(2);
#define HALF_STEP(PX0, PX1, PY0, PY1, t, KB, VB, SB) do {                                                                    \
        DMA_K((t) + 1, SB);                                                                                                   \
        SBAR(); qkt<KB>(PX0, PX1, K_lds, kx, qf, negm);                                                                       \
        finishP(PY0, PY1, pa0, pa1, pa2, pa3); SBAR();                                                                 \
        MASKT(PX0, PX1, (t)); alX = decide<false>(PX0, PX1, l_reg, negm); SBAR();                                             \
        pv_tile<VB, true>(o, vp0, pa0, pa1, pa2, pa3, PX0, PX1, l_reg);                                                              \
        WAIT_BAR(2);                                                                                                          \
        DMA_V((t) + 1, SB);                                                                                                   \
        RESC(alX);                                                                                                            \
        WAIT_BAR(2); } while (0)
    for (int t = 1; t + 1 < NT; t += 2) {
        HALF_STEP(pB0, pB1, pA0, pA1, t, 1, 0, 0);
        HALF_STEP(pA0, pA1, pB0, pB1, t + 1, 0, 1, 1);
    }
    SBAR(); qkt<1>(pB0, pB1, K_lds, kx, qf, negm);
    finishP(pA0, pA1, pa0, pa1, pa2, pa3); SBAR();
    MASKT(pB0, pB1, NT - 1); alX = decide<false>(pB0, pB1, l_reg, negm); SBAR();
    pv_tile<0, true>(o, vp0, pa0, pa1, pa2, pa3, pB0, pB1, l_reg);
    RESC(alX);
    WAIT_BAR(0);
    finishP(pB0, pB1, pa0, pa1, pa2, pa3); SBAR();
    pv_tile<1, false>(o, vp0, pa0, pa1, pa2, pa3, pB0, pB1, l_reg);
    { auto rr = __builtin_amdgcn_permlane32_swap(__float_as_uint(l_reg), __float_as_uint(l_reg), false, false); l_reg = __uint_as_float(rr[0]) + __uint_as_float(rr[1]); }
    SBAR(); asm volatile("" ::: "memory");
    int le = lane; asm volatile("" : "+v"(le));
    const int r32e = le & 31, hie = le >> 5;
    float* wse = (float*)(lds + OFF_WS) + wid * 64;
    if (hie == 0) wse[r32e] = l_reg; asm volatile("s_waitcnt lgkmcnt(0)" ::: "memory");
    {
        float rli[16]; const float* lb_ = wse + 4 * hie;
#pragma unroll
        for (int r = 0; r < 16; ++r) rli[r] = __builtin_amdgcn_rcpf(lb_[(r & 3) + 8 * (r >> 2)]);
        if (comp == 1) { const float lam = ((const float*)(P.ws + WS_CTL))[CT_LAM];
#pragma unroll
            for (int r = 0; r < 16; ++r) rli[r] *= lam; }
#pragma unroll
        for (int d0 = 0; d0 < 4; ++d0)
#pragma unroll
            for (int r = 0; r < 16; ++r) o[d0][r] *= rli[r];
    }
    __syncthreads();
    float* X = (float*)(lds + OFF_X) + wq * XW;
    float* Xl = X + le;
    if (comp == 1) {
#pragma unroll
        for (int d0 = 0; d0 < 4; ++d0)
#pragma unroll
            for (int r = 0; r < 16; ++r) Xl[(d0 * 16 + r) * 64] = o[d0][r];
    }
    __syncthreads();
    if (comp == 0) {
#pragma unroll
        for (int r = 0; r < 16; ++r) { float s = 0.f;
#pragma unroll
            for (int d0 = 0; d0 < 4; ++d0) { const float v = o[d0][r] - Xl[(d0 * 16 + r) * 64]; o[d0][r] = v; s += v * v; }
            s += __shfl_xor(s, 1); s += __shfl_xor(s, 2); s += __shfl_xor(s, 4); s += __shfl_xor(s, 8); s += __shfl_xor(s, 16);
            const float rs = (1.0f - LAMBDA_INIT) / sqrtf(s * (1.0f / HD) + SUBLN_EPS);
#pragma unroll
            for (int d0 = 0; d0 < 4; ++d0) o[d0][r] *= rs; }
        asm volatile("s_waitcnt lgkmcnt(0)" ::: "memory"); SBAR();
        float* Xb = X + 4 * hie * 132 + r32e;
#pragma unroll
        for (int r = 0; r < 16; ++r)
#pragma unroll
            for (int d0 = 0; d0 < 4; ++d0) Xb[((r & 3) + 8 * (r >> 2)) * 132 + d0 * 32] = o[d0][r];
        asm volatile("s_waitcnt lgkmcnt(0)" ::: "memory"); SBAR();
        const int row = le >> 1, hf = le & 1, t = qlo + row;
        const bf16_t* DGp = (const bf16_t*)(P.ws + WS_DG) + (size_t)t * DH + h * HD + hf * 64; bf16_t* MXp = (bf16_t*)(P.ws + WS_MIX) + (size_t)t * DM + DH + h * HD + hf * 64;
        const float* nwp = P.diff_norm_w + hf * 64; const float* xr = X + row * 132 + hf * 64;
#pragma unroll
        for (int ps = 0; ps < 2; ++ps) {
            u32x4 g[4]; f32x4 y[8], nw[8];
#pragma unroll
            for (int k = 0; k < 4; ++k) g[k] = *(const u32x4*)(DGp + ps * 32 + k * 8);
#pragma unroll
            for (int k = 0; k < 8; ++k) { y[k] = *(const f32x4*)(xr + ps * 32 + k * 4); nw[k] = *(const f32x4*)(nwp + ps * 32 + k * 4); }
#pragma unroll
            for (int k = 0; k < 4; ++k) { u32x4 w;
#pragma unroll
                for (int j = 0; j < 2; ++j) { const f32x4 yy = y[2 * k + j] * nw[2 * k + j]; const unsigned g01 = g[k][2 * j], g23 = g[k][2 * j + 1];
                    w[2 * j] = pk2(yy.x * __uint_as_float(g01 << 16), yy.y * __uint_as_float(g01 & 0xffff0000u)); w[2 * j + 1] = pk2(yy.z * __uint_as_float(g23 << 16), yy.w * __uint_as_float(g23 & 0xffff0000u)); }
                *(u32x4*)(MXp + ps * 32 + k * 8) = w; }
            asm volatile("" ::: "memory");
        }
    }
    __syncthreads();
#undef DMA1
#undef DMA_K
#undef DMA_V
#undef WAIT_BAR
#undef RESC
#undef KBASE
#undef MASKT
#undef HALF_STEP
}
__device__ __forceinline__ void attn_phase(const Params& P, int vcu, int nblk, char* lds) {
    for (int it = vcu; it < 256; it += nblk) { const int h = it >> 6, j = it & 63; for (int u = 0; u < 2; ++u) attn_unit(P, h, u ? j : 127 - j, lds); }
}
#undef KSWZ
#undef SBAR
}

namespace hg {
typedef short bf16x8 __attribute__((ext_vector_type(8)));
typedef short s16x4 __attribute__((ext_vector_type(4)));
typedef float f32x16 __attribute__((ext_vector_type(16)));
typedef __attribute__((address_space(3))) unsigned char lds_u8;
constexpr int RS_Q = 272, RS_T = 320, RS_P = 144, RS_O = 528;
constexpr int OFF_QT = 0, OFF_KT = 17408, OFF_OO = 0, OFF_KH = 34816, OFF_VV = 55296, OFF_ST = 75776, OFF_PP = 110592, OFF_GT = 119808, OFF_BM = 123904, OFF_BL = 124416, LDS_BYTES = 124928;
__device__ __forceinline__ int crow(int r, int hi) { return (r & 3) + 8 * (r >> 2) + 4 * hi; }
__device__ __forceinline__ bf16x8 ld128(const lds_u8* p) { return *(const __attribute__((address_space(3))) bf16x8*)p; }
typedef short v4i16_t __attribute__((ext_vector_type(4)));
__device__ __forceinline__ s16x4 vtr(const lds_u8* p) { return __builtin_bit_cast(s16x4, __builtin_amdgcn_ds_read_tr16_b64_v4i16((__attribute__((address_space(3))) v4i16_t*)p)); }
__device__ __forceinline__ bf16x8 tr_frag(const lds_u8* base, int RS, int kbase, int nbase, int lane) {
    const lds_u8* p = base + (kbase + 8 * (lane >> 5) + ((lane & 15) >> 2)) * RS + (nbase + 16 * ((lane >> 4) & 1) + 4 * (lane & 3)) * 2;
    const s16x4 lo = vtr(p), hi = vtr(p + 4 * RS);
    return (bf16x8){lo[0], lo[1], lo[2], lo[3], hi[0], hi[1], hi[2], hi[3]};
}
#define MFMA32(a, b, c) __builtin_amdgcn_mfma_f32_32x32x16_bf16((a), (b), (c), 0, 0, 0)

template <bool FULL>
__device__ __forceinline__ void chunk_prep(const Params& P, int h, int tc, lds_u8* lds, float& bs0, float& bs1) {
    const int tid = opaque_tid(), d2 = tid & 63, rg = tid >> 6;
    const float* Gp = (const float*)(P.ws + WS_G) + (size_t)(tc + 8 * rg) * DH + h * HD + 2 * d2;
    const bf16_t* Qp = (const bf16_t*)(P.ws + WS_HQ) + (size_t)(tc + 8 * rg) * DH + h * HD + 2 * d2;
    const bf16_t* Vp = (const bf16_t*)(P.ws + WS_HI) + (size_t)(tc + (tid >> 4)) * DH + h * HD + (tid & 15) * 8;
    f32x2 g[8]; unsigned qraw[8];
#pragma unroll
    for (int i = 0; i < 8; ++i) { g[i] = *(const f32x2*)(Gp + (size_t)i * DH); if (FULL) qraw[i] = *(const unsigned*)(Qp + (size_t)i * DH); }
    const u32x4 va = *(const u32x4*)Vp, vb = *(const u32x4*)(Vp + (size_t)32 * DH);
    f32x2 cs[8]; float c0 = 0.f, c1 = 0.f;
#pragma unroll
    for (int i = 0; i < 8; ++i) { c0 += g[i].x; c1 += g[i].y; cs[i] = (f32x2){c0, c1}; }
    __attribute__((address_space(3))) float* GT = (__attribute__((address_space(3))) float*)(lds + OFF_GT);
    *(__attribute__((address_space(3))) f32x2*)(GT + rg * 128 + 2 * d2) = (f32x2){c0, c1};
    *(__attribute__((address_space(3))) u32x4*)(lds + OFF_VV + (tid >> 4) * RS_T + (tid & 15) * 16) = va;
    *(__attribute__((address_space(3))) u32x4*)(lds + OFF_VV + ((tid >> 4) + 32) * RS_T + (tid & 15) * 16) = vb;
    __syncthreads();
    float p0 = 0.f, p1 = 0.f, m0 = 0.f, m1 = 0.f, t0 = 0.f, t1 = 0.f;
#pragma unroll
    for (int j = 0; j < 8; ++j) { const f32x2 t = *(__attribute__((address_space(3))) f32x2*)(GT + j * 128 + 2 * d2);
        if (j < rg) { p0 += t.x; p1 += t.y; } if (j < 4) { m0 += t.x; m1 += t.y; } t0 += t.x; t1 += t.y; }
    if (rg == 0) { *(__attribute__((address_space(3))) f32x2*)(lds + OFF_BM + d2 * 8) = (f32x2){m0, m1}; *(__attribute__((address_space(3))) f32x2*)(lds + OFF_BL + d2 * 8) = (f32x2){t0, t1}; }
    bs0 += t0; bs1 += t1;
#pragma unroll
    for (int i = 0; i < 8; ++i) {
        const int row = 8 * rg + i; const float b0 = p0 + cs[i].x, b1 = p1 + cs[i].y;
        const float k0 = 1.0f - __expf(g[i].x), k1 = 1.0f - __expf(g[i].y);
        *(__attribute__((address_space(3))) unsigned*)(lds + OFF_KH + row * RS_T + d2 * 4) = pk2(k0 * __expf(t0 - b0), k1 * __expf(t1 - b1));
        if (FULL) {
            const float q0 = __uint_as_float(qraw[i] << 16), q1 = __uint_as_float(qraw[i] & 0xffff0000u);
            *(__attribute__((address_space(3))) unsigned*)(lds + OFF_QT + row * RS_Q + d2 * 4) = pk2(q0 * __expf(b0 - m0), q1 * __expf(b1 - m1));
            *(__attribute__((address_space(3))) unsigned*)(lds + OFF_KT + row * RS_Q + d2 * 4) = pk2(k0 * __expf(m0 - b0), k1 * __expf(m1 - b1));
        }
    }
    __syncthreads();
}
__device__ __forceinline__ void state_update(lds_u8* lds, f32x16 (&S)[2], int w, int lane) {
    const int db = w >> 1, hi = lane >> 5;
    const __attribute__((address_space(3))) float* BL = (const __attribute__((address_space(3))) float*)(lds + OFF_BL);
#pragma unroll
    for (int g4 = 0; g4 < 4; ++g4) { const f32x4 bl = *(const __attribute__((address_space(3))) f32x4*)(BL + 32 * db + 8 * g4 + 4 * hi);
#pragma unroll
        for (int q = 0; q < 4; ++q) { const float f = __expf(bl[q]); S[0][4 * g4 + q] *= f; S[1][4 * g4 + q] *= f; } }
#pragma unroll
    for (int ks = 0; ks < 4; ++ks) {
        const bf16x8 a = tr_frag(lds + OFF_KH, RS_T, 16 * ks, 32 * db, lane);
        const bf16x8 b0 = tr_frag(lds + OFF_VV, RS_T, 16 * ks, 32 * (2 * (w & 1)), lane), b1 = tr_frag(lds + OFF_VV, RS_T, 16 * ks, 32 * (2 * (w & 1) + 1), lane);
        S[0] = MFMA32(a, b0, S[0]); S[1] = MFMA32(a, b1, S[1]);
    }
}
__device__ __forceinline__ float* us_ptr(const Params& P, int sc, int h, int w, int j, int lane) {
    return (float*)(P.ws + WS_US) + ((size_t)(sc * NH + h) * HD + 32 * (w >> 1)) * HD + 32 * (2 * (w & 1) + j) + (lane & 31);
}
__device__ __forceinline__ void local_item(const Params& P, int sc, int h, lds_u8* lds) {
    const int tid = opaque_tid(), w = __builtin_amdgcn_readfirstlane(tid >> 6), lane = tid & 63, hi = lane >> 5;
    f32x16 S[2] = {}; float bs0 = 0.f, bs1 = 0.f;
    for (int c = 0; c < 4; ++c) {
        chunk_prep<false>(P, h, sc * 256 + c * 64, lds, bs0, bs1);
        state_update(lds, S, w, lane);
        __syncthreads();
    }
#pragma unroll
    for (int j = 0; j < 2; ++j) { float* up = us_ptr(P, sc, h, w, j, lane);
#pragma unroll
        for (int r = 0; r < 16; ++r) up[(size_t)crow(r, hi) * HD] = S[j][r]; }
    if (tid < 64) *(f32x2*)((float*)(P.ws + WS_BS) + (size_t)(sc * NH + h) * HD + 2 * tid) = (f32x2){bs0, bs1};
}
__device__ __forceinline__ void local_phase(const Params& P, int vcu, int nblk, lds_u8* lds) { for (int it = vcu; it < 256; it += nblk) local_item(P, it >> 2, it & 3, lds); }
__device__ __forceinline__ void scan_phase(const Params& P, int bid, int nblk) {
    const int tid = opaque_tid(); if (tid >= 256) return;
    float* US = (float*)(P.ws + WS_US); const float* BS = (const float*)(P.ws + WS_BS);
    for (int i = bid * 256 + tid; i < NH * HD * HD; i += nblk * 256) {
        const int hd = i >> 7; float s = 0.f;
        for (int sc0 = 0; sc0 < 64; sc0 += 8) {
            float u[8], a[8];
#pragma unroll
            for (int k = 0; k < 8; ++k) { u[k] = US[(size_t)(sc0 + k) * (NH * HD * HD) + i]; a[k] = BS[(size_t)(sc0 + k) * (NH * HD) + hd]; }
#pragma unroll
            for (int k = 0; k < 8; ++k) { US[(size_t)(sc0 + k) * (NH * HD * HD) + i] = s; s = __expf(a[k]) * s + u[k]; }
        }
    }
}
__device__ __forceinline__ void out_item(const Params& P, int sc, int h, lds_u8* lds) {
    const int tid = opaque_tid(), w = __builtin_amdgcn_readfirstlane(tid >> 6), lane = tid & 63, r32 = lane & 31, hi = lane >> 5;
    f32x16 S[2]; float bs0 = 0.f, bs1 = 0.f;
#pragma unroll
    for (int j = 0; j < 2; ++j) { const float* up = us_ptr(P, sc, h, w, j, lane);
#pragma unroll
        for (int r = 0; r < 16; ++r) S[j][r] = up[(size_t)crow(r, hi) * HD]; }
    const int tb = w >> 2, eb = w & 3, db = w >> 1;
    for (int c = 0; c < 4; ++c) {
        const int tc = sc * 256 + c * 64;
        chunk_prep<true>(P, h, tc, lds, bs0, bs1);
        { const __attribute__((address_space(3))) float* BM = (const __attribute__((address_space(3))) float*)(lds + OFF_BM);
#pragma unroll
          for (int g4 = 0; g4 < 4; ++g4) { const int d0 = 32 * db + 8 * g4 + 4 * hi; const f32x4 bm = *(const __attribute__((address_space(3))) f32x4*)(BM + d0);
              const float f0 = __expf(bm[0]), f1 = __expf(bm[1]), f2 = __expf(bm[2]), f3 = __expf(bm[3]);
#pragma unroll
              for (int j = 0; j < 2; ++j) { const int e = 32 * (2 * (w & 1) + j) + r32;
                  *(__attribute__((address_space(3))) u32x2*)(lds + OFF_ST + e * RS_Q + d0 * 2) = (u32x2){pk2(S[j][4 * g4] * f0, S[j][4 * g4 + 1] * f1), pk2(S[j][4 * g4 + 2] * f2, S[j][4 * g4 + 3] * f3)}; } } }
        if (w < 3) {
            const int sb = (w == 2) ? 1 : 0, tb2 = (w >= 1) ? 1 : 0; f32x16 acc = {};
#pragma unroll
            for (int ks = 0; ks < 8; ++ks) { const bf16x8 a = ld128(lds + OFF_KT + (32 * sb + r32) * RS_Q + (16 * ks + 8 * hi) * 2), b = ld128(lds + OFF_QT + (32 * tb2 + r32) * RS_Q + (16 * ks + 8 * hi) * 2);
                acc = MFMA32(a, b, acc); }
            const int t = 32 * tb2 + r32;
#pragma unroll
            for (int g4 = 0; g4 < 4; ++g4) { const int s0 = 32 * sb + 8 * g4 + 4 * hi; float v[4];
#pragma unroll
                for (int q = 0; q < 4; ++q) v[q] = (s0 + q <= t) ? acc[4 * g4 + q] : 0.f;
                *(__attribute__((address_space(3))) u32x2*)(lds + OFF_PP + t * RS_P + s0 * 2) = (u32x2){pk2(v[0], v[1]), pk2(v[2], v[3])}; }
        }
        __syncthreads();
        f32x16 o = {};
#pragma unroll
        for (int ks = 0; ks < 8; ++ks) { const bf16x8 a = ld128(lds + OFF_QT + (32 * tb + r32) * RS_Q + (16 * ks + 8 * hi) * 2), b = ld128(lds + OFF_ST + (32 * eb + r32) * RS_Q + (16 * ks + 8 * hi) * 2);
            o = MFMA32(a, b, o); }
#pragma unroll
        for (int ks = 0; ks < 4; ++ks) if (ks < 2 * (tb + 1)) { const bf16x8 a = ld128(lds + OFF_PP + (32 * tb + r32) * RS_P + (16 * ks + 8 * hi) * 2), b = tr_frag(lds + OFF_VV, RS_T, 16 * ks, 32 * eb, lane);
            o = MFMA32(a, b, o); }
        state_update(lds, S, w, lane);
        __syncthreads();
        { __attribute__((address_space(3))) float* OO = (__attribute__((address_space(3))) float*)(lds + OFF_OO);
#pragma unroll
          for (int r = 0; r < 16; ++r) OO[(32 * tb + crow(r, hi)) * (RS_O / 4) + 32 * eb + r32] = o[r]; }
        __syncthreads();
        { const int t = tid >> 3, e0 = (tid & 7) * 16; const __attribute__((address_space(3))) f32x4* orow = (const __attribute__((address_space(3))) f32x4*)(lds + OFF_OO + t * RS_O + e0 * 4);
          f32x4 v[4]; float ss = 0.f;
#pragma unroll
          for (int k = 0; k < 4; ++k) { v[k] = orow[k]; ss += (v[k].x * v[k].x + v[k].y * v[k].y) + (v[k].z * v[k].z + v[k].w * v[k].w); }
          ss += __shfl_xor(ss, 1); ss += __shfl_xor(ss, 2); ss += __shfl_xor(ss, 4);
          const float rs = 1.0f / sqrtf(ss * (1.0f / HD) + NORM_EPS);
          const bf16_t* hgp = (const bf16_t*)(P.ws + WS_HG) + (size_t)(tc + t) * DH + h * HD + e0; const u32x4 ga = *(const u32x4*)hgp, gb = *(const u32x4*)(hgp + 8);
          const f32x4* nw = (const f32x4*)(P.hgrn_norm_w + e0); float y[16];
#pragma unroll
          for (int k = 0; k < 4; ++k) { const f32x4 n4 = nw[k]; const unsigned g01 = (k < 2) ? ga[2 * k] : gb[2 * (k - 2)], g23 = (k < 2) ? ga[2 * k + 1] : gb[2 * (k - 2) + 1];
              y[4 * k] = v[k].x * rs * n4.x * __uint_as_float(g01 << 16); y[4 * k + 1] = v[k].y * rs * n4.y * __uint_as_float(g01 & 0xffff0000u);
              y[4 * k + 2] = v[k].z * rs * n4.z * __uint_as_float(g23 << 16); y[4 * k + 3] = v[k].w * rs * n4.w * __uint_as_float(g23 & 0xffff0000u); }
          bf16_t* mp = (bf16_t*)(P.ws + WS_MIX) + (size_t)(tc + t) * DM + h * HD + e0;
          *(u32x4*)mp = (u32x4){pk2(y[0], y[1]), pk2(y[2], y[3]), pk2(y[4], y[5]), pk2(y[6], y[7])};
          *(u32x4*)(mp + 8) = (u32x4){pk2(y[8], y[9]), pk2(y[10], y[11]), pk2(y[12], y[13]), pk2(y[14], y[15])}; }
        __syncthreads();
    }
}
__device__ __forceinline__ void out_phase(const Params& P, int vcu, int nblk, lds_u8* lds) { for (int it = vcu; it < 256; it += nblk) out_item(P, it >> 2, it & 3, lds); }
#undef MFMA32
}


#define LAS __attribute__((address_space(3)))
#define XB_TMO      128
#define XB_XCNT(j)  (256  + 64 * (j))
#define XB_XSUB(j)  (1280 + 64 * (j))
#define XB_XGEN(j)  (2304 + 64 * (j))
#define XB_TOP      3328
#define XB_TOPGEN   3392
#define XCD_BAR_WORDS 3456
#define XB_SPIN_CAP (1u << 18)
__device__ __forceinline__ unsigned xb_ld(unsigned* p)              { return __hip_atomic_load(p, __ATOMIC_RELAXED, __HIP_MEMORY_SCOPE_AGENT); }
__device__ __forceinline__ unsigned xb_add(unsigned* p, unsigned v) { return __hip_atomic_fetch_add(p, v, __ATOMIC_RELAXED, __HIP_MEMORY_SCOPE_AGENT); }
__device__ __forceinline__ unsigned xb_xcc_id() { return (unsigned)__builtin_amdgcn_s_getreg((3 << 11) | 20) & 0xFu; }
#define XB_SPIN(cond, bar) do { unsigned _sp = 0; while (cond) { __builtin_amdgcn_s_sleep(1); \
    if ((++_sp & 255u) == 0u) { if (xb_ld(&(bar)[XB_TMO])) break; if (_sp > XB_SPIN_CAP) { atomicAdd(&(bar)[XB_TMO], 1u); break; } } } } while (0)
struct XcdBarrier { unsigned* bar; unsigned x; volatile LAS unsigned* st; };
__device__ __forceinline__ XcdBarrier xcd_barrier_post(unsigned* bar, volatile LAS unsigned* st) {
    XcdBarrier b; b.bar = bar; b.x = xb_xcc_id(); b.st = st;
    if (threadIdx.x == 0) (void)xb_add(&bar[XB_XCNT(b.x)], 1u);
    return b;
}
__device__ __forceinline__ void xcd_barrier_complete(unsigned* bar, unsigned x, unsigned& nloc, unsigned& nx) {
    const unsigned G = gridDim.x * gridDim.y * gridDim.z;
    unsigned sum, cnt, mine, sp = 0u;
    for (;;) {
        sum = 0u; cnt = 0u; mine = 0u;
#pragma unroll
        for (unsigned j = 0; j < 16; ++j) { const unsigned c = xb_ld(&bar[XB_XCNT(j)]); sum += c; cnt += (c > 0u) ? 1u : 0u; mine = (j == x) ? c : mine; }
        if (sum == G) break;
        __builtin_amdgcn_s_sleep(1);
        if ((++sp & 255u) == 0u) { if (xb_ld(&bar[XB_TMO])) break; if (sp > XB_SPIN_CAP) { atomicAdd(&bar[XB_TMO], 1u); break; } }
    }
    nloc = mine > 0u ? mine : 1u; nx = cnt > 0u ? cnt : 1u;
}
__device__ __forceinline__ void xcd_barrier(const XcdBarrier& b) {
    asm volatile("s_waitcnt vmcnt(0)" ::: "memory");
    __syncthreads();
    if (threadIdx.x == 0) {
        unsigned* bar = b.bar;
        __builtin_amdgcn_s_waitcnt(0);
        unsigned nloc = b.st[0], nx = b.st[1];
        if (nloc == 0u) { xcd_barrier_complete(bar, b.x, nloc, nx); b.st[0] = nloc; b.st[1] = nx; }
        const unsigned old = xb_add(&bar[XB_XSUB(b.x)], 1u);
        const unsigned gen = old / nloc;
        if (old + 1u == (gen + 1u) * nloc) {
            __builtin_amdgcn_fence(__ATOMIC_RELEASE, "agent");
            asm volatile("s_waitcnt vmcnt(0)" ::: "memory");
            const unsigned og = xb_add(&bar[XB_TOP], 1u);
            const unsigned tg = og / nx;
            if (og + 1u == (tg + 1u) * nx) xb_add(&bar[XB_TOPGEN], 1u);
            else XB_SPIN(xb_ld(&bar[XB_TOPGEN]) == tg, bar);
            __builtin_amdgcn_fence(__ATOMIC_ACQUIRE, "agent");
            xb_add(&bar[XB_XGEN(b.x)], 1u);
            asm volatile("s_waitcnt vmcnt(0)" ::: "memory");
        } else {
            XB_SPIN(xb_ld(&bar[XB_XGEN(b.x)]) == gen, bar);
            __builtin_amdgcn_fence(__ATOMIC_ACQUIRE, "agent");
            asm volatile("s_waitcnt vmcnt(0)" ::: "memory");
        }
    }
    __syncthreads();
}
constexpr int CW_BAR = 131072;
constexpr int MISC_OFF = 147456 - 64;
constexpr int NWAVES = 8;
constexpr int LDS_BYTES = 147456;
constexpr int N_PHASES = 7;
struct Args { Params P; int ph_lo, ph_hi, flags, pad; };

__device__ __forceinline__ void final_norm_phase(const Params& P, int bid, int nblk) {
    const int lane = threadIdx.x & 63, wave = threadIdx.x >> 6, gw = bid * NWAVES + wave, ngw = nblk * NWAVES;
    const float* rowsq = (const float*)(P.ws + WS_CTL) + CT_ROWSQ;
    for (int m = gw; m < T; m += ngw) {
        f32x4* yr = (f32x4*)(P.out + (size_t)m * DM) + lane; const f32x4* wr = (const f32x4*)P.final_norm_w + lane;
        const float rstd = 1.0f / sqrtf(rowsq[m] * (1.0f / DM) + NORM_EPS);
#pragma unroll
        for (int j = 0; j < 4; ++j) { const f32x4 v = yr[64 * j], w = wr[64 * j]; yr[64 * j] = (f32x4){v.x * rstd * w.x, v.y * rstd * w.y, v.z * rstd * w.z, v.w * rstd * w.w}; }
    }
}

__global__ void __launch_bounds__(NWAVES * 64, 2) mk_fwd(Args a) {
    extern __shared__ __attribute__((aligned(16))) unsigned char lds[];
    const Params& P = a.P;
    const int G = gridDim.x, bx = blockIdx.x;
    const int vcu = (G % 8 == 0) ? (bx % 8) * (G / 8) + bx / 8 : bx;
    const int lo = a.ph_lo, hi = a.ph_hi;
#define IN(k) (lo <= (k) && (k) < hi)
#define SEAM(k) do { if (IN(k) && IN((k) + 1)) xcd_barrier(bar); } while (0)
    if (threadIdx.x < 16) ((LAS unsigned*)((LAS unsigned char*)lds + MISC_OFF))[threadIdx.x] = 0u;
    __syncthreads();
    const XcdBarrier bar = xcd_barrier_post((unsigned*)(P.ws + WS_CTL) + CW_BAR, (volatile LAS unsigned*)((LAS unsigned char*)lds + MISC_OFF));
    if (IN(0)) {
        prologue_phase(P, bx, G, (float*)lds);
        float* rowsq = (float*)(P.ws + WS_CTL) + CT_ROWSQ;
        for (int i = bx * (NWAVES * 64) + threadIdx.x; i < T; i += G * NWAVES * 64) rowsq[i] = 0.f;
    }
    SEAM(0);
    if (IN(1)) {
        pg8::Gemm g{(const bf16_t*)(P.ws + WS_XN), (const bf16_t*)(P.ws + WS_WIN), T, DIN, DM}; pg8::StaticOrder S; S.init(T, DIN, G, bx);
        EpiIn E{P};
        pg8::gemm_phase<EpiIn, pg8::StaticOrder, true, true>((PG8_LAS unsigned char*)lds, g, S, E);
    }
    SEAM(1);
    if (IN(2)) hg::local_phase(P, vcu, G, (hg::lds_u8*)lds);
    SEAM(2);
    if (IN(3)) hg::scan_phase(P, bx, G);
    SEAM(3);
    if (IN(4)) { att::attn_phase(P, vcu, G, (char*)lds); hg::out_phase(P, vcu, G, (hg::lds_u8*)lds); }
    SEAM(4);
    if (IN(5)) {
        pg8::Gemm g{(const bf16_t*)(P.ws + WS_MIX), (const bf16_t*)(P.ws + WS_WOUT), T, DM, DM}; pg8::StaticOrder S; S.init(T, DM, G, bx);
        EpiOut E{P};
        pg8::gemm_phase<EpiOut, pg8::StaticOrder, false, true>((PG8_LAS unsigned char*)lds, g, S, E);
    }
    SEAM(5);
    if (IN(6)) final_norm_phase(P, bx, G);
#undef IN
#undef SEAM
}

static int g_grid = 0;
static void launch_phases(const Params& P, int lo, int hi, hipStream_t stream) {
    Args a{}; a.P = P; a.ph_lo = lo; a.ph_hi = hi; a.flags = 0; a.pad = 0;
    if (hipMemsetAsync(P.ws + WS_CTL + (size_t)CW_BAR * 4, 0, XCD_BAR_WORDS * 4, stream) != hipSuccess) { fprintf(stderr, "kernel_launch: memset of the barrier words failed\n"); return; }
    hipLaunchKernelGGL(mk_fwd, dim3(g_grid), dim3(NWAVES * 64), LDS_BYTES, stream, a);
    const hipError_t e = hipPeekAtLastError();
    if (e != hipSuccess) fprintf(stderr, "kernel_launch: launch [%d,%d) failed: %s (grid %d)\n", lo, hi, hipGetErrorString(e), g_grid);
}

extern "C" void kernel_launch(void* const* d_in, const int* in_sizes, int n_in, void* d_out, int out_size, void* d_ws, size_t ws_size, hipStream_t stream) {
    if (n_in != 12 || in_sizes[0] != T * DM || out_size != T * DM || ws_size < 256 * MiB) { fprintf(stderr, "kernel_launch: unexpected shapes (n_in %d in0 %d out %d ws %zu)\n", n_in, n_in > 0 ? in_sizes[0] : -1, out_size, ws_size); return; }
    if (g_grid == 0) {
        int dev = 0, cus = 0, per_cu = 0;
        if (hipGetDevice(&dev) != hipSuccess || hipDeviceGetAttribute(&cus, hipDeviceAttributeMultiprocessorCount, dev) != hipSuccess) { fprintf(stderr, "kernel_launch: device query failed\n"); g_grid = -1; return; }
        if (hipFuncSetAttribute((const void*)mk_fwd, hipFuncAttributeMaxDynamicSharedMemorySize, LDS_BYTES) != hipSuccess) { fprintf(stderr, "kernel_launch: hipFuncSetAttribute failed\n"); g_grid = -1; return; }
        if (hipOccupancyMaxActiveBlocksPerMultiprocessor(&per_cu, (const void*)mk_fwd, NWAVES * 64, LDS_BYTES) != hipSuccess || per_cu < 1) { fprintf(stderr, "kernel_launch: occupancy query says %d blocks per CU\n", per_cu); per_cu = 1; }
        (void)hipGetLastError();
        g_grid = cus * (per_cu < 1 ? 1 : 1);
    }
    if (g_grid < 0) return;
    Params P{};
    P.x = (const float*)d_in[0]; P.norm_w = (const float*)d_in[1]; P.w_in = (const float*)d_in[2]; P.lb_logits = (const float*)d_in[3]; P.hgrn_norm_w = (const float*)d_in[4];
    P.lq1 = (const float*)d_in[5]; P.lk1 = (const float*)d_in[6]; P.lq2 = (const float*)d_in[7]; P.lk2 = (const float*)d_in[8]; P.diff_norm_w = (const float*)d_in[9];
    P.w_out = (const float*)d_in[10]; P.final_norm_w = (const float*)d_in[11]; P.out = (float*)d_out; P.ws = (unsigned char*)d_ws;
    launch_phases(P, 0, N_PHASES, stream);
}
```
